# Optimizing an MI355X kernel written in HIP

```python
import functools
import jax, jax.numpy as jnp
from jax import lax
import numpy as np

D_MODEL = 1024
BATCH = 1
SEQ = 16384
DEPTH = 1
DEC_BATCH = 128
DEC_SEQ = 8
PAST_LEN = 16384
PAGE_SIZE = 128

N_HEADS = 16
N_KV_HEADS = 4
HEAD_DIM = D_MODEL // N_HEADS
GROUP = N_HEADS // N_KV_HEADS
ATTN_WIDTH = N_HEADS * HEAD_DIM
KV_WIDTH = N_KV_HEADS * HEAD_DIM
WINDOW = 128
BLOCK = 128
ROPE_THETA = 10000.0
CONV_WIDTH = D_MODEL
CONV_K = 3
N_META = 16
EPS = 1e-6
NEG_INF = -1e30
IN_SIZES = (ATTN_WIDTH, KV_WIDTH, KV_WIDTH, ATTN_WIDTH,
            CONV_WIDTH, CONV_WIDTH, CONV_WIDTH, CONV_WIDTH, D_MODEL, D_MODEL)
IN_WIDTH = sum(IN_SIZES)

kernel_name = 'hybrid_swa_sink_shortconv_gated_merge_step'


def _split_points():
    return [int(s) for s in np.cumsum(IN_SIZES)[:-1]]


def _rms_norm(x, w):
    xf = x.astype(jnp.float32)
    r = lax.rsqrt(jnp.mean(xf * xf, axis=-1, keepdims=True) + EPS)
    return (xf * r).astype(x.dtype) * w.astype(x.dtype)


def _rope(x, pos):
    half = HEAD_DIM // 2
    inv = jnp.power(ROPE_THETA, -jnp.arange(half, dtype=jnp.float32) * (2.0 / HEAD_DIM))
    ang = pos.astype(jnp.float32)[:, None] * inv[None, :]
    cos = jnp.cos(ang)[:, None, :]
    sin = jnp.sin(ang)[:, None, :]
    xf = x.astype(jnp.float32)
    x1, x2 = xf[..., :half], xf[..., half:]
    return jnp.concatenate([x1 * cos - x2 * sin, x2 * cos + x1 * sin], axis=-1).astype(x.dtype)


def _sink_softmax(s, sinks):
    sk = sinks.astype(jnp.float32).reshape(N_KV_HEADS, GROUP)[:, :, None, None]
    m = jnp.maximum(jnp.max(s, axis=-1, keepdims=True), sk)
    p = jnp.exp(s - m)
    return p / (jnp.sum(p, axis=-1, keepdims=True) + jnp.exp(sk - m))


def _window_attn_prompt(q, k, v, sinks, pos):
    n, L = q.shape[:2]
    nb = L // BLOCK
    qb = q.reshape(n, nb, BLOCK, N_KV_HEADS, GROUP, HEAD_DIM)
    kb = k.reshape(n, nb, BLOCK, N_KV_HEADS, HEAD_DIM)
    vb = v.reshape(n, nb, BLOCK, N_KV_HEADS, HEAD_DIM)
    shift = ((0, 0), (1, 0), (0, 0), (0, 0), (0, 0))
    kk = jnp.concatenate([jnp.pad(kb[:, :-1], shift), kb], axis=2)
    vv = jnp.concatenate([jnp.pad(vb[:, :-1], shift), vb], axis=2)
    pb = pos.reshape(nb, BLOCK)
    kpos = jnp.concatenate([pb - BLOCK, pb], axis=1)
    diff = pb[:, :, None] - kpos[:, None, :]
    mask = (diff >= 0) & (diff <= WINDOW) & (kpos[:, None, :] >= 0)
    s = jnp.einsum('bnqkgd,bnskd->bnkgqs', qb, kk).astype(jnp.float32) * (HEAD_DIM ** -0.5)
    s = jnp.where(mask[None, :, None, None], s, NEG_INF)
    p = _sink_softmax(s, sinks).astype(v.dtype)
    o = jnp.einsum('bnkgqs,bnskd->bnqkgd', p, vv)
    return o.reshape(n, L, ATTN_WIDTH)


def _window_attn_sample(q, k, v, sinks, cache_k, cache_v):
    n, T = q.shape[:2]
    kk = jnp.concatenate([cache_k.astype(k.dtype), k], axis=1)
    vv = jnp.concatenate([cache_v.astype(v.dtype), v], axis=1)
    qpos = PAST_LEN + jnp.arange(T)
    kpos = PAST_LEN - WINDOW + jnp.arange(WINDOW + T)
    diff = qpos[:, None] - kpos[None, :]
    mask = (diff >= 0) & (diff <= WINDOW)
    qg = q.reshape(n, T, N_KV_HEADS, GROUP, HEAD_DIM)
    s = jnp.einsum('btkgd,bskd->bkgts', qg, kk).astype(jnp.float32) * (HEAD_DIM ** -0.5)
    s = jnp.where(mask[None, None, None], s, NEG_INF)
    p = _sink_softmax(s, sinks).astype(v.dtype)
    o = jnp.einsum('bkgts,bskd->btkgd', p, vv)
    return o.reshape(n, T, ATTN_WIDTH)


def _causal_conv(u_ext, w):
    T = u_ext.shape[1] - (CONV_K - 1)
    w = w.astype(u_ext.dtype)
    out = w[0] * u_ext[:, 0:T]
    for i in range(1, CONV_K):
        out = out + w[i] * u_ext[:, i:i + T]
    return out


def _layer(h, pos, valid, conv_prefix, attend, norm_w, w_in, q_norm_w, k_norm_w, sinks,
           conv_w, w_proj_a, w_proj_b, w_out):
    n, t, _ = h.shape
    xn = _rms_norm(h, norm_w)
    p = jnp.einsum('ntd,de->nte', xn, w_in)
    q, k, v, z_a, b, c, hc, z_b, g_a, g_b = jnp.split(p, _split_points(), axis=-1)
    q = _rope(_rms_norm(q.reshape(n, t, N_HEADS, HEAD_DIM), q_norm_w), pos)
    k = _rope(_rms_norm(k.reshape(n, t, N_KV_HEADS, HEAD_DIM), k_norm_w), pos)
    v = v.reshape(n, t, N_KV_HEADS, HEAD_DIM)
    o_a = attend(q, k, v, sinks)
    u = jnp.where(valid[None, :, None], c * hc, 0)
    u_ext = jnp.concatenate([conv_prefix.astype(u.dtype), u], axis=1)
    o_b = b * _causal_conv(u_ext, conv_w)
    br_a = jnp.einsum('nte,ed->ntd', o_a * jax.nn.silu(z_a), w_proj_a)
    br_b = jnp.einsum('nte,ed->ntd', o_b * jax.nn.silu(z_b), w_proj_b)
    mixed = jax.nn.sigmoid(g_a) * br_a + jax.nn.sigmoid(g_b) * br_b
    return h + jnp.einsum('ntd,de->nte', mixed, w_out), k, v, u_ext


def setup_inputs(seed: int = 0) -> dict:
    key = jax.random.key(seed)
    ks = jax.random.split(key, 16)
    f32 = jnp.float32
    nrm = lambda k, shape, scale=1.0: jax.random.normal(k, shape, f32) * scale
    return {
        'x_prompt': nrm(ks[0], (BATCH, SEQ, D_MODEL)),
        'x_sample': nrm(ks[1], (DEC_BATCH, DEC_SEQ, D_MODEL)),
        'cache_k': nrm(ks[2], (DEPTH, DEC_BATCH, WINDOW, N_KV_HEADS, HEAD_DIM)),
        'cache_v': nrm(ks[3], (DEPTH, DEC_BATCH, WINDOW, N_KV_HEADS, HEAD_DIM)),
        'state_conv': nrm(ks[4], (DEPTH, DEC_BATCH, CONV_K - 1, CONV_WIDTH)),
        'meta_tokens': nrm(ks[5], (N_META, D_MODEL)),
        'norm_w': 1.0 + nrm(ks[6], (DEPTH, D_MODEL), 0.02),
        'w_in': nrm(ks[7], (DEPTH, D_MODEL, IN_WIDTH), D_MODEL ** -0.5),
        'q_norm_w': 1.0 + nrm(ks[8], (DEPTH, HEAD_DIM), 0.02),
        'k_norm_w': 1.0 + nrm(ks[9], (DEPTH, HEAD_DIM), 0.02),
        'sinks': nrm(ks[10], (DEPTH, N_HEADS)),
        'conv_w': nrm(ks[11], (DEPTH, CONV_K, CONV_WIDTH), CONV_K ** -0.5),
        'w_proj_a': nrm(ks[12], (DEPTH, ATTN_WIDTH, D_MODEL), ATTN_WIDTH ** -0.5),
        'w_proj_b': nrm(ks[13], (DEPTH, CONV_WIDTH, D_MODEL), CONV_WIDTH ** -0.5),
        'w_out': nrm(ks[14], (DEPTH, D_MODEL, D_MODEL), D_MODEL ** -0.5),
    }


def reference(x_prompt, x_sample, cache_k, cache_v, state_conv, meta_tokens, norm_w, w_in,
              q_norm_w, k_norm_w, sinks, conv_w, w_proj_a, w_proj_b, w_out):
    nb_, _, d = x_prompt.shape
    lead = BLOCK - N_META
    meta = jnp.broadcast_to(meta_tokens.astype(x_prompt.dtype)[None], (nb_, N_META, d))
    h = jnp.concatenate([jnp.zeros((nb_, lead, d), x_prompt.dtype), meta, x_prompt], axis=1)
    pos_p = jnp.arange(h.shape[1]) - lead
    valid_p = pos_p >= 0
    attend_p = functools.partial(_window_attn_prompt, pos=pos_p)
    conv0 = jnp.zeros((nb_, CONV_K - 1, CONV_WIDTH), x_prompt.dtype)
    nk_p, nv_p, nc_p = [], [], []
    for l in range(DEPTH):
        h, k, v, u_ext = _layer(h, pos_p, valid_p, conv0, attend_p, norm_w[l], w_in[l],
                                q_norm_w[l], k_norm_w[l], sinks[l], conv_w[l],
                                w_proj_a[l], w_proj_b[l], w_out[l])
        nk_p.append(k[:, -WINDOW:])
        nv_p.append(v[:, -WINDOW:])
        nc_p.append(u_ext[:, -(CONV_K - 1):])
    y_prompt = h[:, BLOCK:]

    hs = x_sample
    t = x_sample.shape[1]
    pos_s = PAST_LEN + jnp.arange(t)
    valid_s = jnp.ones((t,), dtype=bool)
    nk_s, nv_s, nc_s = [], [], []
    for l in range(DEPTH):
        attend_s = functools.partial(_window_attn_sample, cache_k=cache_k[l], cache_v=cache_v[l])
        hs, k, v, u_ext = _layer(hs, pos_s, valid_s, state_conv[l], attend_s, norm_w[l], w_in[l],
                                 q_norm_w[l], k_norm_w[l], sinks[l], conv_w[l],
                                 w_proj_a[l], w_proj_b[l], w_out[l])
        nk_s.append(jnp.concatenate([cache_k[l].astype(k.dtype), k], axis=1)[:, -WINDOW:])
        nv_s.append(jnp.concatenate([cache_v[l].astype(v.dtype), v], axis=1)[:, -WINDOW:])
        nc_s.append(u_ext[:, -(CONV_K - 1):])
    y_sample = hs

    new_k_prompt = jnp.stack(nk_p, 0)
    new_v_prompt = jnp.stack(nv_p, 0)
    new_conv_prompt = jnp.stack(nc_p, 0)
    new_k_sample = jnp.stack(nk_s, 0)
    new_v_sample = jnp.stack(nv_s, 0)
    new_conv_sample = jnp.stack(nc_s, 0)
    return (y_prompt, y_sample, new_k_prompt, new_v_prompt, new_conv_prompt,
            new_k_sample, new_v_sample, new_conv_sample)
```

```cpp
#include <hip/hip_runtime.h>
#include <hip/hip_cooperative_groups.h>
#include <cstdio>
#include <cstdint>
namespace cg = cooperative_groups;

#ifndef DBG_NPH
#define DBG_NPH 5
#define DBG_DUMP 0
#endif
#ifndef MK_N_LAUNCHES
#define MK_N_LAUNCHES 1
#endif

#define LAS __attribute__((address_space(3)))
typedef unsigned short bf16_t;
typedef short bf16x8 __attribute__((ext_vector_type(8)));
typedef float f32x4 __attribute__((ext_vector_type(4)));
typedef float f32x16 __attribute__((ext_vector_type(16)));
typedef unsigned u32x4 __attribute__((ext_vector_type(4)));
typedef unsigned u32x2 __attribute__((ext_vector_type(2)));

constexpr int DM = 1024, NIN = 8704;
constexpr int R_META = 112, R_PROMPT = 128, R_SAMPLE = 16512, R_END = 17536, MROWS = 17664;
constexpr int M23 = 17408;
constexpr int NPOS = 16400;
constexpr float EPS = 1e-6f;
constexpr float LOG2E = 1.4426950408889634f;
constexpr float C2 = 0.125f * LOG2E;
constexpr size_t O_Y = 0, O_NKP = 17825792, O_NVP = 17858560, O_NCP = 17891328, O_NKS = 17893376, O_NVS = 22087680, O_NCS = 26281984;
constexpr size_t BUFB = (size_t)MROWS * DM * 2;
constexpr size_t WS_WIN = 0, WS_WA = (size_t)NIN * DM * 2, WS_WB = WS_WA + 2097152, WS_WO = WS_WB + 2097152;
constexpr size_t WS_B0 = 25165824;
constexpr size_t WS_QA = WS_B0 + BUFB, WS_BZ = WS_QA + BUFB, WS_SZA = WS_BZ + BUFB, WS_U = WS_SZA + BUFB, WS_SGB = WS_U + BUFB;
constexpr size_t WS_K = WS_SGB + BUFB, WS_VT = WS_K + (size_t)MROWS * 256 * 2, WS_ROPE = WS_VT + (size_t)MROWS * 256 * 2, WS_END = WS_ROPE + (size_t)NPOS * 64 * 4;
static_assert(WS_END <= 268435456, "d_ws map");

constexpr int LDS_BYTES = 147456;

namespace pg8 {
constexpr int BM = 256, BK = 64, HALF = 128, HTB = HALF * BK * 2, STAGE_BYTES = 8 * HTB, NXCD = 8, WGM = 8;
__host__ __device__ __forceinline__ int lds_byte(int r, int c) { const int st = (r >> 4) * 2 + (c >> 5), rr = r & 15, cc = c & 31, ob = rr * 64 + cc * 2; return st * 1024 + (ob ^ (((ob >> 9) & 1) << 5)); }
__host__ __device__ __forceinline__ void stage_rc(int b, int& R, int& C) { const int st = b / 1024, sb = b % 1024, swz = sb ^ (((sb >> 9) & 1) << 5); R = (st >> 1) * 16 + swz / 64; C = (st & 1) * 32 + (swz % 64) / 2; }
__host__ __device__ __forceinline__ int perm32(int rho) { const int n = rho >> 4, i = rho & 15; return 8 * (i >> 2) + 4 * n + (i & 3); }

struct Unit { int pm, pn, part; };
struct Gemm { const bf16_t* A; const bf16_t* Bt; int M, N, K; size_t partA, partB; };

struct StaticOrder {
    int nM, nN, nwg, G, c, np;
    __host__ __device__ void init(int M, int N, int G_, int c_, int np_) { nM = M / BM; nN = N / BM; nwg = nM * nN; G = G_; c = c_; np = np_; }
    __host__ __device__ bool next(int i, Unit& u) const {
        const int it = (np == 2) ? (i >> 1) : i; u.part = (np == 2) ? (i & 1) : 0;
        const long L = (long)it * G + c; if (L >= nwg) return false;
        int wgid = (int)L; { const int q = nwg / NXCD, r = nwg % NXCD, xcd = wgid % NXCD, off = wgid / NXCD; wgid = (xcd < r ? xcd * (q + 1) : r * (q + 1) + (xcd - r) * q) + off; }
        const int nig = WGM * nN, gid = wgid / nig, fm = gid * WGM, gsz = (nM - fm) < WGM ? (nM - fm) : WGM;
        u.pm = fm + ((wgid % nig) % gsz); u.pn = (wgid % nig) / gsz; return true;
    }
};

typedef float f32x2_t __attribute__((ext_vector_type(2))); typedef __bf16 bf16x2_t __attribute__((ext_vector_type(2)));
__device__ __forceinline__ unsigned cvt_pk_bf16(float lo, float hi) { const f32x2_t v = {lo, hi}; const bf16x2_t b = __builtin_convertvector(v, bf16x2_t); return __builtin_bit_cast(unsigned, b); }

template <class Epi>
__device__ __forceinline__ void gemm_phase(LAS unsigned char* lds, const Gemm g, const StaticOrder& S, const Epi& E) {
    const int tid = threadIdx.x, wid = __builtin_amdgcn_readfirstlane(tid >> 6), lane = tid & 63, wr = wid >> 2, wc = wid & 3, fr = lane & 15, fq = lane >> 4;
    const int K = g.K, nt = K / BK;
    unsigned voffA[2], voffB[2];
#pragma unroll
    for (int i = 0; i < 2; ++i) { int R, C; stage_rc(tid * 16 + i * 8192, R, C); const int Rb = ((R & ~31) + perm32(R & 31));
        voffA[i] = (unsigned)(R * K + C) * 2u; voffB[i] = (unsigned)(Rb * K + C) * 2u; }
    const size_t kstep = (size_t)(BK * 2);
    const size_t hstep = (size_t)HALF * K * 2;
    const size_t tstep = 2 * hstep;
    const unsigned ldsw = (unsigned)wid * 1024u;
    const int aoff = lds_byte(wr * 64 + fr, fq * 8), boff = lds_byte(wc * 32 + fr, fq * 8);
#define PG8_SA(b, h) (((b) * 2 + (h)) * HTB)
#define PG8_SB(b, h) ((4 + (b) * 2 + (h)) * HTB)
#define PG8_STAGE(bufoff, gbase, voff) do { _Pragma("unroll") for (int _i = 0; _i < 2; ++_i) \
        __builtin_amdgcn_global_load_lds((const unsigned*)((const char*)(gbase) + (voff)[_i]), (LAS unsigned*)(lds + (bufoff) + ldsw + _i * 8192), 16, 0, 0); } while (0)
#define PG8_LDA(dst, b, h) do { _Pragma("unroll") for (int m = 0; m < 4; ++m) _Pragma("unroll") for (int k = 0; k < 2; ++k) dst[m][k] = *(const LAS bf16x8*)(lds + PG8_SA(b, h) + aoff + m * 2048 + k * 1024); } while (0)
#define PG8_LDB(dst, b, h) do { _Pragma("unroll") for (int n = 0; n < 2; ++n) _Pragma("unroll") for (int k = 0; k < 2; ++k) dst[n][k] = *(const LAS bf16x8*)(lds + PG8_SB(b, h) + boff + n * 2048 + k * 1024); } while (0)
#define PG8_MMA(ai, bj, At, Bt) do { __builtin_amdgcn_s_setprio(1); _Pragma("unroll") for (int m = 0; m < 4; ++m) _Pragma("unroll") for (int n = 0; n < 2; ++n) _Pragma("unroll") for (int k = 0; k < 2; ++k) \
        acc[ai][bj][m][n] = __builtin_amdgcn_mfma_f32_16x16x32_bf16(Bt[n][k], At[m][k], acc[ai][bj][m][n], 0, 0, 0); __builtin_amdgcn_s_setprio(0); } while (0)
#define PG8_WAIT_V(n) asm volatile("s_waitcnt vmcnt(" #n ")" ::: "memory")
#define PG8_WAIT_L(n) asm volatile("s_waitcnt lgkmcnt(" #n ")" ::: "memory")
#define PG8_BAR __builtin_amdgcn_s_barrier()
#define PG8_SCHED __builtin_amdgcn_sched_barrier(0)
    Unit cur, nxt; int ui = 0;
    if (!S.next(0, cur)) return;
    f32x4 acc[2][2][4][2];
#pragma unroll
    for (int a = 0; a < 2; ++a)
#pragma unroll
        for (int b = 0; b < 2; ++b)
#pragma unroll
            for (int m = 0; m < 4; ++m)
#pragma unroll
                for (int n = 0; n < 2; ++n) acc[a][b][m][n] = (f32x4){0.f, 0.f, 0.f, 0.f};
    bf16x8 At[4][2], B0[2][2], B1[2][2];
    const char* cA = (const char*)g.A + (size_t)cur.pm * tstep + (size_t)cur.part * g.partA; const char* cB = (const char*)g.Bt + (size_t)cur.pn * tstep + (size_t)cur.part * g.partB;
    PG8_STAGE(PG8_SB(0, 0), cB, voffB); PG8_STAGE(PG8_SB(0, 1), cB + hstep, voffB); PG8_STAGE(PG8_SA(0, 0), cA, voffA); PG8_STAGE(PG8_SA(0, 1), cA + hstep, voffA);
    if (wr == 1) PG8_BAR;
    PG8_WAIT_V(2); PG8_BAR;
    PG8_STAGE(PG8_SB(1, 0), cB + kstep, voffB); PG8_STAGE(PG8_SA(1, 0), cA + kstep, voffA); PG8_STAGE(PG8_SB(1, 1), cB + hstep + kstep, voffB);
    PG8_WAIT_V(6); PG8_BAR;
    for (;;) {
        const bool has_next = S.next(ui + 1, nxt);
        const char* nA = has_next ? (const char*)g.A + (size_t)nxt.pm * tstep + (size_t)nxt.part * g.partA : cA; const char* nB = has_next ? (const char*)g.Bt + (size_t)nxt.pn * tstep + (size_t)nxt.part * g.partB : cB;
        for (int t = 0; t < nt; t += 2) {
            const bool last = (t == nt - 2);
            const char* a1 = cA + (size_t)(t + 1) * kstep;
            const char* a2 = last ? nA : cA + (size_t)(t + 2) * kstep; const char* b2 = last ? nB : cB + (size_t)(t + 2) * kstep;
            const char* a3 = a2 + kstep; const char* b3 = b2 + kstep;
            PG8_LDB(B0, 0, 0); PG8_LDB(B1, 0, 1); PG8_SCHED; PG8_LDA(At, 0, 0); PG8_STAGE(PG8_SA(1, 1), a1 + hstep, voffA);
            PG8_WAIT_V(8); PG8_WAIT_L(0); PG8_BAR; PG8_MMA(0, 0, At, B0); PG8_MMA(0, 1, At, B1); PG8_BAR; PG8_SCHED;
            PG8_LDA(At, 0, 1); PG8_STAGE(PG8_SB(0, 0), b2, voffB); PG8_STAGE(PG8_SB(0, 1), b2 + hstep, voffB); PG8_STAGE(PG8_SA(0, 0), a2, voffA);
            PG8_WAIT_V(8); PG8_WAIT_L(0); PG8_BAR; PG8_MMA(1, 0, At, B0); PG8_MMA(1, 1, At, B1); PG8_BAR; PG8_SCHED;
            PG8_LDB(B0, 1, 0); PG8_LDB(B1, 1, 1); PG8_SCHED; PG8_LDA(At, 1, 0); PG8_STAGE(PG8_SA(0, 1), a2 + hstep, voffA);
            PG8_WAIT_V(8); PG8_WAIT_L(0); PG8_BAR; PG8_MMA(0, 0, At, B0); PG8_MMA(0, 1, At, B1); PG8_BAR; PG8_SCHED;
            PG8_LDA(At, 1, 1); PG8_STAGE(PG8_SB(1, 0), b3, voffB); PG8_STAGE(PG8_SB(1, 1), b3 + hstep, voffB); PG8_STAGE(PG8_SA(1, 0), a3, voffA);
            PG8_WAIT_V(8); PG8_WAIT_L(0); PG8_BAR; PG8_MMA(1, 0, At, B0); PG8_MMA(1, 1, At, B1); PG8_BAR; PG8_SCHED;
        }
        if (wr == 0) PG8_BAR;
        E(acc, cur, wr, wc, fr, fq);
        if (!has_next) break;
        if (!E.keep(cur)) {
#pragma unroll
        for (int a = 0; a < 2; ++a)
#pragma unroll
            for (int b = 0; b < 2; ++b)
#pragma unroll
                for (int m = 0; m < 4; ++m)
#pragma unroll
                    for (int n = 0; n < 2; ++n) acc[a][b][m][n] = (f32x4){0.f, 0.f, 0.f, 0.f};
        }
        cur = nxt; cA = nA; cB = nB; ++ui;
        if (wr == 1) PG8_BAR;
    }
    PG8_WAIT_V(0);
    PG8_BAR;
#undef PG8_SA
#undef PG8_SB
#undef PG8_STAGE
#undef PG8_LDA
#undef PG8_LDB
#undef PG8_MMA
#undef PG8_WAIT_V
#undef PG8_WAIT_L
#undef PG8_BAR
#undef PG8_SCHED
}
}
using pg8::cvt_pk_bf16;

__device__ __forceinline__ float bf_lo(unsigned u) { return __uint_as_float(u << 16); }
__device__ __forceinline__ float bf_hi(unsigned u) { return __uint_as_float(u & 0xffff0000u); }
__device__ __forceinline__ float sigm_f(float x) { return __builtin_amdgcn_rcpf(1.f + __builtin_amdgcn_exp2f(-LOG2E * x)); }
__device__ __forceinline__ float silu_f(float x) { return x * sigm_f(x); }
__device__ __forceinline__ f32x4 sigm4(const f32x4 v) { f32x4 r; r.x = sigm_f(v.x); r.y = sigm_f(v.y); r.z = sigm_f(v.z); r.w = sigm_f(v.w); return r; }
__device__ __forceinline__ int rowpos(int row) { return row < R_SAMPLE ? (row > R_META ? row - R_META : 0) : (row < R_END ? 16384 + ((row - R_SAMPLE) & 7) : 0); }
__device__ __forceinline__ u32x4 pack8(const f32x4 a, const f32x4 b) { u32x4 w; w.x = cvt_pk_bf16(a[0], a[1]); w.y = cvt_pk_bf16(a[2], a[3]); w.z = cvt_pk_bf16(b[0], b[1]); w.w = cvt_pk_bf16(b[2], b[3]); return w; }

struct Epi1 {
    bf16_t *Q, *Kb, *Vt, *SZA, *BZ, *U, *SGA, *SGB; const float *rope, *qnw, *knw; float* out;
    __device__ __forceinline__ bool keep(const pg8::Unit&) const { return false; }
    __device__ __forceinline__ void operator()(f32x4 (&acc)[2][2][4][2], const pg8::Unit& u, int wr, int wc, int fr, int fq) const {
        const int pn = u.pn, row0 = u.pm * 256 + wr * 64 + fr;
        if (pn < 5) {
            const bool isq = pn < 4; const float* nw = isq ? qnw : knw;
            f32x4 w[2][2];
#pragma unroll
            for (int bj = 0; bj < 2; ++bj)
#pragma unroll
                for (int n = 0; n < 2; ++n) w[bj][n] = *(const f32x4*)(nw + 32 * bj + 8 * fq + 4 * n);
            const float sc = isq ? C2 : 1.f;
#pragma unroll
            for (int ai = 0; ai < 2; ++ai)
#pragma unroll
                for (int m = 0; m < 4; ++m) {
                    const int row = row0 + ai * 128 + m * 16;
                    float ss = 0.f;
#pragma unroll
                    for (int bj = 0; bj < 2; ++bj)
#pragma unroll
                        for (int n = 0; n < 2; ++n) { const f32x4 x = acc[ai][bj][m][n]; ss += (x[0] * x[0] + x[1] * x[1]) + (x[2] * x[2] + x[3] * x[3]); }
                    ss += __shfl_xor(ss, 16); ss += __shfl_xor(ss, 32);
                    const float rinv = 1.0f / sqrtf(ss * (1.f / 64.f) + EPS);
                    const float* rp = rope + (size_t)rowpos(row) * 64 + 8 * fq;
                    f32x4 o1[2], o2[2];
#pragma unroll
                    for (int n = 0; n < 2; ++n) {
                        const f32x4 cs = *(const f32x4*)(rp + 4 * n), sn = *(const f32x4*)(rp + 32 + 4 * n);
                        const f32x4 x1 = acc[ai][0][m][n] * rinv * w[0][n], x2 = acc[ai][1][m][n] * rinv * w[1][n];
                        o1[n] = (x1 * cs - x2 * sn) * sc; o2[n] = (x2 * cs + x1 * sn) * sc;
                    }
                    if (isq) {
                        bf16_t* p = Q + (size_t)row * DM + 64 * (4 * pn + wc) + 8 * fq;
                        *(u32x4*)p = pack8(o1[0], o1[1]); *(u32x4*)(p + 32) = pack8(o2[0], o2[1]);
                    } else {
                        bf16_t* p = Kb + (size_t)row * 256 + 64 * wc + 8 * fq;
                        *(u32x4*)p = pack8(o1[0], o1[1]); *(u32x4*)(p + 32) = pack8(o2[0], o2[1]);
                        if (u.pm >= 64) {
                            float* d = nullptr;
                            if (row >= 16384 && row < R_SAMPLE) d = out + O_NKP + (size_t)(row - 16384) * 256;
                            else if (row >= R_SAMPLE && row < R_END) { const int sr = row - R_SAMPLE; d = out + O_NKS + ((size_t)(sr >> 3) * 128 + 120 + (sr & 7)) * 256; }
                            if (d) { d += 64 * wc + 8 * fq; *(f32x4*)d = o1[0]; *(f32x4*)(d + 4) = o1[1]; *(f32x4*)(d + 32) = o2[0]; *(f32x4*)(d + 36) = o2[1]; }
                        }
                    }
                }
        } else if (pn == 5) {
#pragma unroll
            for (int ai = 0; ai < 2; ++ai)
#pragma unroll
                for (int m = 0; m < 4; ++m) {
                    const int row = row0 + ai * 128 + m * 16;
                    float* d = nullptr;
                    if (u.pm >= 64) {
                        if (row >= 16384 && row < R_SAMPLE) d = out + O_NVP + (size_t)(row - 16384) * 256;
                        else if (row >= R_SAMPLE && row < R_END) { const int sr = row - R_SAMPLE; d = out + O_NVS + ((size_t)(sr >> 3) * 128 + 120 + (sr & 7)) * 256; }
                    }
#pragma unroll
                    for (int bj = 0; bj < 2; ++bj)
#pragma unroll
                        for (int n = 0; n < 2; ++n) {
                            const int c = 128 * bj + 32 * wc + 8 * fq + 4 * n; const f32x4 x = acc[ai][bj][m][n];
                            const unsigned p0 = cvt_pk_bf16(x[0], x[1]), p1 = cvt_pk_bf16(x[2], x[3]);
                            bf16_t* vp = Vt + (size_t)c * MROWS + row;
                            vp[0] = (bf16_t)(p0 & 0xffffu); vp[MROWS] = (bf16_t)(p0 >> 16); vp[2 * (size_t)MROWS] = (bf16_t)(p1 & 0xffffu); vp[3 * (size_t)MROWS] = (bf16_t)(p1 >> 16);
                            if (d) *(f32x4*)(d + c) = x;
                        }
                }
        } else if (pn >= 10 && pn < 26) {
            const int ch = 64 * (pn - 10) + 16 * wc + 4 * fq;
#pragma unroll
            for (int ai = 0; ai < 2; ++ai)
#pragma unroll
                for (int m = 0; m < 4; ++m) {
                    const int row = row0 + ai * 128 + m * 16;
                    const f32x4 b = acc[ai][0][m][0], c = acc[ai][0][m][1], hc = acc[ai][1][m][0], zb = acc[ai][1][m][1];
                    const f32x4 uu = c * hc, bz = b * zb * sigm4(zb);
                    u32x2 wu, wb; wu.x = cvt_pk_bf16(uu[0], uu[1]); wu.y = cvt_pk_bf16(uu[2], uu[3]); wb.x = cvt_pk_bf16(bz[0], bz[1]); wb.y = cvt_pk_bf16(bz[2], bz[3]);
                    *(u32x2*)(U + (size_t)row * DM + ch) = wu; *(u32x2*)(BZ + (size_t)row * DM + ch) = wb;
                    if (u.pm >= 64) {
                        if (row == 16510 || row == 16511) *(f32x4*)(out + O_NCP + (size_t)(row - 16510) * DM + ch) = uu;
                        else if (row >= R_SAMPLE && row < R_END && ((row - R_SAMPLE) & 7) >= 6) { const int sr = row - R_SAMPLE; *(f32x4*)(out + O_NCS + ((size_t)(sr >> 3) * 2 + ((sr & 7) - 6)) * DM + ch) = uu; }
                    }
                }
        } else {
            bf16_t* p0 = SZA; bf16_t* p1 = SGA; bf16_t* p2 = SGB;
            asm volatile("" : "+s"(p0), "+s"(p1), "+s"(p2));
            const bool sil = pn < 10;
            bf16_t* base = pn < 10 ? p0 : (pn < 30 ? p1 : p2); const int colt = (pn < 10 ? pn - 6 : (pn < 30 ? pn - 26 : pn - 30)) * 256;
            const int col0 = colt + 32 * wc + 8 * fq;
#pragma unroll
            for (int ai = 0; ai < 2; ++ai)
#pragma unroll
                for (int m = 0; m < 4; ++m) {
                    bf16_t* rowp = base + (size_t)(row0 + ai * 128 + m * 16) * DM + col0;
#pragma unroll
                    for (int bj = 0; bj < 2; ++bj) {
                        const f32x4 v0 = acc[ai][bj][m][0], v1 = acc[ai][bj][m][1];
                        f32x4 s0 = sigm4(v0), s1 = sigm4(v1);
                        if (sil) { s0 = s0 * v0; s1 = s1 * v1; }
                        *(u32x4*)(rowp + bj * 128) = pack8(s0, s1);
                    }
                }
        }
    }
};

struct Epi2 {
    const bf16_t *SGA, *SGB; bf16_t* MIX;
    __device__ __forceinline__ bool keep(const pg8::Unit& u) const { return u.part == 0; }
    __device__ __forceinline__ void operator()(f32x4 (&acc)[2][2][4][2], const pg8::Unit& u, int wr, int wc, int fr, int fq) const {
        const int row0 = u.pm * 256 + wr * 64 + fr, col0 = u.pn * 256 + 32 * wc + 8 * fq;
#pragma unroll
        for (int ai = 0; ai < 2; ++ai)
#pragma unroll
            for (int m = 0; m < 4; ++m) {
                const size_t off = (size_t)(row0 + ai * 128 + m * 16) * DM + col0;
#pragma unroll
                for (int bj = 0; bj < 2; ++bj) {
                    const u32x4 gb = *(const u32x4*)(SGB + off + bj * 128);
                    f32x4 b0 = {bf_lo(gb.x), bf_hi(gb.x), bf_lo(gb.y), bf_hi(gb.y)}, b1 = {bf_lo(gb.z), bf_hi(gb.z), bf_lo(gb.w), bf_hi(gb.w)};
                    if (u.part == 0) {
                        const u32x4 ga = *(const u32x4*)(SGA + off + bj * 128);
                        const f32x4 a0 = {bf_lo(ga.x), bf_hi(ga.x), bf_lo(ga.y), bf_hi(ga.y)}, a1 = {bf_lo(ga.z), bf_hi(ga.z), bf_lo(ga.w), bf_hi(ga.w)};
#pragma unroll
                        for (int e = 0; e < 4; ++e) { acc[ai][bj][m][0][e] *= a0[e] * __builtin_amdgcn_rcpf(b0[e]); acc[ai][bj][m][1][e] *= a1[e] * __builtin_amdgcn_rcpf(b1[e]); }
                    } else {
                        *(u32x4*)(MIX + off + bj * 128) = pack8(acc[ai][bj][m][0] * b0, acc[ai][bj][m][1] * b1);
                    }
                }
            }
    }
};

struct Epi3 {
    const float *xp, *xs; float* y;
    __device__ __forceinline__ bool keep(const pg8::Unit&) const { return false; }
    __device__ __forceinline__ void operator()(f32x4 (&acc)[2][2][4][2], const pg8::Unit& u, int wr, int wc, int fr, int fq) const {
        const int row0 = u.pm * 256 + wr * 64 + fr, col0 = u.pn * 256 + 32 * wc + 8 * fq;
#pragma unroll
        for (int ai = 0; ai < 2; ++ai)
#pragma unroll
            for (int m = 0; m < 4; ++m) {
                const int gr = row0 + ai * 128 + m * 16;
                const float* xr = (gr < 16384 ? xp + (size_t)gr * DM : xs + (size_t)(gr - 16384) * DM) + col0;
                float* yr = y + (size_t)gr * DM + col0;
#pragma unroll
                for (int bj = 0; bj < 2; ++bj)
#pragma unroll
                    for (int n = 0; n < 2; ++n) *(f32x4*)(yr + bj * 128 + 4 * n) = *(const f32x4*)(xr + bj * 128 + 4 * n) + acc[ai][bj][m][n];
            }
    }
};

__device__ __forceinline__ float wave_sum(float v) {
#pragma unroll
    for (int o = 1; o < 64; o <<= 1) v += __shfl_xor(v, o);
    return v;
}
__device__ __forceinline__ int win_orig_col(int n) {
    const int pn = n >> 8, c = n & 255;
    if (pn < 5) { const int bj = c >> 7, wc = (c >> 5) & 3, j = c & 31; return 64 * (4 * pn + wc) + 32 * bj + j; }
    if (pn >= 10 && pn < 26) { const int t = pn - 10, bj = c >> 7, wc = (c >> 5) & 3, fq = (c >> 3) & 3, nn = (c >> 2) & 1, e = c & 3; return 2560 + 1024 * (2 * bj + nn) + 64 * t + 16 * wc + 4 * fq + e; }
    return n;
}
template <bool PERMUTE>
__device__ __forceinline__ void p0_transpose_item(const float* W, int K, int N, bf16_t* WT, LAS float* scr, int item, int lane) {
    const int nblk = N / 32, kb = item / nblk, nb = item % nblk, k0 = 64 * kb, n0 = 32 * nb;
    const int ncol = PERMUTE ? win_orig_col(n0 + (lane & 31)) : n0 + (lane & 31);
#pragma unroll 8
    for (int i = 0; i < 32; ++i) { const int kk = 2 * i + (lane >> 5); scr[kk * 33 + (lane & 31)] = W[(size_t)(k0 + kk) * N + ncol]; }
    asm volatile("s_waitcnt lgkmcnt(0)" ::: "memory");
    const int c = lane & 7;
#pragma unroll
    for (int j = 0; j < 4; ++j) { const int n = (lane >> 3) + 8 * j; const LAS float* s = scr + (8 * c) * 33 + n;
        u32x4 o; o.x = cvt_pk_bf16(s[0 * 33], s[1 * 33]); o.y = cvt_pk_bf16(s[2 * 33], s[3 * 33]); o.z = cvt_pk_bf16(s[4 * 33], s[5 * 33]); o.w = cvt_pk_bf16(s[6 * 33], s[7 * 33]);
        *(u32x4*)(WT + (size_t)(n0 + n) * K + k0 + 8 * c) = o; }
    asm volatile("s_waitcnt lgkmcnt(0)" ::: "memory");
}

struct Args { const float* in[15]; float* out; unsigned char* ws; int ph_lo, ph_hi; };

__device__ __forceinline__ void p0_prologue(const Args& a, LAS unsigned char* lds, int tid, int lane, int wave, int G) {
    LAS float* scr = (LAS float*)(lds + wave * 16384);
    const int gw = blockIdx.x * 8 + wave, NGW = G * 8;
    bf16_t* WIN = (bf16_t*)(a.ws + WS_WIN); bf16_t* WA = (bf16_t*)(a.ws + WS_WA); bf16_t* WB = (bf16_t*)(a.ws + WS_WB); bf16_t* WO = (bf16_t*)(a.ws + WS_WO);
    constexpr int I_IN = 16 * (NIN / 32), I_SQ = 16 * 32, NITEMS = I_IN + 3 * I_SQ;
    for (int it = gw; it < NITEMS; it += NGW) {
        int r = it;
        if (r < I_IN) { p0_transpose_item<true>(a.in[7], DM, NIN, WIN, scr, r, lane); continue; } r -= I_IN;
        if (r < I_SQ) { p0_transpose_item<false>(a.in[12], DM, DM, WA, scr, r, lane); continue; } r -= I_SQ;
        if (r < I_SQ) { p0_transpose_item<false>(a.in[13], DM, DM, WB, scr, r, lane); continue; } r -= I_SQ;
        p0_transpose_item<false>(a.in[14], DM, DM, WO, scr, r, lane);
    }
    bf16_t* XN = (bf16_t*)(a.ws + WS_B0);
    const f32x4* nwp = (const f32x4*)a.in[6] + lane;
    f32x4 nw[4];
#pragma unroll
    for (int j = 0; j < 4; ++j) nw[j] = nwp[64 * j];
    for (int m = gw; m < MROWS; m += NGW) {
        unsigned long long* o8 = (unsigned long long*)(XN + (size_t)m * DM) + lane;
        const float* src = nullptr;
        if (m >= R_PROMPT && m < R_SAMPLE) src = a.in[0] + (size_t)(m - R_PROMPT) * DM;
        else if (m >= R_SAMPLE && m < R_END) src = a.in[1] + (size_t)(m - R_SAMPLE) * DM;
        else if (m >= R_META && m < R_PROMPT) src = a.in[5] + (size_t)(m - R_META) * DM;
        if (!src) {
#pragma unroll
            for (int j = 0; j < 4; ++j) o8[64 * j] = 0ull;
            continue;
        }
        const f32x4* xr = (const f32x4*)src + lane;
        f32x4 v[4]; float s = 0.f;
#pragma unroll
        for (int j = 0; j < 4; ++j) { v[j] = xr[64 * j]; s += (v[j].x * v[j].x + v[j].y * v[j].y) + (v[j].z * v[j].z + v[j].w * v[j].w); }
        const float r = 1.0f / sqrtf(wave_sum(s) * (1.f / DM) + EPS);
#pragma unroll
        for (int j = 0; j < 4; ++j) { const f32x4 y = v[j] * r * nw[j]; o8[64 * j] = (unsigned long long)cvt_pk_bf16(y.x, y.y) | ((unsigned long long)cvt_pk_bf16(y.z, y.w) << 32); }
    }
    float* rope = (float*)(a.ws + WS_ROPE);
    for (int i = blockIdx.x * 512 + tid; i < NPOS * 32; i += G * 512) {
        const int pos = i >> 5, j = i & 31;
        double invd = 1.0; for (int q = 0; q < j; ++q) invd *= 0.74989420933245582730;
        const float inv = (float)invd; const float angf = (float)pos * inv; const double ang = (double)angf;
        const double kq = __builtin_rint(ang * 0.63661977236758134308); const int qi = (int)kq;
        double rr = __builtin_fma(-kq, 1.57079632679489655800, ang); rr = __builtin_fma(-kq, 6.12323399573676603587e-17, rr);
        const double r2 = rr * rr;
        double sn = r2 * (1.0 / 6227020800.0) - (1.0 / 39916800.0); sn = sn * r2 + (1.0 / 362880.0); sn = sn * r2 - (1.0 / 5040.0); sn = sn * r2 + (1.0 / 120.0); sn = sn * r2 - (1.0 / 6.0); sn = sn * r2 * rr + rr;
        double cs = r2 * (1.0 / 479001600.0) - (1.0 / 3628800.0); cs = cs * r2 + (1.0 / 40320.0); cs = cs * r2 - (1.0 / 720.0); cs = cs * r2 + (1.0 / 24.0); cs = cs * r2 - 0.5; cs = cs * r2 + 1.0;
        double so, co;
        switch (qi & 3) { case 0: so = sn; co = cs; break; case 1: so = cs; co = -sn; break; case 2: so = -sn; co = -cs; break; default: so = -cs; co = sn; break; }
        rope[(size_t)pos * 64 + j] = (float)co; rope[(size_t)pos * 64 + 32 + j] = (float)so;
    }
}

__device__ __forceinline__ int crow(int r, int hi) { return (r & 3) + 8 * (r >> 2) + 4 * hi; }
__device__ __forceinline__ bf16x8 packp(const f32x16& p, int s) {
    u32x4 w; w.x = cvt_pk_bf16(p[8 * s + 0], p[8 * s + 1]); w.y = cvt_pk_bf16(p[8 * s + 2], p[8 * s + 3]); w.z = cvt_pk_bf16(p[8 * s + 4], p[8 * s + 5]); w.w = cvt_pk_bf16(p[8 * s + 6], p[8 * s + 7]);
    return __builtin_bit_cast(bf16x8, w);
}
__device__ __forceinline__ float sink_softmax5(f32x16 (&S)[5], int qcmp, int hi, float sink2, int minkr) {
    const float NEG = -INFINITY;
#pragma unroll
    for (int r = 0; r < 16; ++r) { const int c = crow(r, hi); if (c < qcmp) S[0][r] = NEG; if (c > qcmp) S[4][r] = NEG; }
    if (minkr > 0) {
#pragma unroll
        for (int kb = 0; kb < 5; ++kb)
#pragma unroll
            for (int r = 0; r < 16; ++r) if (32 * kb + crow(r, hi) < minkr) S[kb][r] = NEG;
    }
    float m = sink2;
#pragma unroll
    for (int kb = 0; kb < 5; ++kb)
#pragma unroll
        for (int r = 0; r < 16; ++r) m = fmaxf(m, S[kb][r]);
    m = fmaxf(m, __shfl_xor(m, 32));
    float l = 0.f;
#pragma unroll
    for (int kb = 0; kb < 5; ++kb)
#pragma unroll
        for (int r = 0; r < 16; ++r) { const float p = __builtin_amdgcn_exp2f(S[kb][r] - m); S[kb][r] = p; l += p; }
    l += __shfl_xor(l, 32);
    l += __builtin_amdgcn_exp2f(sink2 - m);
    return 1.0f / l;
}
__device__ __forceinline__ void attn_store(const f32x16 (&O)[2], float inv_l, int row, int head, int hi, const bf16_t* SZA, bf16_t* QA) {
#pragma unroll
    for (int blk = 0; blk < 2; ++blk)
#pragma unroll
        for (int rr = 0; rr < 4; ++rr) {
            const size_t off = (size_t)row * DM + 64 * head + 32 * blk + 8 * rr + 4 * hi;
            const u32x2 z = *(const u32x2*)(SZA + off);
            u32x2 w; w.x = cvt_pk_bf16(O[blk][4 * rr] * inv_l * bf_lo(z.x), O[blk][4 * rr + 1] * inv_l * bf_hi(z.x)); w.y = cvt_pk_bf16(O[blk][4 * rr + 2] * inv_l * bf_lo(z.y), O[blk][4 * rr + 3] * inv_l * bf_hi(z.y));
            *(u32x2*)(QA + off) = w;
        }
}

__device__ __forceinline__ void attn_prompt_unit(LAS unsigned char* lds, int tid, int id, const bf16_t* Kb, const bf16_t* Vt, bf16_t* QA, const bf16_t* SZA, const float* sinks) {
    const int lane = tid & 63, wid = __builtin_amdgcn_readfirstlane(tid >> 6), ql = lane & 31, hi = lane >> 5;
    const int n = 1 + (id >> 3), g = (id >> 1) & 3, half = id & 1;
    const int kbase = 128 * (n - 1) + 64 * half;
    LAS unsigned char* Ks = lds; LAS unsigned char* Vs = lds + 27648;
#pragma unroll
    for (int i = 0; i < 3; ++i) {
        const int ch = tid + 512 * i;
        { const int row = ch >> 3, c = ch & 7; const u32x4 v = *(const u32x4*)(Kb + (size_t)(kbase + row) * 256 + g * 64 + c * 8); *(LAS u32x4*)(Ks + row * 144 + c * 16) = v; }
        { const int d = ch / 24, c = ch - d * 24; const u32x4 v = *(const u32x4*)(Vt + (size_t)(g * 64 + d) * MROWS + kbase + c * 8);
          LAS u32x2* p = (LAS u32x2*)(Vs + d * 392 + c * 16); p[0] = (u32x2){v.x, v.y}; p[1] = (u32x2){v.z, v.w}; }
    }
    const int hq = 4 * g + (wid >> 1), i0 = 32 * (wid & 1);
    const int qrow = kbase + 128 + i0 + ql;
    bf16x8 qr[4];
#pragma unroll
    for (int d0 = 0; d0 < 4; ++d0) qr[d0] = *(const bf16x8*)(QA + (size_t)qrow * DM + 64 * hq + 16 * d0 + 8 * hi);
    const float sink2 = sinks[hq] * LOG2E;
    __syncthreads();
    f32x16 S[5];
#pragma unroll
    for (int kb = 0; kb < 5; ++kb) {
        S[kb] = (f32x16){};
#pragma unroll
        for (int d0 = 0; d0 < 4; ++d0) { const bf16x8 a = *(const LAS bf16x8*)(Ks + (i0 + 32 * kb + ql) * 144 + (16 * d0 + 8 * hi) * 2); S[kb] = __builtin_amdgcn_mfma_f32_32x32x16_bf16(a, qr[d0], S[kb], 0, 0, 0); }
    }
    const float inv_l = sink_softmax5(S, ql, hi, sink2, R_META - (kbase + i0));
    f32x16 O[2]; O[0] = (f32x16){}; O[1] = (f32x16){};
#pragma unroll
    for (int kb = 0; kb < 5; ++kb)
#pragma unroll
        for (int s = 0; s < 2; ++s) {
            const bf16x8 pb = packp(S[kb], s);
#pragma unroll
            for (int blk = 0; blk < 2; ++blk) {
                const LAS unsigned char* vp = Vs + (32 * blk + ql) * 392 + (i0 + 32 * kb + 16 * s + 4 * hi) * 2;
                const u32x2 lo = *(const LAS u32x2*)vp, hh = *(const LAS u32x2*)(vp + 16);
                const u32x4 av = {lo.x, lo.y, hh.x, hh.y};
                O[blk] = __builtin_amdgcn_mfma_f32_32x32x16_bf16(__builtin_bit_cast(bf16x8, av), pb, O[blk], 0, 0, 0);
            }
        }
    attn_store(O, inv_l, qrow, hq, hi, SZA, QA);
    __syncthreads();
}

__device__ __forceinline__ bf16x8 cvt8(const f32x4 a, const f32x4 b) { return __builtin_bit_cast(bf16x8, pack8(a, b)); }

__device__ __forceinline__ void attn_sample_unit(int b, int g, int lane, const float* ck, const float* cv, const bf16_t* Kb, const bf16_t* Vt, bf16_t* QA, const bf16_t* SZA, const float* sinks, float* out) {
    const int ql = lane & 31, hi = lane >> 5, hh = ql >> 3, t = ql & 7;
    const int row = R_SAMPLE + 8 * b + t, head = 4 * g + hh;
    bf16x8 qr[4];
#pragma unroll
    for (int d0 = 0; d0 < 4; ++d0) qr[d0] = *(const bf16x8*)(QA + (size_t)row * DM + 64 * head + 16 * d0 + 8 * hi);
    const float sink2 = sinks[head] * LOG2E;
    const float* ckb = ck + (size_t)b * 128 * 256 + g * 64; const float* cvb = cv + (size_t)b * 128 * 256 + g * 64;
    float* oks = out + O_NKS + (size_t)b * 128 * 256 + g * 64; float* ovs = out + O_NVS + (size_t)b * 128 * 256 + g * 64;
    float m = sink2, l = hi ? 0.f : 1.f;
    f32x16 O[2]; O[0] = (f32x16){}; O[1] = (f32x16){};
    const float NEG = -INFINITY;
#pragma unroll 1
    for (int kb = 0; kb < 5; ++kb) {
        f32x16 S = (f32x16){};
        if (kb < 4) {
            const int s = 32 * kb + ql;
#pragma unroll
            for (int d0 = 0; d0 < 4; ++d0) {
                const float* p = ckb + (size_t)s * 256 + 16 * d0 + 8 * hi; const f32x4 x0 = *(const f32x4*)p, x1 = *(const f32x4*)(p + 4);
                if (s >= 8) { float* o = oks + (size_t)(s - 8) * 256 + 16 * d0 + 8 * hi; *(f32x4*)o = x0; *(f32x4*)(o + 4) = x1; }
                S = __builtin_amdgcn_mfma_f32_32x32x16_bf16(cvt8(x0, x1), qr[d0], S, 0, 0, 0);
            }
        } else {
#pragma unroll
            for (int d0 = 0; d0 < 4; ++d0) {
                u32x4 kv = {0u, 0u, 0u, 0u};
                if (ql < 8) kv = *(const u32x4*)(Kb + (size_t)(R_SAMPLE + 8 * b + ql) * 256 + g * 64 + 16 * d0 + 8 * hi);
                S = __builtin_amdgcn_mfma_f32_32x32x16_bf16(__builtin_bit_cast(bf16x8, kv), qr[d0], S, 0, 0, 0);
            }
        }
        if (kb == 0) {
#pragma unroll
            for (int r = 0; r < 16; ++r) if (crow(r, hi) < t) S[r] = NEG;
        }
        if (kb == 4) {
#pragma unroll
            for (int r = 0; r < 16; ++r) if (crow(r, hi) > t) S[r] = NEG;
        }
        float mb = S[0];
#pragma unroll
        for (int r = 1; r < 16; ++r) mb = fmaxf(mb, S[r]);
        mb = fmaxf(mb, __shfl_xor(mb, 32));
        const float mn = fmaxf(m, mb), alpha = __builtin_amdgcn_exp2f(m - mn); m = mn;
        float ps = 0.f;
#pragma unroll
        for (int r = 0; r < 16; ++r) { const float p = __builtin_amdgcn_exp2f(S[r] - mn); S[r] = p; ps += p; }
        l = l * alpha + ps;
        O[0] = O[0] * alpha; O[1] = O[1] * alpha;
        if (kb < 4) {
#pragma unroll
            for (int s2 = 0; s2 < 2; ++s2) {
                const bf16x8 pb = packp(S, s2);
#pragma unroll
                for (int blk = 0; blk < 2; ++blk) {
                    const int d = 32 * blk + ql;
                    f32x4 v0, v1;
                    const int kk = 32 * kb + 16 * s2 + 4 * hi;
                    const float* vsrc = cvb + (size_t)kk * 256 + d; float* vdst = ovs + (size_t)kk * 256 + d - 8 * 256;
                    v0.x = vsrc[0]; v0.y = vsrc[256]; v0.z = vsrc[512]; v0.w = vsrc[768]; v1.x = vsrc[2048]; v1.y = vsrc[2304]; v1.z = vsrc[2560]; v1.w = vsrc[2816];
                    if (kk >= 8) { vdst[0] = v0.x; vdst[256] = v0.y; vdst[512] = v0.z; vdst[768] = v0.w; }
                    vdst[2048] = v1.x; vdst[2304] = v1.y; vdst[2560] = v1.z; vdst[2816] = v1.w;
                    O[blk] = __builtin_amdgcn_mfma_f32_32x32x16_bf16(cvt8(v0, v1), pb, O[blk], 0, 0, 0);
                }
            }
        } else {
            const bf16x8 pb = packp(S, 0);
#pragma unroll
            for (int blk = 0; blk < 2; ++blk) {
                const int d = 32 * blk + ql;
                const u32x2 lo = *(const u32x2*)(Vt + (size_t)(g * 64 + d) * MROWS + R_SAMPLE + 8 * b + 4 * hi);
                const u32x4 av = {lo.x, lo.y, 0u, 0u};
                O[blk] = __builtin_amdgcn_mfma_f32_32x32x16_bf16(__builtin_bit_cast(bf16x8, av), pb, O[blk], 0, 0, 0);
            }
        }
    }
    l += __shfl_xor(l, 32);
    attn_store(O, 1.0f / l, row, head, hi, SZA, QA);
}

__device__ __forceinline__ void conv_pass(int gtid, int nthr, const bf16_t* U, bf16_t* BZ, const float* cw, const float* state) {
    const int ch = (gtid & 127) * 8;
    float w0[8], w1[8], w2[8];
#pragma unroll
    for (int e = 0; e < 8; ++e) { w0[e] = cw[ch + e]; w1[e] = cw[DM + ch + e]; w2[e] = cw[2 * DM + ch + e]; }
    for (int item = gtid >> 7; item < M23 / 8; item += nthr >> 7) {
        const int r0 = R_PROMPT + 8 * item;
        float um2[8], um1[8];
        if (r0 < R_SAMPLE) {
            const u32x4 a = *(const u32x4*)(U + (size_t)(r0 - 2) * DM + ch), b = *(const u32x4*)(U + (size_t)(r0 - 1) * DM + ch);
            um2[0] = bf_lo(a.x); um2[1] = bf_hi(a.x); um2[2] = bf_lo(a.y); um2[3] = bf_hi(a.y); um2[4] = bf_lo(a.z); um2[5] = bf_hi(a.z); um2[6] = bf_lo(a.w); um2[7] = bf_hi(a.w);
            um1[0] = bf_lo(b.x); um1[1] = bf_hi(b.x); um1[2] = bf_lo(b.y); um1[3] = bf_hi(b.y); um1[4] = bf_lo(b.z); um1[5] = bf_hi(b.z); um1[6] = bf_lo(b.w); um1[7] = bf_hi(b.w);
        } else {
            const float* st = state + (size_t)((r0 - R_SAMPLE) >> 3) * 2 * DM + ch;
#pragma unroll
            for (int e = 0; e < 8; ++e) { um2[e] = st[e]; um1[e] = st[DM + e]; }
        }
#pragma unroll
        for (int i = 0; i < 8; ++i) {
            const size_t off = (size_t)(r0 + i) * DM + ch;
            const u32x4 a = *(const u32x4*)(U + off), z = *(const u32x4*)(BZ + off);
            float uc[8], bz[8], o[8];
            uc[0] = bf_lo(a.x); uc[1] = bf_hi(a.x); uc[2] = bf_lo(a.y); uc[3] = bf_hi(a.y); uc[4] = bf_lo(a.z); uc[5] = bf_hi(a.z); uc[6] = bf_lo(a.w); uc[7] = bf_hi(a.w);
            bz[0] = bf_lo(z.x); bz[1] = bf_hi(z.x); bz[2] = bf_lo(z.y); bz[3] = bf_hi(z.y); bz[4] = bf_lo(z.z); bz[5] = bf_hi(z.z); bz[6] = bf_lo(z.w); bz[7] = bf_hi(z.w);
#pragma unroll
            for (int e = 0; e < 8; ++e) { o[e] = bz[e] * (w0[e] * um2[e] + w1[e] * um1[e] + w2[e] * uc[e]); um2[e] = um1[e]; um1[e] = uc[e]; }
            u32x4 w; w.x = cvt_pk_bf16(o[0], o[1]); w.y = cvt_pk_bf16(o[2], o[3]); w.z = cvt_pk_bf16(o[4], o[5]); w.w = cvt_pk_bf16(o[6], o[7]);
            *(u32x4*)(BZ + off) = w;
        }
    }
}

__global__ void __launch_bounds__(512, 2) hybrid_fwd(Args a) {
    extern __shared__ __attribute__((aligned(16))) unsigned char lds_raw[];
    LAS unsigned char* lds = (LAS unsigned char*)lds_raw;
    const int tid = threadIdx.x, lane = tid & 63, wave = __builtin_amdgcn_readfirstlane(tid >> 6), G = gridDim.x;
    const int lo = a.ph_lo, hi = a.ph_hi;
#define IN(k) (lo <= (k) && (k) < hi)
#define SEAM(k) do { if (IN(k) && IN((k) + 1)) { cg::this_grid().sync(); } } while (0)
    unsigned char* ws = a.ws;
    bf16_t* XN = (bf16_t*)(ws + WS_B0); bf16_t* QA = (bf16_t*)(ws + WS_QA); bf16_t* BZ = (bf16_t*)(ws + WS_BZ); bf16_t* SZA = (bf16_t*)(ws + WS_SZA);
    bf16_t* Ub = (bf16_t*)(ws + WS_U); bf16_t* SGB = (bf16_t*)(ws + WS_SGB); bf16_t* Kb = (bf16_t*)(ws + WS_K); bf16_t* Vt = (bf16_t*)(ws + WS_VT);
    bf16_t* SGA = (bf16_t*)a.out; float* rope = (float*)(ws + WS_ROPE);

    if (IN(0)) { p0_prologue(a, lds, tid, lane, wave, G); }
    SEAM(0);
    if (IN(1)) {
        pg8::Gemm g{XN, (const bf16_t*)(ws + WS_WIN), MROWS, NIN, DM, 0, 0}; pg8::StaticOrder S; S.init(MROWS, NIN, G, (int)blockIdx.x, 1);
        Epi1 E{QA, Kb, Vt, SZA, BZ, Ub, SGA, SGB, rope, a.in[8], a.in[9], a.out};
        pg8::gemm_phase<Epi1>(lds, g, S, E);
    }
    SEAM(1);
    if (IN(2)) {
        for (int id = blockIdx.x; id < 1024; id += G) attn_prompt_unit(lds, tid, id, Kb, Vt, QA, SZA, a.in[10]);
        for (int id = wave * G + blockIdx.x; id < 512; id += 8 * G) attn_sample_unit(id >> 2, id & 3, lane, a.in[2], a.in[3], Kb, Vt, QA, SZA, a.in[10], a.out);
        conv_pass(blockIdx.x * 512 + tid, G * 512, Ub, BZ, a.in[11], a.in[4]);
    }
    SEAM(2);
    if (IN(3)) {
        pg8::Gemm g{QA + (size_t)R_PROMPT * DM, (const bf16_t*)(ws + WS_WA), M23, DM, DM, BUFB, 2097152}; pg8::StaticOrder S; S.init(M23, DM, G, (int)blockIdx.x, 2);
        Epi2 E{SGA + (size_t)R_PROMPT * DM, SGB + (size_t)R_PROMPT * DM, XN};
        pg8::gemm_phase<Epi2>(lds, g, S, E);
    }
    SEAM(3);
    if (IN(4)) {
        pg8::Gemm g{XN, (const bf16_t*)(ws + WS_WO), M23, DM, DM, 0, 0}; pg8::StaticOrder S; S.init(M23, DM, G, (int)blockIdx.x, 1);
        Epi3 E{a.in[0], a.in[1], a.out + O_Y};
        pg8::gemm_phase<Epi3>(lds, g, S, E);
    }
#undef IN
#undef SEAM
}


#ifndef DBG_DUMP
#define DBG_DUMP 0
#endif
__global__ void dbg_dump(const bf16_t* src, float* dst, size_t n) {
    for (size_t i = (size_t)blockIdx.x * blockDim.x + threadIdx.x; i < n; i += (size_t)gridDim.x * blockDim.x) dst[i] = __uint_as_float((unsigned)src[i] << 16);
}
extern "C" void kernel_launch(void* const* d_in, const int* in_sizes, int n_in, void* d_out, int out_size, void* d_ws, size_t ws_size, hipStream_t stream) {
    static int grid = 0;
    if (grid == 0) {
        int dev = 0, cus = 0, per_cu = 0;
        if (n_in != 15 || ws_size < WS_END) { fprintf(stderr, "kernel_launch: unexpected inputs (n_in %d, ws %zu)\n", n_in, ws_size); grid = -1; return; }
        if (hipGetDevice(&dev) != hipSuccess || hipDeviceGetAttribute(&cus, hipDeviceAttributeMultiprocessorCount, dev) != hipSuccess) { grid = -1; return; }
        if (hipFuncSetAttribute((const void*)hybrid_fwd, hipFuncAttributeMaxDynamicSharedMemorySize, LDS_BYTES) != hipSuccess) { fprintf(stderr, "kernel_launch: hipFuncSetAttribute failed\n"); grid = -1; return; }
        if (hipOccupancyMaxActiveBlocksPerMultiprocessor(&per_cu, (const void*)hybrid_fwd, 512, LDS_BYTES) != hipSuccess || per_cu < 1) { fprintf(stderr, "kernel_launch: occupancy query gives %d\n", per_cu); per_cu = 1; }
        (void)hipGetLastError();
        grid = cus * 1;
    }
    if (grid < 0) return;
    Args a{};
    for (int i = 0; i < 15; ++i) a.in[i] = (const float*)d_in[i];
    a.out = (float*)d_out; a.ws = (unsigned char*)d_ws;
#if MK_N_LAUNCHES == 1
    a.ph_lo = 0; a.ph_hi = 5;
    void* args[] = {&a};
    hipError_t e = hipLaunchCooperativeKernel((const void*)hybrid_fwd, dim3(grid), dim3(512), args, LDS_BYTES, stream);
    if (e != hipSuccess) fprintf(stderr, "cooperative launch failed: %s (grid %d)\n", hipGetErrorString(e), grid);
#else
    for (int p = 0; p < DBG_NPH; ++p) {
        a.ph_lo = p; a.ph_hi = p + 1;
        hipLaunchKernelGGL(hybrid_fwd, dim3(grid), dim3(512), LDS_BYTES, stream, a);
    }
#if DBG_DUMP == 1
    hipLaunchKernelGGL(dbg_dump, dim3(1024), dim3(256), 0, stream, (const bf16_t*)((unsigned char*)d_ws + WS_QA) + (size_t)R_PROMPT * DM, (float*)d_out + 9043968, (size_t)M23 * DM - 9043968);
#elif DBG_DUMP == 2
    hipLaunchKernelGGL(dbg_dump, dim3(1024), dim3(256), 0, stream, (const bf16_t*)((unsigned char*)d_ws + WS_BZ) + (size_t)R_PROMPT * DM, (float*)d_out + 9043968, (size_t)M23 * DM - 9043968);
#elif DBG_DUMP == 4
    hipLaunchKernelGGL(dbg_dump, dim3(1024), dim3(256), 0, stream, (const bf16_t*)((unsigned char*)d_ws + WS_SZA) + (size_t)R_PROMPT * DM, (float*)d_out + 9043968, (size_t)M23 * DM - 9043968);
#elif DBG_DUMP == 5
    hipLaunchKernelGGL(dbg_dump, dim3(1024), dim3(256), 0, stream, (const bf16_t*)((unsigned char*)d_ws + WS_K), (float*)d_out + 9043968, (size_t)MROWS * 256 * 2);
#elif DBG_DUMP == 6
    hipLaunchKernelGGL(dbg_dump, dim3(1024), dim3(256), 0, stream, (const bf16_t*)((unsigned char*)d_ws + WS_QA) + (size_t)R_SAMPLE * DM, (float*)d_out + 16777216, (size_t)1024 * DM);
#elif DBG_DUMP == 3
    hipLaunchKernelGGL(dbg_dump, dim3(1024), dim3(256), 0, stream, (const bf16_t*)((unsigned char*)d_ws + WS_B0), (float*)d_out + 9043968, (size_t)M23 * DM - 9043968);
#endif
#endif
}
```

```cpp
#include <hip/hip_runtime.h>
#include <hip/hip_cooperative_groups.h>
#include <cstdio>
#include <cstdint>
namespace cg = cooperative_groups;

#ifndef REP_MASK
#define REP_MASK 0
#endif
#ifndef DBG_NPH
#define DBG_NPH 5
#define DBG_DUMP 0
#endif
#ifndef MK_N_LAUNCHES
#define MK_N_LAUNCHES 1
#endif

#define LAS __attribute__((address_space(3)))
typedef unsigned short bf16_t;
typedef short bf16x8 __attribute__((ext_vector_type(8)));
typedef float f32x4 __attribute__((ext_vector_type(4)));
typedef float f32x16 __attribute__((ext_vector_type(16)));
typedef unsigned u32x4 __attribute__((ext_vector_type(4)));
typedef unsigned u32x2 __attribute__((ext_vector_type(2)));

constexpr int DM = 1024, NIN = 8704;
constexpr int R_META = 112, R_PROMPT = 128, R_SAMPLE = 16512, R_END = 17536, MROWS = 17664;
constexpr int M23 = 17408;
constexpr int NPOS = 16400;
constexpr float EPS = 1e-6f;
constexpr float LOG2E = 1.4426950408889634f;
constexpr float C2 = 0.125f * LOG2E;
constexpr size_t O_Y = 0, O_NKP = 17825792, O_NVP = 17858560, O_NCP = 17891328, O_NKS = 17893376, O_NVS = 22087680, O_NCS = 26281984;
constexpr size_t BUFB = (size_t)MROWS * DM * 2;
constexpr size_t WS_WIN = 0, WS_WA = (size_t)NIN * DM * 2, WS_WB = WS_WA + 2097152, WS_WO = WS_WB + 2097152;
constexpr size_t WS_B0 = 25165824;
constexpr size_t WS_QA = WS_B0 + BUFB, WS_BZ = WS_QA + BUFB, WS_SZA = WS_BZ + BUFB, WS_U = WS_SZA + BUFB, WS_SGB = WS_U + BUFB;
constexpr size_t WS_K = WS_SGB + BUFB, WS_VT = WS_K + (size_t)MROWS * 256 * 2, WS_ROPE = WS_VT + (size_t)MROWS * 256 * 2, WS_END = WS_ROPE + (size_t)NPOS * 64 * 4;
constexpr size_t WS_CTL = 265289728, CTL_BYTES = 65536;
static_assert(WS_END <= WS_CTL && WS_CTL + CTL_BYTES <= 268435456, "d_ws map");

constexpr int LDS_BYTES = 147456;

namespace pg8 {
constexpr int BM = 256, BK = 64, HALF = 128, HTB = HALF * BK * 2, STAGE_BYTES = 8 * HTB, NXCD = 8, WGM = 8;
__host__ __device__ __forceinline__ int lds_byte(int r, int c) { const int st = (r >> 4) * 2 + (c >> 5), rr = r & 15, cc = c & 31, ob = rr * 64 + cc * 2; return st * 1024 + (ob ^ (((ob >> 9) & 1) << 5)); }
__host__ __device__ __forceinline__ void stage_rc(int b, int& R, int& C) { const int st = b / 1024, sb = b % 1024, swz = sb ^ (((sb >> 9) & 1) << 5); R = (st >> 1) * 16 + swz / 64; C = (st & 1) * 32 + (swz % 64) / 2; }
__host__ __device__ __forceinline__ int perm32(int rho) { const int n = rho >> 4, i = rho & 15; return 8 * (i >> 2) + 4 * n + (i & 3); }

struct Unit { int pm, pn, part; };
struct Gemm { const bf16_t* A; const bf16_t* Bt; int M, N, K; size_t partA, partB; };

struct StaticOrder {
    int nM, nN, nwg, G, c, np;
    __host__ __device__ void init(int M, int N, int G_, int c_, int np_) { nM = M / BM; nN = N / BM; nwg = nM * nN; G = G_; c = c_; np = np_; }
    __host__ __device__ bool next(int i, Unit& u) const {
        const int it = (np == 2) ? (i >> 1) : i; u.part = (np == 2) ? (i & 1) : 0;
        const long L = (long)it * G + c; if (L >= nwg) return false;
        int wgid = (int)L; { const int q = nwg / NXCD, r = nwg % NXCD, xcd = wgid % NXCD, off = wgid / NXCD; wgid = (xcd < r ? xcd * (q + 1) : r * (q + 1) + (xcd - r) * q) + off; }
        const int nig = WGM * nN, gid = wgid / nig, fm = gid * WGM, gsz = (nM - fm) < WGM ? (nM - fm) : WGM;
        u.pm = fm + ((wgid % nig) % gsz); u.pn = (wgid % nig) / gsz; return true;
    }
};

typedef float f32x2_t __attribute__((ext_vector_type(2))); typedef __bf16 bf16x2_t __attribute__((ext_vector_type(2)));
__device__ __forceinline__ unsigned cvt_pk_bf16(float lo, float hi) { const f32x2_t v = {lo, hi}; const bf16x2_t b = __builtin_convertvector(v, bf16x2_t); return __builtin_bit_cast(unsigned, b); }

template <class Epi>
__device__ __forceinline__ void gemm_phase(LAS unsigned char* lds, const Gemm g, const StaticOrder& S, const Epi& E) {
    const int tid = threadIdx.x, wid = __builtin_amdgcn_readfirstlane(tid >> 6), lane = tid & 63, wr = wid >> 2, wc = wid & 3, fr = lane & 15, fq = lane >> 4;
    const int K = g.K, nt = K / BK;
    unsigned voffA[2], voffB[2];
#pragma unroll
    for (int i = 0; i < 2; ++i) { int R, C; stage_rc(tid * 16 + i * 8192, R, C); const int Rb = ((R & ~31) + perm32(R & 31));
        voffA[i] = (unsigned)(R * K + C) * 2u; voffB[i] = (unsigned)(Rb * K + C) * 2u; }
    const size_t kstep = (size_t)(BK * 2);
    const size_t hstep = (size_t)HALF * K * 2;
    const size_t tstep = 2 * hstep;
    const unsigned ldsw = (unsigned)wid * 1024u;
    const int aoff = lds_byte(wr * 64 + fr, fq * 8), boff = lds_byte(wc * 32 + fr, fq * 8);
#define PG8_SA(b, h) (((b) * 2 + (h)) * HTB)
#define PG8_SB(b, h) ((4 + (b) * 2 + (h)) * HTB)
#define PG8_STAGE(bufoff, gbase, voff) do { _Pragma("unroll") for (int _i = 0; _i < 2; ++_i) \
        __builtin_amdgcn_global_load_lds((const unsigned*)((const char*)(gbase) + (voff)[_i]), (LAS unsigned*)(lds + (bufoff) + ldsw + _i * 8192), 16, 0, 0); } while (0)
#define PG8_LDA(dst, b, h) do { _Pragma("unroll") for (int m = 0; m < 4; ++m) _Pragma("unroll") for (int k = 0; k < 2; ++k) dst[m][k] = *(const LAS bf16x8*)(lds + PG8_SA(b, h) + aoff + m * 2048 + k * 1024); } while (0)
#define PG8_LDB(dst, b, h) do { _Pragma("unroll") for (int n = 0; n < 2; ++n) _Pragma("unroll") for (int k = 0; k < 2; ++k) dst[n][k] = *(const LAS bf16x8*)(lds + PG8_SB(b, h) + boff + n * 2048 + k * 1024); } while (0)
#define PG8_MMA(ai, bj, At, Bt) do { __builtin_amdgcn_s_setprio(1); _Pragma("unroll") for (int m = 0; m < 4; ++m) _Pragma("unroll") for (int n = 0; n < 2; ++n) _Pragma("unroll") for (int k = 0; k < 2; ++k) \
        acc[ai][bj][m][n] = __builtin_amdgcn_mfma_f32_16x16x32_bf16(Bt[n][k], At[m][k], acc[ai][bj][m][n], 0, 0, 0); __builtin_amdgcn_s_setprio(0); } while (0)
#define PG8_WAIT_V(n) asm volatile("s_waitcnt vmcnt(" #n ")" ::: "memory")
#define PG8_WAIT_L(n) asm volatile("s_waitcnt lgkmcnt(" #n ")" ::: "memory")
#define PG8_BAR __builtin_amdgcn_s_barrier()
#define PG8_SCHED __builtin_amdgcn_sched_barrier(0)
    Unit cur, nxt; int ui = 0;
    if (!S.next(0, cur)) return;
    f32x4 acc[2][2][4][2];
#pragma unroll
    for (int a = 0; a < 2; ++a)
#pragma unroll
        for (int b = 0; b < 2; ++b)
#pragma unroll
            for (int m = 0; m < 4; ++m)
#pragma unroll
                for (int n = 0; n < 2; ++n) acc[a][b][m][n] = (f32x4){0.f, 0.f, 0.f, 0.f};
    bf16x8 At[4][2], B0[2][2], B1[2][2];
    const char* cA = (const char*)g.A + (size_t)cur.pm * tstep + (size_t)cur.part * g.partA; const char* cB = (const char*)g.Bt + (size_t)cur.pn * tstep + (size_t)cur.part * g.partB;
    PG8_STAGE(PG8_SB(0, 0), cB, voffB); PG8_STAGE(PG8_SB(0, 1), cB + hstep, voffB); PG8_STAGE(PG8_SA(0, 0), cA, voffA); PG8_STAGE(PG8_SA(0, 1), cA + hstep, voffA);
    if (wr == 1) PG8_BAR;
    PG8_WAIT_V(2); PG8_BAR;
    PG8_STAGE(PG8_SB(1, 0), cB + kstep, voffB); PG8_STAGE(PG8_SA(1, 0), cA + kstep, voffA); PG8_STAGE(PG8_SB(1, 1), cB + hstep + kstep, voffB);
    PG8_WAIT_V(6); PG8_BAR;
    for (;;) {
        const bool has_next = S.next(ui + 1, nxt);
        const char* nA = has_next ? (const char*)g.A + (size_t)nxt.pm * tstep + (size_t)nxt.part * g.partA : cA; const char* nB = has_next ? (const char*)g.Bt + (size_t)nxt.pn * tstep + (size_t)nxt.part * g.partB : cB;
        for (int t = 0; t < nt; t += 2) {
            const bool last = (t == nt - 2);
            const char* a1 = cA + (size_t)(t + 1) * kstep;
            const char* a2 = last ? nA : cA + (size_t)(t + 2) * kstep; const char* b2 = last ? nB : cB + (size_t)(t + 2) * kstep;
            const char* a3 = a2 + kstep; const char* b3 = b2 + kstep;
            PG8_LDB(B0, 0, 0); PG8_LDB(B1, 0, 1); PG8_SCHED; PG8_LDA(At, 0, 0); PG8_STAGE(PG8_SA(1, 1), a1 + hstep, voffA);
            PG8_WAIT_V(8); PG8_WAIT_L(0); PG8_BAR; PG8_MMA(0, 0, At, B0); PG8_MMA(0, 1, At, B1); PG8_BAR; PG8_SCHED;
            PG8_LDA(At, 0, 1); PG8_STAGE(PG8_SB(0, 0), b2, voffB); PG8_STAGE(PG8_SB(0, 1), b2 + hstep, voffB); PG8_STAGE(PG8_SA(0, 0), a2, voffA);
            PG8_WAIT_V(8); PG8_WAIT_L(0); PG8_BAR; PG8_MMA(1, 0, At, B0); PG8_MMA(1, 1, At, B1); PG8_BAR; PG8_SCHED;
            PG8_LDB(B0, 1, 0); PG8_LDB(B1, 1, 1); PG8_SCHED; PG8_LDA(At, 1, 0); PG8_STAGE(PG8_SA(0, 1), a2 + hstep, voffA);
            PG8_WAIT_V(8); PG8_WAIT_L(0); PG8_BAR; PG8_MMA(0, 0, At, B0); PG8_MMA(0, 1, At, B1); PG8_BAR; PG8_SCHED;
            PG8_LDA(At, 1, 1); PG8_STAGE(PG8_SB(1, 0), b3, voffB); PG8_STAGE(PG8_SB(1, 1), b3 + hstep, voffB); PG8_STAGE(PG8_SA(1, 0), a3, voffA);
            PG8_WAIT_V(8); PG8_WAIT_L(0); PG8_BAR; PG8_MMA(1, 0, At, B0); PG8_MMA(1, 1, At, B1); PG8_BAR; PG8_SCHED;
        }
        if (wr == 0) PG8_BAR;
        E(acc, cur, wr, wc, fr, fq);
        if (!has_next) break;
        if (!E.keep(cur)) {
#pragma unroll
        for (int a = 0; a < 2; ++a)
#pragma unroll
            for (int b = 0; b < 2; ++b)
#pragma unroll
                for (int m = 0; m < 4; ++m)
#pragma unroll
                    for (int n = 0; n < 2; ++n) acc[a][b][m][n] = (f32x4){0.f, 0.f, 0.f, 0.f};
        }
        cur = nxt; cA = nA; cB = nB; ++ui;
        if (wr == 1) PG8_BAR;
    }
    PG8_WAIT_V(0);
    PG8_BAR;
#undef PG8_SA
#undef PG8_SB
#undef PG8_STAGE
#undef PG8_LDA
#undef PG8_LDB
#undef PG8_MMA
#undef PG8_WAIT_V
#undef PG8_WAIT_L
#undef PG8_BAR
#undef PG8_SCHED
}
}
using pg8::cvt_pk_bf16;

__device__ __forceinline__ float bf_lo(unsigned u) { return __uint_as_float(u << 16); }
__device__ __forceinline__ float bf_hi(unsigned u) { return __uint_as_float(u & 0xffff0000u); }
__device__ __forceinline__ float sigm_f(float x) { return __builtin_amdgcn_rcpf(1.f + __builtin_amdgcn_exp2f(-LOG2E * x)); }
__device__ __forceinline__ float silu_f(float x) { return x * sigm_f(x); }
__device__ __forceinline__ f32x4 sigm4(const f32x4 v) { f32x4 r; r.x = sigm_f(v.x); r.y = sigm_f(v.y); r.z = sigm_f(v.z); r.w = sigm_f(v.w); return r; }
__device__ __forceinline__ int rowpos(int row) { return row < R_SAMPLE ? (row > R_META ? row - R_META : 0) : (row < R_END ? 16384 + ((row - R_SAMPLE) & 7) : 0); }
__device__ __forceinline__ u32x4 pack8(const f32x4 a, const f32x4 b) { u32x4 w; w.x = cvt_pk_bf16(a[0], a[1]); w.y = cvt_pk_bf16(a[2], a[3]); w.z = cvt_pk_bf16(b[0], b[1]); w.w = cvt_pk_bf16(b[2], b[3]); return w; }

struct Epi1 {
    bf16_t *Q, *Kb, *Vt, *SZA, *BZ, *U, *SGA, *SGB; const float *rope, *qnw, *knw; float* out;
    __device__ __forceinline__ bool keep(const pg8::Unit&) const { return false; }
    __device__ __forceinline__ void operator()(f32x4 (&acc)[2][2][4][2], const pg8::Unit& u, int wr, int wc, int fr, int fq) const {
        const int pn = u.pn, row0 = u.pm * 256 + wr * 64 + fr;
        if (pn < 5) {
            const bool isq = pn < 4; const float* nw = isq ? qnw : knw;
            f32x4 w[2][2];
#pragma unroll
            for (int bj = 0; bj < 2; ++bj)
#pragma unroll
                for (int n = 0; n < 2; ++n) w[bj][n] = *(const f32x4*)(nw + 32 * bj + 8 * fq + 4 * n);
            const float sc = isq ? C2 : 1.f;
#pragma unroll
            for (int ai = 0; ai < 2; ++ai)
#pragma unroll
                for (int m = 0; m < 4; ++m) {
                    const int row = row0 + ai * 128 + m * 16;
                    float ss = 0.f;
#pragma unroll
                    for (int bj = 0; bj < 2; ++bj)
#pragma unroll
                        for (int n = 0; n < 2; ++n) { const f32x4 x = acc[ai][bj][m][n]; ss += (x[0] * x[0] + x[1] * x[1]) + (x[2] * x[2] + x[3] * x[3]); }
                    ss += __shfl_xor(ss, 16); ss += __shfl_xor(ss, 32);
                    const float rinv = 1.0f / sqrtf(ss * (1.f / 64.f) + EPS);
                    const float* rp = rope + (size_t)rowpos(row) * 64 + 8 * fq;
                    f32x4 o1[2], o2[2];
#pragma unroll
                    for (int n = 0; n < 2; ++n) {
                        const f32x4 cs = *(const f32x4*)(rp + 4 * n), sn = *(const f32x4*)(rp + 32 + 4 * n);
                        const f32x4 x1 = acc[ai][0][m][n] * rinv * w[0][n], x2 = acc[ai][1][m][n] * rinv * w[1][n];
                        o1[n] = (x1 * cs - x2 * sn) * sc; o2[n] = (x2 * cs + x1 * sn) * sc;
                    }
                    if (isq) {
                        bf16_t* p = Q + (size_t)row * DM + 64 * (4 * pn + wc) + 8 * fq;
                        *(u32x4*)p = pack8(o1[0], o1[1]); *(u32x4*)(p + 32) = pack8(o2[0], o2[1]);
                    } else {
                        bf16_t* p = Kb + (size_t)row * 256 + 64 * wc + 8 * fq;
                        *(u32x4*)p = pack8(o1[0], o1[1]); *(u32x4*)(p + 32) = pack8(o2[0], o2[1]);
                        if (u.pm >= 64) {
                            float* d = nullptr;
                            if (row >= 16384 && row < R_SAMPLE) d = out + O_NKP + (size_t)(row - 16384) * 256;
                            else if (row >= R_SAMPLE && row < R_END) { const int sr = row - R_SAMPLE; d = out + O_NKS + ((size_t)(sr >> 3) * 128 + 120 + (sr & 7)) * 256; }
                            if (d) { d += 64 * wc + 8 * fq; *(f32x4*)d = o1[0]; *(f32x4*)(d + 4) = o1[1]; *(f32x4*)(d + 32) = o2[0]; *(f32x4*)(d + 36) = o2[1]; }
                        }
                    }
                }
        } else if (pn == 5) {
#pragma unroll
            for (int ai = 0; ai < 2; ++ai)
#pragma unroll
                for (int m = 0; m < 4; ++m) {
                    const int row = row0 + ai * 128 + m * 16;
                    float* d = nullptr;
                    if (u.pm >= 64) {
                        if (row >= 16384 && row < R_SAMPLE) d = out + O_NVP + (size_t)(row - 16384) * 256;
                        else if (row >= R_SAMPLE && row < R_END) { const int sr = row - R_SAMPLE; d = out + O_NVS + ((size_t)(sr >> 3) * 128 + 120 + (sr & 7)) * 256; }
                    }
#pragma unroll
                    for (int bj = 0; bj < 2; ++bj)
#pragma unroll
                        for (int n = 0; n < 2; ++n) {
                            const int c = 128 * bj + 32 * wc + 8 * fq + 4 * n; const f32x4 x = acc[ai][bj][m][n];
                            const unsigned p0 = cvt_pk_bf16(x[0], x[1]), p1 = cvt_pk_bf16(x[2], x[3]);
                            bf16_t* vp = Vt + (size_t)c * MROWS + row;
                            vp[0] = (bf16_t)(p0 & 0xffffu); vp[MROWS] = (bf16_t)(p0 >> 16); vp[2 * (size_t)MROWS] = (bf16_t)(p1 & 0xffffu); vp[3 * (size_t)MROWS] = (bf16_t)(p1 >> 16);
                            if (d) *(f32x4*)(d + c) = x;
                        }
                }
        } else if (pn >= 10 && pn < 26) {
            const int ch = 64 * (pn - 10) + 16 * wc + 4 * fq;
#pragma unroll
            for (int ai = 0; ai < 2; ++ai)
#pragma unroll
                for (int m = 0; m < 4; ++m) {
                    const int row = row0 + ai * 128 + m * 16;
                    const f32x4 b = acc[ai][0][m][0], c = acc[ai][0][m][1], hc = acc[ai][1][m][0], zb = acc[ai][1][m][1];
                    const f32x4 uu = c * hc, bz = b * zb * sigm4(zb);
                    u32x2 wu, wb; wu.x = cvt_pk_bf16(uu[0], uu[1]); wu.y = cvt_pk_bf16(uu[2], uu[3]); wb.x = cvt_pk_bf16(bz[0], bz[1]); wb.y = cvt_pk_bf16(bz[2], bz[3]);
                    *(u32x2*)(U + (size_t)row * DM + ch) = wu; *(u32x2*)(BZ + (size_t)row * DM + ch) = wb;
                    if (u.pm >= 64) {
                        if (row == 16510 || row == 16511) *(f32x4*)(out + O_NCP + (size_t)(row - 16510) * DM + ch) = uu;
                        else if (row >= R_SAMPLE && row < R_END && ((row - R_SAMPLE) & 7) >= 6) { const int sr = row - R_SAMPLE; *(f32x4*)(out + O_NCS + ((size_t)(sr >> 3) * 2 + ((sr & 7) - 6)) * DM + ch) = uu; }
                    }
                }
        } else {
            bf16_t* p0 = SZA; bf16_t* p1 = SGA; bf16_t* p2 = SGB;
            asm volatile("" : "+s"(p0), "+s"(p1), "+s"(p2));
            const bool sil = pn < 10;
            bf16_t* base = pn < 10 ? p0 : (pn < 30 ? p1 : p2); const int colt = (pn < 10 ? pn - 6 : (pn < 30 ? pn - 26 : pn - 30)) * 256;
            const int col0 = colt + 32 * wc + 8 * fq;
#pragma unroll
            for (int ai = 0; ai < 2; ++ai)
#pragma unroll
                for (int m = 0; m < 4; ++m) {
                    bf16_t* rowp = base + (size_t)(row0 + ai * 128 + m * 16) * DM + col0;
#pragma unroll
                    for (int bj = 0; bj < 2; ++bj) {
                        const f32x4 v0 = acc[ai][bj][m][0], v1 = acc[ai][bj][m][1];
                        f32x4 s0 = sigm4(v0), s1 = sigm4(v1);
                        if (sil) { s0 = s0 * v0; s1 = s1 * v1; }
                        *(u32x4*)(rowp + bj * 128) = pack8(s0, s1);
                    }
                }
        }
    }
};

struct Epi2 {
    const bf16_t *SGA, *SGB; bf16_t* MIX;
    __device__ __forceinline__ bool keep(const pg8::Unit& u) const { return u.part == 0; }
    __device__ __forceinline__ void operator()(f32x4 (&acc)[2][2][4][2], const pg8::Unit& u, int wr, int wc, int fr, int fq) const {
        const int row0 = u.pm * 256 + wr * 64 + fr, col0 = u.pn * 256 + 32 * wc + 8 * fq;
#pragma unroll
        for (int ai = 0; ai < 2; ++ai)
#pragma unroll
            for (int m = 0; m < 4; ++m) {
                const size_t off = (size_t)(row0 + ai * 128 + m * 16) * DM + col0;
#pragma unroll
                for (int bj = 0; bj < 2; ++bj) {
                    const u32x4 gb = *(const u32x4*)(SGB + off + bj * 128);
                    f32x4 b0 = {bf_lo(gb.x), bf_hi(gb.x), bf_lo(gb.y), bf_hi(gb.y)}, b1 = {bf_lo(gb.z), bf_hi(gb.z), bf_lo(gb.w), bf_hi(gb.w)};
                    if (u.part == 0) {
                        const u32x4 ga = *(const u32x4*)(SGA + off + bj * 128);
                        const f32x4 a0 = {bf_lo(ga.x), bf_hi(ga.x), bf_lo(ga.y), bf_hi(ga.y)}, a1 = {bf_lo(ga.z), bf_hi(ga.z), bf_lo(ga.w), bf_hi(ga.w)};
#pragma unroll
                        for (int e = 0; e < 4; ++e) { acc[ai][bj][m][0][e] *= a0[e] * __builtin_amdgcn_rcpf(b0[e]); acc[ai][bj][m][1][e] *= a1[e] * __builtin_amdgcn_rcpf(b1[e]); }
                    } else {
                        *(u32x4*)(MIX + off + bj * 128) = pack8(acc[ai][bj][m][0] * b0, acc[ai][bj][m][1] * b1);
                    }
                }
            }
    }
};

struct Epi3 {
    const float *xp, *xs; float* y;
    __device__ __forceinline__ bool keep(const pg8::Unit&) const { return false; }
    __device__ __forceinline__ void operator()(f32x4 (&acc)[2][2][4][2], const pg8::Unit& u, int wr, int wc, int fr, int fq) const {
        const int row0 = u.pm * 256 + wr * 64 + fr, col0 = u.pn * 256 + 32 * wc + 8 * fq;
#pragma unroll
        for (int ai = 0; ai < 2; ++ai)
#pragma unroll
            for (int m = 0; m < 4; ++m) {
                const int gr = row0 + ai * 128 + m * 16;
                const float* xr = (gr < 16384 ? xp + (size_t)gr * DM : xs + (size_t)(gr - 16384) * DM) + col0;
                float* yr = y + (size_t)gr * DM + col0;
#pragma unroll
                for (int bj = 0; bj < 2; ++bj)
#pragma unroll
                    for (int n = 0; n < 2; ++n) *(f32x4*)(yr + bj * 128 + 4 * n) = *(const f32x4*)(xr + bj * 128 + 4 * n) + acc[ai][bj][m][n];
            }
    }
};

__device__ __forceinline__ float wave_sum(float v) {
#pragma unroll
    for (int o = 1; o < 64; o <<= 1) v += __shfl_xor(v, o);
    return v;
}
__device__ __forceinline__ int win_orig_col(int n) {
    const int pn = n >> 8, c = n & 255;
    if (pn < 5) { const int bj = c >> 7, wc = (c >> 5) & 3, j = c & 31; return 64 * (4 * pn + wc) + 32 * bj + j; }
    if (pn >= 10 && pn < 26) { const int t = pn - 10, bj = c >> 7, wc = (c >> 5) & 3, fq = (c >> 3) & 3, nn = (c >> 2) & 1, e = c & 3; return 2560 + 1024 * (2 * bj + nn) + 64 * t + 16 * wc + 4 * fq + e; }
    return n;
}
template <bool PERMUTE>
__device__ __forceinline__ void p0_transpose_item(const float* W, int K, int N, bf16_t* WT, LAS float* scr, int item, int lane) {
    const int nblk = N / 32, kb = item / nblk, nb = item % nblk, k0 = 64 * kb, n0 = 32 * nb;
    const int ncol = PERMUTE ? win_orig_col(n0 + (lane & 31)) : n0 + (lane & 31);
    float tv[32];
#pragma unroll
    for (int i = 0; i < 32; ++i) tv[i] = W[(size_t)(k0 + 2 * i + (lane >> 5)) * N + ncol];
#pragma unroll
    for (int i = 0; i < 32; ++i) scr[(2 * i + (lane >> 5)) * 33 + (lane & 31)] = tv[i];
    asm volatile("s_waitcnt lgkmcnt(0)" ::: "memory");
    const int c = lane & 7;
#pragma unroll
    for (int j = 0; j < 4; ++j) { const int n = (lane >> 3) + 8 * j; const LAS float* s = scr + (8 * c) * 33 + n;
        u32x4 o; o.x = cvt_pk_bf16(s[0 * 33], s[1 * 33]); o.y = cvt_pk_bf16(s[2 * 33], s[3 * 33]); o.z = cvt_pk_bf16(s[4 * 33], s[5 * 33]); o.w = cvt_pk_bf16(s[6 * 33], s[7 * 33]);
        *(u32x4*)(WT + (size_t)(n0 + n) * K + k0 + 8 * c) = o; }
    asm volatile("s_waitcnt lgkmcnt(0)" ::: "memory");
}

struct Args { const float* in[15]; float* out; unsigned char* ws; int ph_lo, ph_hi; };

__device__ __forceinline__ void p0_prologue(const Args& a, LAS unsigned char* lds, int tid, int lane, int wave, int G) {
    LAS float* scr = (LAS float*)(lds + wave * 16384);
    const int gw = blockIdx.x * 8 + wave, NGW = G * 8;
    bf16_t* WIN = (bf16_t*)(a.ws + WS_WIN); bf16_t* WA = (bf16_t*)(a.ws + WS_WA); bf16_t* WB = (bf16_t*)(a.ws + WS_WB); bf16_t* WO = (bf16_t*)(a.ws + WS_WO);
    constexpr int I_IN = 16 * (NIN / 32), I_SQ = 16 * 32, NITEMS = I_IN + 3 * I_SQ;
    for (int it = gw; it < NITEMS; it += NGW) {
        int r = it;
        if (r < I_IN) { p0_transpose_item<true>(a.in[7], DM, NIN, WIN, scr, r, lane); continue; } r -= I_IN;
        if (r < I_SQ) { p0_transpose_item<false>(a.in[12], DM, DM, WA, scr, r, lane); continue; } r -= I_SQ;
        if (r < I_SQ) { p0_transpose_item<false>(a.in[13], DM, DM, WB, scr, r, lane); continue; } r -= I_SQ;
        p0_transpose_item<false>(a.in[14], DM, DM, WO, scr, r, lane);
    }
    bf16_t* XN = (bf16_t*)(a.ws + WS_B0);
    const f32x4* nwp = (const f32x4*)a.in[6] + lane;
    f32x4 nw[4];
#pragma unroll
    for (int j = 0; j < 4; ++j) nw[j] = nwp[64 * j];
    for (int m0 = gw; m0 < MROWS; m0 += 4 * NGW) {
        const float* src[4]; f32x4 v[4][4];
#pragma unroll
        for (int q = 0; q < 4; ++q) {
            const int m = m0 + q * NGW; src[q] = nullptr;
            if (m >= R_PROMPT && m < R_SAMPLE) src[q] = a.in[0] + (size_t)(m - R_PROMPT) * DM;
            else if (m >= R_SAMPLE && m < R_END) src[q] = a.in[1] + (size_t)(m - R_SAMPLE) * DM;
            else if (m >= R_META && m < R_PROMPT) src[q] = a.in[5] + (size_t)(m - R_META) * DM;
#pragma unroll
            for (int j = 0; j < 4; ++j) v[q][j] = src[q] ? ((const f32x4*)src[q] + lane)[64 * j] : (f32x4){0.f, 0.f, 0.f, 0.f};
        }
#pragma unroll
        for (int q = 0; q < 4; ++q) {
            const int m = m0 + q * NGW;
            if (m < MROWS) {
                float s2 = 0.f;
#pragma unroll
                for (int j = 0; j < 4; ++j) s2 += (v[q][j].x * v[q][j].x + v[q][j].y * v[q][j].y) + (v[q][j].z * v[q][j].z + v[q][j].w * v[q][j].w);
                const float r = 1.0f / sqrtf(wave_sum(s2) * (1.f / DM) + EPS);
                unsigned long long* o8 = (unsigned long long*)(XN + (size_t)m * DM) + lane;
#pragma unroll
                for (int j = 0; j < 4; ++j) { const f32x4 y = v[q][j] * r * nw[j]; o8[64 * j] = (unsigned long long)cvt_pk_bf16(y.x, y.y) | ((unsigned long long)cvt_pk_bf16(y.z, y.w) << 32); }
            }
        }
    }
    float* rope = (float*)(a.ws + WS_ROPE);
    for (int i = blockIdx.x * 512 + tid; i < NPOS * 32; i += G * 512) {
        const int pos = i >> 5, j = i & 31;
        double invd = 1.0; for (int q = 0; q < j; ++q) invd *= 0.74989420933245582730;
        const float inv = (float)invd; const float angf = (float)pos * inv; const double ang = (double)angf;
        const double kq = __builtin_rint(ang * 0.63661977236758134308); const int qi = (int)kq;
        double rr = __builtin_fma(-kq, 1.57079632679489655800, ang); rr = __builtin_fma(-kq, 6.12323399573676603587e-17, rr);
        const double r2 = rr * rr;
        double sn = r2 * (1.0 / 6227020800.0) - (1.0 / 39916800.0); sn = sn * r2 + (1.0 / 362880.0); sn = sn * r2 - (1.0 / 5040.0); sn = sn * r2 + (1.0 / 120.0); sn = sn * r2 - (1.0 / 6.0); sn = sn * r2 * rr + rr;
        double cs = r2 * (1.0 / 479001600.0) - (1.0 / 3628800.0); cs = cs * r2 + (1.0 / 40320.0); cs = cs * r2 - (1.0 / 720.0); cs = cs * r2 + (1.0 / 24.0); cs = cs * r2 - 0.5; cs = cs * r2 + 1.0;
        double so, co;
        switch (qi & 3) { case 0: so = sn; co = cs; break; case 1: so = cs; co = -sn; break; case 2: so = -sn; co = -cs; break; default: so = -cs; co = sn; break; }
        rope[(size_t)pos * 64 + j] = (float)co; rope[(size_t)pos * 64 + 32 + j] = (float)so;
    }
}

__device__ __forceinline__ int crow(int r, int hi) { return (r & 3) + 8 * (r >> 2) + 4 * hi; }
__device__ __forceinline__ bf16x8 packp(const f32x16& p, int s) {
    u32x4 w; w.x = cvt_pk_bf16(p[8 * s + 0], p[8 * s + 1]); w.y = cvt_pk_bf16(p[8 * s + 2], p[8 * s + 3]); w.z = cvt_pk_bf16(p[8 * s + 4], p[8 * s + 5]); w.w = cvt_pk_bf16(p[8 * s + 6], p[8 * s + 7]);
    return __builtin_bit_cast(bf16x8, w);
}
__device__ __forceinline__ float sink_softmax5(f32x16 (&S)[5], int qcmp, int hi, float sink2, int minkr) {
    const float NEG = -INFINITY;
#pragma unroll
    for (int r = 0; r < 16; ++r) { const int c = crow(r, hi); if (c < qcmp) S[0][r] = NEG; if (c > qcmp) S[4][r] = NEG; }
    if (minkr > 0) {
#pragma unroll
        for (int kb = 0; kb < 5; ++kb)
#pragma unroll
            for (int r = 0; r < 16; ++r) if (32 * kb + crow(r, hi) < minkr) S[kb][r] = NEG;
    }
    float m = sink2;
#pragma unroll
    for (int kb = 0; kb < 5; ++kb)
#pragma unroll
        for (int r = 0; r < 16; ++r) m = fmaxf(m, S[kb][r]);
    m = fmaxf(m, __shfl_xor(m, 32));
    float l = 0.f;
#pragma unroll
    for (int kb = 0; kb < 5; ++kb)
#pragma unroll
        for (int r = 0; r < 16; ++r) { const float p = __builtin_amdgcn_exp2f(S[kb][r] - m); S[kb][r] = p; l += p; }
    l += __shfl_xor(l, 32);
    l += __builtin_amdgcn_exp2f(sink2 - m);
    return 1.0f / l;
}
__device__ __forceinline__ void attn_store(const f32x16 (&O)[2], float inv_l, int row, int head, int hi, const bf16_t* SZA, bf16_t* QA) {
#pragma unroll
    for (int blk = 0; blk < 2; ++blk)
#pragma unroll
        for (int rr = 0; rr < 4; ++rr) {
            const size_t off = (size_t)row * DM + 64 * head + 32 * blk + 8 * rr + 4 * hi;
            const u32x2 z = *(const u32x2*)(SZA + off);
            u32x2 w; w.x = cvt_pk_bf16(O[blk][4 * rr] * inv_l * bf_lo(z.x), O[blk][4 * rr + 1] * inv_l * bf_hi(z.x)); w.y = cvt_pk_bf16(O[blk][4 * rr + 2] * inv_l * bf_lo(z.y), O[blk][4 * rr + 3] * inv_l * bf_hi(z.y));
            *(u32x2*)(QA + off) = w;
        }
}

__device__ __forceinline__ void attn_prompt_all(LAS unsigned char* lds, int tid, int G, const bf16_t* Kb, const bf16_t* Vt, bf16_t* QA, const bf16_t* SZA, const float* sinks) {
    const int lane = tid & 63, wid = __builtin_amdgcn_readfirstlane(tid >> 6), ql = lane & 31, hi = lane >> 5;
    LAS unsigned char* Ks = lds; LAS unsigned char* Vs = lds + 27648;
    const int i0 = 32 * (wid & 1);
    u32x4 kst[3], vst[3]; bf16x8 qn[4];
#define ATT_FETCH(id_) do { const int n_ = 1 + ((id_) >> 3), g_ = ((id_) >> 1) & 3, kbase_ = 128 * (n_ - 1) + 64 * ((id_) & 1); \
        _Pragma("unroll") for (int i = 0; i < 3; ++i) { const int ch = tid + 512 * i; \
            { const int row = ch >> 3, c = ch & 7; kst[i] = *(const u32x4*)(Kb + (size_t)(kbase_ + row) * 256 + g_ * 64 + c * 8); } \
            { const int d = ch / 24, c = ch - d * 24; vst[i] = *(const u32x4*)(Vt + (size_t)(g_ * 64 + d) * MROWS + kbase_ + c * 8); } } \
        const int qrow_ = kbase_ + 128 + i0 + ql, hq_ = 4 * g_ + (wid >> 1); \
        _Pragma("unroll") for (int d0 = 0; d0 < 4; ++d0) qn[d0] = *(const bf16x8*)(QA + (size_t)qrow_ * DM + 64 * hq_ + 16 * d0 + 8 * hi); } while (0)
    int id = blockIdx.x;
    if (id < 1024) ATT_FETCH(id);
    for (; id < 1024; id += G) {
        const int n = 1 + (id >> 3), g = (id >> 1) & 3, half = id & 1;
        const int kbase = 128 * (n - 1) + 64 * half;
#pragma unroll
        for (int i = 0; i < 3; ++i) {
            const int ch = tid + 512 * i;
            { const int row = ch >> 3, c = ch & 7; *(LAS u32x4*)(Ks + row * 144 + c * 16) = kst[i]; }
            { const int d = ch / 24, c = ch - d * 24; LAS u32x2* p = (LAS u32x2*)(Vs + d * 392 + c * 16); p[0] = (u32x2){vst[i].x, vst[i].y}; p[1] = (u32x2){vst[i].z, vst[i].w}; }
        }
        const int hq = 4 * g + (wid >> 1);
        const int qrow = kbase + 128 + i0 + ql;
        bf16x8 qr[4];
#pragma unroll
        for (int d0 = 0; d0 < 4; ++d0) qr[d0] = qn[d0];
        const float sink2 = sinks[hq] * LOG2E;
        __syncthreads();
        if (id + G < 1024) ATT_FETCH(id + G);
        f32x16 S[5];
#pragma unroll
        for (int kb = 0; kb < 5; ++kb) {
            S[kb] = (f32x16){};
#pragma unroll
            for (int d0 = 0; d0 < 4; ++d0) { const bf16x8 a = *(const LAS bf16x8*)(Ks + (i0 + 32 * kb + ql) * 144 + (16 * d0 + 8 * hi) * 2); S[kb] = __builtin_amdgcn_mfma_f32_32x32x16_bf16(a, qr[d0], S[kb], 0, 0, 0); }
        }
        const float inv_l = sink_softmax5(S, ql, hi, sink2, R_META - (kbase + i0));
        f32x16 O[2]; O[0] = (f32x16){}; O[1] = (f32x16){};
#pragma unroll
        for (int kb = 0; kb < 5; ++kb)
#pragma unroll
            for (int s = 0; s < 2; ++s) {
                const bf16x8 pb = packp(S[kb], s);
#pragma unroll
                for (int blk = 0; blk < 2; ++blk) {
                    const LAS unsigned char* vp = Vs + (32 * blk + ql) * 392 + (i0 + 32 * kb + 16 * s + 4 * hi) * 2;
                    const u32x2 lo = *(const LAS u32x2*)vp, hh = *(const LAS u32x2*)(vp + 16);
                    const u32x4 av = {lo.x, lo.y, hh.x, hh.y};
                    O[blk] = __builtin_amdgcn_mfma_f32_32x32x16_bf16(__builtin_bit_cast(bf16x8, av), pb, O[blk], 0, 0, 0);
                }
            }
#pragma unroll
        for (int blk = 0; blk < 2; ++blk)
#pragma unroll
            for (int rr = 0; rr < 4; ++rr) {
                const size_t off = (size_t)qrow * DM + 64 * hq + 32 * blk + 8 * rr + 4 * hi; const u32x2 z = *(const u32x2*)(SZA + off);
                u32x2 w; w.x = cvt_pk_bf16(O[blk][4 * rr] * inv_l * bf_lo(z.x), O[blk][4 * rr + 1] * inv_l * bf_hi(z.x)); w.y = cvt_pk_bf16(O[blk][4 * rr + 2] * inv_l * bf_lo(z.y), O[blk][4 * rr + 3] * inv_l * bf_hi(z.y));
                *(u32x2*)(QA + off) = w;
            }
        __syncthreads();
    }
#undef ATT_FETCH
}

__device__ __forceinline__ bf16x8 cvt8(const f32x4 a, const f32x4 b) { return __builtin_bit_cast(bf16x8, pack8(a, b)); }

__device__ __forceinline__ void attn_sample_unit(int b, int g, int hh, int lane, const float* ck, const float* cv, const bf16_t* Kb, const bf16_t* Vt, bf16_t* QA, const bf16_t* SZA, const float* sinks, float* out) {
    const int ql = lane & 31, hi = lane >> 5, t = ql & 7; const bool cp = (hh == 0);
    const int row = R_SAMPLE + 8 * b + t, head = 4 * g + hh;
    bf16x8 qr[4];
#pragma unroll
    for (int d0 = 0; d0 < 4; ++d0) qr[d0] = *(const bf16x8*)(QA + (size_t)row * DM + 64 * head + 16 * d0 + 8 * hi);
    const float sink2 = sinks[head] * LOG2E;
    const float* ckb = ck + (size_t)b * 128 * 256 + g * 64; const float* cvb = cv + (size_t)b * 128 * 256 + g * 64;
    float* oks = out + O_NKS + (size_t)b * 128 * 256 + g * 64; float* ovs = out + O_NVS + (size_t)b * 128 * 256 + g * 64;
    float m = sink2, l = hi ? 0.f : 1.f;
    f32x16 O[2]; O[0] = (f32x16){}; O[1] = (f32x16){};
    const float NEG = -INFINITY;
#pragma unroll 1
    for (int kb = 0; kb < 5; ++kb) {
        f32x16 S = (f32x16){};
        if (kb < 4) {
            const int s = 32 * kb + ql;
#pragma unroll
            for (int d0 = 0; d0 < 4; ++d0) {
                const float* p = ckb + (size_t)s * 256 + 16 * d0 + 8 * hi; const f32x4 x0 = *(const f32x4*)p, x1 = *(const f32x4*)(p + 4);
                if (cp && s >= 8) { float* o = oks + (size_t)(s - 8) * 256 + 16 * d0 + 8 * hi; *(f32x4*)o = x0; *(f32x4*)(o + 4) = x1; }
                S = __builtin_amdgcn_mfma_f32_32x32x16_bf16(cvt8(x0, x1), qr[d0], S, 0, 0, 0);
            }
        } else {
#pragma unroll
            for (int d0 = 0; d0 < 4; ++d0) {
                u32x4 kv = {0u, 0u, 0u, 0u};
                if (ql < 8) kv = *(const u32x4*)(Kb + (size_t)(R_SAMPLE + 8 * b + ql) * 256 + g * 64 + 16 * d0 + 8 * hi);
                S = __builtin_amdgcn_mfma_f32_32x32x16_bf16(__builtin_bit_cast(bf16x8, kv), qr[d0], S, 0, 0, 0);
            }
        }
        if (kb == 0) {
#pragma unroll
            for (int r = 0; r < 16; ++r) if (crow(r, hi) < t) S[r] = NEG;
        }
        if (kb == 4) {
#pragma unroll
            for (int r = 0; r < 16; ++r) if (crow(r, hi) > t) S[r] = NEG;
        }
        float mb = S[0];
#pragma unroll
        for (int r = 1; r < 16; ++r) mb = fmaxf(mb, S[r]);
        mb = fmaxf(mb, __shfl_xor(mb, 32));
        const float mn = fmaxf(m, mb), alpha = __builtin_amdgcn_exp2f(m - mn); m = mn;
        float ps = 0.f;
#pragma unroll
        for (int r = 0; r < 16; ++r) { const float p = __builtin_amdgcn_exp2f(S[r] - mn); S[r] = p; ps += p; }
        l = l * alpha + ps;
        O[0] = O[0] * alpha; O[1] = O[1] * alpha;
        if (kb < 4) {
#pragma unroll
            for (int s2 = 0; s2 < 2; ++s2) {
                const bf16x8 pb = packp(S, s2);
#pragma unroll
                for (int blk = 0; blk < 2; ++blk) {
                    const int d = 32 * blk + ql;
                    f32x4 v0, v1;
                    const int kk = 32 * kb + 16 * s2 + 4 * hi;
                    const float* vsrc = cvb + (size_t)kk * 256 + d; float* vdst = ovs + (size_t)kk * 256 + d - 8 * 256;
                    v0.x = vsrc[0]; v0.y = vsrc[256]; v0.z = vsrc[512]; v0.w = vsrc[768]; v1.x = vsrc[2048]; v1.y = vsrc[2304]; v1.z = vsrc[2560]; v1.w = vsrc[2816];
                    if (cp && kk >= 8) { vdst[0] = v0.x; vdst[256] = v0.y; vdst[512] = v0.z; vdst[768] = v0.w; }
                    if (cp) { vdst[2048] = v1.x; vdst[2304] = v1.y; vdst[2560] = v1.z; vdst[2816] = v1.w; }
                    O[blk] = __builtin_amdgcn_mfma_f32_32x32x16_bf16(cvt8(v0, v1), pb, O[blk], 0, 0, 0);
                }
            }
        } else {
            const bf16x8 pb = packp(S, 0);
#pragma unroll
            for (int blk = 0; blk < 2; ++blk) {
                const int d = 32 * blk + ql;
                const u32x2 lo = *(const u32x2*)(Vt + (size_t)(g * 64 + d) * MROWS + R_SAMPLE + 8 * b + 4 * hi);
                const u32x4 av = {lo.x, lo.y, 0u, 0u};
                O[blk] = __builtin_amdgcn_mfma_f32_32x32x16_bf16(__builtin_bit_cast(bf16x8, av), pb, O[blk], 0, 0, 0);
            }
        }
    }
    l += __shfl_xor(l, 32);
    if (ql < 8) attn_store(O, 1.0f / l, row, head, hi, SZA, QA);
}

__device__ __forceinline__ void conv_pass(int gtid, int nthr, const bf16_t* U, bf16_t* BZ, const float* cw, const float* state) {
    const int ch = (gtid & 127) * 8;
    float w0[8], w1[8], w2[8];
#pragma unroll
    for (int e = 0; e < 8; ++e) { w0[e] = cw[ch + e]; w1[e] = cw[DM + ch + e]; w2[e] = cw[2 * DM + ch + e]; }
    for (int item = gtid >> 7; item < M23 / 8; item += nthr >> 7) {
        const int r0 = R_PROMPT + 8 * item;
        float um2[8], um1[8];
        if (r0 < R_SAMPLE) {
            const u32x4 a = *(const u32x4*)(U + (size_t)(r0 - 2) * DM + ch), b = *(const u32x4*)(U + (size_t)(r0 - 1) * DM + ch);
            um2[0] = bf_lo(a.x); um2[1] = bf_hi(a.x); um2[2] = bf_lo(a.y); um2[3] = bf_hi(a.y); um2[4] = bf_lo(a.z); um2[5] = bf_hi(a.z); um2[6] = bf_lo(a.w); um2[7] = bf_hi(a.w);
            um1[0] = bf_lo(b.x); um1[1] = bf_hi(b.x); um1[2] = bf_lo(b.y); um1[3] = bf_hi(b.y); um1[4] = bf_lo(b.z); um1[5] = bf_hi(b.z); um1[6] = bf_lo(b.w); um1[7] = bf_hi(b.w);
        } else {
            const float* st = state + (size_t)((r0 - R_SAMPLE) >> 3) * 2 * DM + ch;
#pragma unroll
            for (int e = 0; e < 8; ++e) { um2[e] = st[e]; um1[e] = st[DM + e]; }
        }
#pragma unroll
        for (int i = 0; i < 8; ++i) {
            const size_t off = (size_t)(r0 + i) * DM + ch;
            const u32x4 a = *(const u32x4*)(U + off), z = *(const u32x4*)(BZ + off);
            float uc[8], bz[8], o[8];
            uc[0] = bf_lo(a.x); uc[1] = bf_hi(a.x); uc[2] = bf_lo(a.y); uc[3] = bf_hi(a.y); uc[4] = bf_lo(a.z); uc[5] = bf_hi(a.z); uc[6] = bf_lo(a.w); uc[7] = bf_hi(a.w);
            bz[0] = bf_lo(z.x); bz[1] = bf_hi(z.x); bz[2] = bf_lo(z.y); bz[3] = bf_hi(z.y); bz[4] = bf_lo(z.z); bz[5] = bf_hi(z.z); bz[6] = bf_lo(z.w); bz[7] = bf_hi(z.w);
#pragma unroll
            for (int e = 0; e < 8; ++e) { o[e] = bz[e] * (w0[e] * um2[e] + w1[e] * um1[e] + w2[e] * uc[e]); um2[e] = um1[e]; um1[e] = uc[e]; }
            u32x4 w; w.x = cvt_pk_bf16(o[0], o[1]); w.y = cvt_pk_bf16(o[2], o[3]); w.z = cvt_pk_bf16(o[4], o[5]); w.w = cvt_pk_bf16(o[6], o[7]);
            *(u32x4*)(BZ + off) = w;
        }
    }
}


#define XB_TMO      128
#define XB_XCNT(j)  (256  + 64 * (j))
#define XB_XSUB(j)  (1280 + 64 * (j))
#define XB_XGEN(j)  (2304 + 64 * (j))
#define XB_TOP      3328
#define XB_TOPGEN   3392
#define XCD_BAR_WORDS 3456
#define XB_SPIN_CAP (1u << 18)
__device__ __forceinline__ unsigned xb_ld(unsigned* p)              { return __hip_atomic_load(p, __ATOMIC_RELAXED, __HIP_MEMORY_SCOPE_AGENT); }
__device__ __forceinline__ unsigned xb_add(unsigned* p, unsigned v) { return __hip_atomic_fetch_add(p, v, __ATOMIC_RELAXED, __HIP_MEMORY_SCOPE_AGENT); }
__device__ __forceinline__ unsigned xb_xcc_id() { return (unsigned)__builtin_amdgcn_s_getreg((3 << 11) | 20) & 0xFu; }
#define XB_SPIN(cond, bar) do { unsigned _sp = 0; while (cond) { __builtin_amdgcn_s_sleep(1); \
    if ((++_sp & 255u) == 0u) { if (xb_ld(&(bar)[XB_TMO])) break; if (_sp > XB_SPIN_CAP) { atomicAdd(&(bar)[XB_TMO], 1u); break; } } } } while (0)
struct XcdBarrier { unsigned* bar; unsigned x; volatile LAS unsigned* st; };
__device__ __forceinline__ XcdBarrier xcd_barrier_post(unsigned* bar, volatile LAS unsigned* st) {
    XcdBarrier b; b.bar = bar; b.x = xb_xcc_id(); b.st = st;
    if (threadIdx.x == 0) (void)xb_add(&bar[XB_XCNT(b.x)], 1u);
    return b;
}
__device__ __forceinline__ void xcd_barrier_complete(unsigned* bar, unsigned x, unsigned& nloc, unsigned& nx) {
    const unsigned G = gridDim.x * gridDim.y * gridDim.z;
    unsigned sum, cnt, mine, sp = 0u;
    for (;;) {
        sum = 0u; cnt = 0u; mine = 0u;
#pragma unroll
        for (unsigned j = 0; j < 16; ++j) { const unsigned c = xb_ld(&bar[XB_XCNT(j)]); sum += c; cnt += (c > 0u) ? 1u : 0u; mine = (j == x) ? c : mine; }
        if (sum == G) break;
        __builtin_amdgcn_s_sleep(1);
        if ((++sp & 255u) == 0u) { if (xb_ld(&bar[XB_TMO])) break; if (sp > XB_SPIN_CAP) { atomicAdd(&bar[XB_TMO], 1u); break; } }
    }
    nloc = mine > 0u ? mine : 1u; nx = cnt > 0u ? cnt : 1u;
}
__device__ __forceinline__ void xcd_barrier(const XcdBarrier& b) {
    asm volatile("s_waitcnt vmcnt(0)" ::: "memory");
    __syncthreads();
    if (threadIdx.x == 0) {
        unsigned* bar = b.bar;
        __builtin_amdgcn_s_waitcnt(0);
        unsigned nloc = b.st[0], nx = b.st[1];
        if (nloc == 0u) { xcd_barrier_complete(bar, b.x, nloc, nx); b.st[0] = nloc; b.st[1] = nx; }
        const unsigned old = xb_add(&bar[XB_XSUB(b.x)], 1u);
        const unsigned gen = old / nloc;
        if (old + 1u == (gen + 1u) * nloc) {
            __builtin_amdgcn_fence(__ATOMIC_RELEASE, "agent");
            asm volatile("s_waitcnt vmcnt(0)" ::: "memory");
            const unsigned og = xb_add(&bar[XB_TOP], 1u);
            const unsigned tg = og / nx;
            if (og + 1u == (tg + 1u) * nx) xb_add(&bar[XB_TOPGEN], 1u);
            else XB_SPIN(xb_ld(&bar[XB_TOPGEN]) == tg, bar);
            __builtin_amdgcn_fence(__ATOMIC_ACQUIRE, "agent");
            xb_add(&bar[XB_XGEN(b.x)], 1u);
            asm volatile("s_waitcnt vmcnt(0)" ::: "memory");
        } else {
            XB_SPIN(xb_ld(&bar[XB_XGEN(b.x)]) == gen, bar);
            __builtin_amdgcn_fence(__ATOMIC_ACQUIRE, "agent");
            asm volatile("s_waitcnt vmcnt(0)" ::: "memory");
        }
    }
    __syncthreads();
}

__global__ void __launch_bounds__(512, 2) hybrid_fwd(Args a) {
    extern __shared__ __attribute__((aligned(16))) unsigned char lds_raw[];
    LAS unsigned char* lds = (LAS unsigned char*)lds_raw;
    const int tid = threadIdx.x, lane = tid & 63, wave = __builtin_amdgcn_readfirstlane(tid >> 6), G = gridDim.x;
    const int lo = a.ph_lo, hi = a.ph_hi;
#define IN(k) (lo <= (k) && (k) < hi)
#define GSYNC() xcd_barrier(xbar)
#define SEAM(k) do { if (IN(k) && IN((k) + 1)) { GSYNC(); } } while (0)
    volatile LAS unsigned* MISC = (volatile LAS unsigned*)(lds + 131072);
    if (tid < 4) MISC[tid] = 0u;
    __syncthreads();
    XcdBarrier xbar; xbar.bar = (unsigned*)(a.ws + WS_CTL); xbar.x = 0; xbar.st = MISC;
    if (hi - lo > 1) xbar = xcd_barrier_post((unsigned*)(a.ws + WS_CTL), MISC);
    if (lo > 1000) cg::this_grid().sync();
    unsigned char* ws = a.ws;
    bf16_t* XN = (bf16_t*)(ws + WS_B0); bf16_t* QA = (bf16_t*)(ws + WS_QA); bf16_t* BZ = (bf16_t*)(ws + WS_BZ); bf16_t* SZA = (bf16_t*)(ws + WS_SZA);
    bf16_t* Ub = (bf16_t*)(ws + WS_U); bf16_t* SGB = (bf16_t*)(ws + WS_SGB); bf16_t* Kb = (bf16_t*)(ws + WS_K); bf16_t* Vt = (bf16_t*)(ws + WS_VT);
    bf16_t* SGA = (bf16_t*)a.out; float* rope = (float*)(ws + WS_ROPE);

#define PH0() do { if (IN(0)) { p0_prologue(a, lds, tid, lane, wave, G); } } while (0)
#define PH1() do { if (IN(1)) { \
        pg8::Gemm g{XN, (const bf16_t*)(ws + WS_WIN), MROWS, NIN, DM, 0, 0}; pg8::StaticOrder S; S.init(MROWS, NIN, G, (int)blockIdx.x, 1); \
        Epi1 E{QA, Kb, Vt, SZA, BZ, Ub, SGA, SGB, rope, a.in[8], a.in[9], a.out}; \
        pg8::gemm_phase<Epi1>(lds, g, S, E); } } while (0)
#define PH3() do { if (IN(3)) { \
        pg8::Gemm g{QA + (size_t)R_PROMPT * DM, (const bf16_t*)(ws + WS_WA), M23, DM, DM, BUFB, 2097152}; pg8::StaticOrder S; S.init(M23, DM, G, (int)blockIdx.x, 2); \
        Epi2 E{SGA + (size_t)R_PROMPT * DM, SGB + (size_t)R_PROMPT * DM, XN}; \
        pg8::gemm_phase<Epi2>(lds, g, S, E); } } while (0)
#define PH4() do { if (IN(4)) { \
        pg8::Gemm g{XN, (const bf16_t*)(ws + WS_WO), M23, DM, DM, 0, 0}; pg8::StaticOrder S; S.init(M23, DM, G, (int)blockIdx.x, 1); \
        Epi3 E{a.in[0], a.in[1], a.out + O_Y}; \
        pg8::gemm_phase<Epi3>(lds, g, S, E); } } while (0)
    PH0();
#if REP_MASK & 1
    GSYNC(); PH0();
#endif
    SEAM(0);
#if REP_MASK & 32
    GSYNC(); GSYNC(); GSYNC(); GSYNC(); GSYNC(); GSYNC(); GSYNC(); GSYNC();
#endif
    PH1();
#if REP_MASK & 2
    GSYNC(); PH1();
#endif
    SEAM(1);
#define PH2() do { if (IN(2)) { \
        attn_prompt_all(lds, tid, G, Kb, Vt, QA, SZA, a.in[10]); \
        for (int u = blockIdx.x * 2 + (wave >> 2); u < 512; u += 2 * G) attn_sample_unit(u >> 2, u & 3, wave & 3, lane, a.in[2], a.in[3], Kb, Vt, QA, SZA, a.in[10], a.out); \
        conv_pass(blockIdx.x * 512 + tid, G * 512, Ub, BZ, a.in[11], a.in[4]); } } while (0)
    PH2();
#if REP_MASK & 4
    GSYNC(); PH1(); GSYNC(); PH2();
#endif
    SEAM(2);
    PH3();
#if REP_MASK & 8
    GSYNC(); PH3();
#endif
    SEAM(3);
    PH4();
#if REP_MASK & 16
    GSYNC(); PH4();
#endif
#undef IN
#undef SEAM
}


#ifndef DBG_DUMP
#define DBG_DUMP 0
#endif
__global__ void dbg_dump(const bf16_t* src, float* dst, size_t n) {
    for (size_t i = (size_t)blockIdx.x * blockDim.x + threadIdx.x; i < n; i += (size_t)gridDim.x * blockDim.x) dst[i] = __uint_as_float((unsigned)src[i] << 16);
}
extern "C" void kernel_launch(void* const* d_in, const int* in_sizes, int n_in, void* d_out, int out_size, void* d_ws, size_t ws_size, hipStream_t stream) {
    static int grid = 0;
    if (grid == 0) {
        int dev = 0, cus = 0, per_cu = 0;
        if (n_in != 15 || ws_size < WS_END) { fprintf(stderr, "kernel_launch: unexpected inputs (n_in %d, ws %zu)\n", n_in, ws_size); grid = -1; return; }
        if (hipGetDevice(&dev) != hipSuccess || hipDeviceGetAttribute(&cus, hipDeviceAttributeMultiprocessorCount, dev) != hipSuccess) { grid = -1; return; }
        if (hipFuncSetAttribute((const void*)hybrid_fwd, hipFuncAttributeMaxDynamicSharedMemorySize, LDS_BYTES) != hipSuccess) { fprintf(stderr, "kernel_launch: hipFuncSetAttribute failed\n"); grid = -1; return; }
        if (hipOccupancyMaxActiveBlocksPerMultiprocessor(&per_cu, (const void*)hybrid_fwd, 512, LDS_BYTES) != hipSuccess || per_cu < 1) { fprintf(stderr, "kernel_launch: occupancy query gives %d\n", per_cu); per_cu = 1; }
        (void)hipGetLastError();
        grid = cus * 1;
    }
    if (grid < 0) return;
    Args a{};
    for (int i = 0; i < 15; ++i) a.in[i] = (const float*)d_in[i];
    a.out = (float*)d_out; a.ws = (unsigned char*)d_ws;
#if MK_N_LAUNCHES == 1
    if (hipMemsetAsync((char*)d_ws + WS_CTL, 0, CTL_BYTES, stream) != hipSuccess) { fprintf(stderr, "kernel_launch: memset of the barrier words failed\n"); return; }
    a.ph_lo = 0; a.ph_hi = 5;
    void* args[] = {&a};
    hipError_t e = hipLaunchCooperativeKernel((const void*)hybrid_fwd, dim3(grid), dim3(512), args, LDS_BYTES, stream);
    if (e != hipSuccess) fprintf(stderr, "cooperative launch failed: %s (grid %d)\n", hipGetErrorString(e), grid);
#else
    for (int p = 0; p < DBG_NPH; ++p) {
        a.ph_lo = p; a.ph_hi = p + 1;
        hipLaunchKernelGGL(hybrid_fwd, dim3(grid), dim3(512), LDS_BYTES, stream, a);
    }
#if DBG_DUMP == 1
    hipLaunchKernelGGL(dbg_dump, dim3(1024), dim3(256), 0, stream, (const bf16_t*)((unsigned char*)d_ws + WS_QA) + (size_t)R_PROMPT * DM, (float*)d_out + 9043968, (size_t)M23 * DM - 9043968);
#elif DBG_DUMP == 2
    hipLaunchKernelGGL(dbg_dump, dim3(1024), dim3(256), 0, stream, (const bf16_t*)((unsigned char*)d_ws + WS_BZ) + (size_t)R_PROMPT * DM, (float*)d_out + 9043968, (size_t)M23 * DM - 9043968);
#elif DBG_DUMP == 4
    hipLaunchKernelGGL(dbg_dump, dim3(1024), dim3(256), 0, stream, (const bf16_t*)((unsigned char*)d_ws + WS_SZA) + (size_t)R_PROMPT * DM, (float*)d_out + 9043968, (size_t)M23 * DM - 9043968);
#elif DBG_DUMP == 5
    hipLaunchKernelGGL(dbg_dump, dim3(1024), dim3(256), 0, stream, (const bf16_t*)((unsigned char*)d_ws + WS_K), (float*)d_out + 9043968, (size_t)MROWS * 256 * 2);
#elif DBG_DUMP == 6
    hipLaunchKernelGGL(dbg_dump, dim3(1024), dim3(256), 0, stream, (const bf16_t*)((unsigned char*)d_ws + WS_QA) + (size_t)R_SAMPLE * DM, (float*)d_out + 16777216, (size_t)1024 * DM);
#elif DBG_DUMP == 3
    hipLaunchKernelGGL(dbg_dump, dim3(1024), dim3(256), 0, stream, (const bf16_t*)((unsigned char*)d_ws + WS_B0), (float*)d_out + 9043968, (size_t)M23 * DM - 9043968);
#endif
#endif
}
```

```cpp
#include <hip/hip_runtime.h>
#include <hip/hip_cooperative_groups.h>
#include <cstdio>
#include <cstdint>
namespace cg = cooperative_groups;

#ifndef CHAIN_LATE
#define CHAIN_LATE 0
#endif
#ifndef REP_MASK
#define REP_MASK 0
#endif
#ifndef DBG_NPH
#define DBG_NPH 5
#define DBG_DUMP 0
#endif
#ifndef MK_N_LAUNCHES
#define MK_N_LAUNCHES 1
#endif

#define LAS __attribute__((address_space(3)))
typedef unsigned short bf16_t;
typedef short bf16x8 __attribute__((ext_vector_type(8)));
typedef float f32x4 __attribute__((ext_vector_type(4)));
typedef float f32x16 __attribute__((ext_vector_type(16)));
typedef unsigned u32x4 __attribute__((ext_vector_type(4)));
typedef unsigned u32x2 __attribute__((ext_vector_type(2)));

constexpr int DM = 1024, NIN = 8704;
constexpr int R_META = 112, R_PROMPT = 128, R_SAMPLE = 16512, R_END = 17536, MROWS = 17664;
constexpr int M23 = 17408;
constexpr int NPOS = 16400;
constexpr float EPS = 1e-6f;
constexpr float LOG2E = 1.4426950408889634f;
constexpr float C2 = 0.125f * LOG2E;
constexpr size_t O_Y = 0, O_NKP = 17825792, O_NVP = 17858560, O_NCP = 17891328, O_NKS = 17893376, O_NVS = 22087680, O_NCS = 26281984;
constexpr size_t BUFB = (size_t)MROWS * DM * 2;
constexpr size_t WS_WIN = 0, WS_WA = (size_t)NIN * DM * 2, WS_WB = WS_WA + 2097152, WS_WO = WS_WB + 2097152;
constexpr size_t WS_B0 = 25165824;
constexpr size_t WS_QA = WS_B0 + BUFB, WS_BZ = WS_QA + BUFB, WS_SZA = WS_BZ + BUFB, WS_U = WS_SZA + BUFB, WS_SGB = WS_U + BUFB;
constexpr size_t WS_K = WS_SGB + BUFB, WS_VT = WS_K + (size_t)MROWS * 256 * 2, WS_ROPE = WS_VT + (size_t)MROWS * 256 * 2, WS_END = WS_ROPE + (size_t)NPOS * 64 * 4;
constexpr size_t WS_CTL = 265289728, CTL_BYTES = 65536;
static_assert(WS_END <= WS_CTL && WS_CTL + CTL_BYTES <= 268435456, "d_ws map");

constexpr int LDS_BYTES = 147456;

namespace pg8 {
constexpr int BM = 256, BK = 64, HALF = 128, HTB = HALF * BK * 2, STAGE_BYTES = 8 * HTB, NXCD = 8, WGM = 8;
__host__ __device__ __forceinline__ int lds_byte(int r, int c) { const int st = (r >> 4) * 2 + (c >> 5), rr = r & 15, cc = c & 31, ob = rr * 64 + cc * 2; return st * 1024 + (ob ^ (((ob >> 9) & 1) << 5)); }
__host__ __device__ __forceinline__ void stage_rc(int b, int& R, int& C) { const int st = b / 1024, sb = b % 1024, swz = sb ^ (((sb >> 9) & 1) << 5); R = (st >> 1) * 16 + swz / 64; C = (st & 1) * 32 + (swz % 64) / 2; }
__host__ __device__ __forceinline__ int perm32(int rho) { const int n = rho >> 4, i = rho & 15; return 8 * (i >> 2) + 4 * n + (i & 3); }

struct Unit { int pm, pn, part; };
struct Gemm { const bf16_t* A; const bf16_t* Bt; int M, N, K; size_t partA, partB; };

struct StaticOrder {
    int nM, nN, nwg, G, c, np, direct, special;
    __host__ __device__ void init(int M, int N, int G_, int c_, int np_, int direct_ = -1) { nM = M / BM; nN = N / BM; nwg = nM * nN; G = G_; c = c_; np = np_; direct = direct_; special = 0; }
    __host__ __device__ bool next(int i, Unit& u) const {
        const int it = (np == 2) ? (i >> 1) : i; u.part = (np == 2) ? (i & 1) : 0;
        if (direct >= 0) { if (it > 0) return false; u.pm = direct / nN; u.pn = direct % nN; return true; }
        const long L = (long)it * G + c;
        if (L >= nwg) {
            if (!special) return false;
            const int Lp = (int)(L - nwg); if (Lp >= 332) return false;
            if (Lp < 286) { u.pm = 58 + Lp / 26; u.pn = Lp % 26; }
            else { const int q = Lp - 286; if (q < 6) { u.pm = 63; u.pn = 26 + q; } else { u.pm = 64 + (q - 6) / 8; u.pn = 26 + (q - 6) % 8; } }
            return true;
        }
        int wgid = (int)L; { const int q = nwg / NXCD, r = nwg % NXCD, xcd = wgid % NXCD, off = wgid / NXCD; wgid = (xcd < r ? xcd * (q + 1) : r * (q + 1) + (xcd - r) * q) + off; }
        const int nig = WGM * nN, gid = wgid / nig, fm = gid * WGM, gsz = (nM - fm) < WGM ? (nM - fm) : WGM;
        u.pm = fm + ((wgid % nig) % gsz); u.pn = (wgid % nig) / gsz; return true;
    }
};

typedef float f32x2_t __attribute__((ext_vector_type(2))); typedef __bf16 bf16x2_t __attribute__((ext_vector_type(2)));
__device__ __forceinline__ unsigned cvt_pk_bf16(float lo, float hi) { const f32x2_t v = {lo, hi}; const bf16x2_t b = __builtin_convertvector(v, bf16x2_t); return __builtin_bit_cast(unsigned, b); }

template <class Epi>
__device__ __forceinline__ void gemm_phase(LAS unsigned char* lds, const Gemm g, const StaticOrder& S, const Epi& E) {
    int tid_ = threadIdx.x; asm volatile("" : "+v"(tid_));
    const int tid = tid_, wid = __builtin_amdgcn_readfirstlane(tid >> 6), lane = tid & 63, wr = wid >> 2, wc = wid & 3, fr = lane & 15, fq = lane >> 4;
    const int K = g.K, nt = K / BK;
    unsigned voffA[2], voffB[2];
#pragma unroll
    for (int i = 0; i < 2; ++i) { int R, C; stage_rc(tid * 16 + i * 8192, R, C); const int Rb = ((R & ~31) + perm32(R & 31));
        voffA[i] = (unsigned)(R * K + C) * 2u; voffB[i] = (unsigned)(Rb * K + C) * 2u; }
    const size_t kstep = (size_t)(BK * 2);
    const size_t hstep = (size_t)HALF * K * 2;
    const size_t tstep = 2 * hstep;
    const unsigned ldsw = (unsigned)wid * 1024u;
    const int aoff = lds_byte(wr * 64 + fr, fq * 8), boff = lds_byte(wc * 32 + fr, fq * 8);
#define PG8_SA(b, h) (((b) * 2 + (h)) * HTB)
#define PG8_SB(b, h) ((4 + (b) * 2 + (h)) * HTB)
#define PG8_STAGE(bufoff, gbase, voff) do { _Pragma("unroll") for (int _i = 0; _i < 2; ++_i) \
        __builtin_amdgcn_global_load_lds((const unsigned*)((const char*)(gbase) + (voff)[_i]), (LAS unsigned*)(lds + (bufoff) + ldsw + _i * 8192), 16, 0, 0); } while (0)
#define PG8_LDA(dst, b, h) do { _Pragma("unroll") for (int m = 0; m < 4; ++m) _Pragma("unroll") for (int k = 0; k < 2; ++k) dst[m][k] = *(const LAS bf16x8*)(lds + PG8_SA(b, h) + aoff + m * 2048 + k * 1024); } while (0)
#define PG8_LDB(dst, b, h) do { _Pragma("unroll") for (int n = 0; n < 2; ++n) _Pragma("unroll") for (int k = 0; k < 2; ++k) dst[n][k] = *(const LAS bf16x8*)(lds + PG8_SB(b, h) + boff + n * 2048 + k * 1024); } while (0)
#define PG8_MMA(ai, bj, At, Bt) do { __builtin_amdgcn_s_setprio(1); _Pragma("unroll") for (int m = 0; m < 4; ++m) _Pragma("unroll") for (int n = 0; n < 2; ++n) _Pragma("unroll") for (int k = 0; k < 2; ++k) \
        acc[ai][bj][m][n] = __builtin_amdgcn_mfma_f32_16x16x32_bf16(Bt[n][k], At[m][k], acc[ai][bj][m][n], 0, 0, 0); __builtin_amdgcn_s_setprio(0); } while (0)
#define PG8_WAIT_V(n) asm volatile("s_waitcnt vmcnt(" #n ")" ::: "memory")
#define PG8_WAIT_L(n) asm volatile("s_waitcnt lgkmcnt(" #n ")" ::: "memory")
#define PG8_BAR __builtin_amdgcn_s_barrier()
#define PG8_SCHED __builtin_amdgcn_sched_barrier(0)
    Unit cur, nxt; int ui = 0;
    if (!S.next(0, cur)) return;
    f32x4 acc[2][2][4][2];
#pragma unroll
    for (int a = 0; a < 2; ++a)
#pragma unroll
        for (int b = 0; b < 2; ++b)
#pragma unroll
            for (int m = 0; m < 4; ++m)
#pragma unroll
                for (int n = 0; n < 2; ++n) acc[a][b][m][n] = (f32x4){0.f, 0.f, 0.f, 0.f};
    bf16x8 At[4][2], B0[2][2], B1[2][2];
    const char* cA = (const char*)g.A + (size_t)cur.pm * tstep + (size_t)cur.part * g.partA; const char* cB = (const char*)g.Bt + (size_t)cur.pn * tstep + (size_t)cur.part * g.partB;
    PG8_STAGE(PG8_SB(0, 0), cB, voffB); PG8_STAGE(PG8_SB(0, 1), cB + hstep, voffB); PG8_STAGE(PG8_SA(0, 0), cA, voffA); PG8_STAGE(PG8_SA(0, 1), cA + hstep, voffA);
    if (wr == 1) PG8_BAR;
    PG8_WAIT_V(2); PG8_BAR;
    PG8_STAGE(PG8_SB(1, 0), cB + kstep, voffB); PG8_STAGE(PG8_SA(1, 0), cA + kstep, voffA); PG8_STAGE(PG8_SB(1, 1), cB + hstep + kstep, voffB);
    PG8_WAIT_V(6); PG8_BAR;
    for (;;) {
        const bool has_next = S.next(ui + 1, nxt);
        const char* nA = has_next ? (const char*)g.A + (size_t)nxt.pm * tstep + (size_t)nxt.part * g.partA : cA; const char* nB = has_next ? (const char*)g.Bt + (size_t)nxt.pn * tstep + (size_t)nxt.part * g.partB : cB;
        for (int t = 0; t < nt; t += 2) {
            const bool last = (t == nt - 2);
            const char* a1 = cA + (size_t)(t + 1) * kstep;
            const char* a2 = last ? nA : cA + (size_t)(t + 2) * kstep; const char* b2 = last ? nB : cB + (size_t)(t + 2) * kstep;
            const char* a3 = a2 + kstep; const char* b3 = b2 + kstep;
            PG8_LDB(B0, 0, 0); PG8_LDB(B1, 0, 1); PG8_SCHED; PG8_LDA(At, 0, 0); PG8_STAGE(PG8_SA(1, 1), a1 + hstep, voffA);
            PG8_WAIT_V(8); PG8_WAIT_L(0); PG8_BAR; PG8_MMA(0, 0, At, B0); PG8_MMA(0, 1, At, B1); PG8_BAR; PG8_SCHED;
            PG8_LDA(At, 0, 1); PG8_STAGE(PG8_SB(0, 0), b2, voffB); PG8_STAGE(PG8_SB(0, 1), b2 + hstep, voffB); PG8_STAGE(PG8_SA(0, 0), a2, voffA);
            PG8_WAIT_V(8); PG8_WAIT_L(0); PG8_BAR; PG8_MMA(1, 0, At, B0); PG8_MMA(1, 1, At, B1); PG8_BAR; PG8_SCHED;
            PG8_LDB(B0, 1, 0); PG8_LDB(B1, 1, 1); PG8_SCHED; PG8_LDA(At, 1, 0); PG8_STAGE(PG8_SA(0, 1), a2 + hstep, voffA);
            PG8_WAIT_V(8); PG8_WAIT_L(0); PG8_BAR; PG8_MMA(0, 0, At, B0); PG8_MMA(0, 1, At, B1); PG8_BAR; PG8_SCHED;
            PG8_LDA(At, 1, 1); PG8_STAGE(PG8_SB(1, 0), b3, voffB); PG8_STAGE(PG8_SB(1, 1), b3 + hstep, voffB); PG8_STAGE(PG8_SA(1, 0), a3, voffA);
            PG8_WAIT_V(8); PG8_WAIT_L(0); PG8_BAR; PG8_MMA(1, 0, At, B0); PG8_MMA(1, 1, At, B1); PG8_BAR; PG8_SCHED;
        }
        if (wr == 0) PG8_BAR;
        { Unit eu = cur; asm volatile("" : "+s"(eu.pm), "+s"(eu.pn), "+s"(eu.part));
          E(acc, eu, wr, wc, fr, fq); }
        if (!has_next) break;
        if (!E.keep(cur)) {
#pragma unroll
        for (int a = 0; a < 2; ++a)
#pragma unroll
            for (int b = 0; b < 2; ++b)
#pragma unroll
                for (int m = 0; m < 4; ++m)
#pragma unroll
                    for (int n = 0; n < 2; ++n) acc[a][b][m][n] = (f32x4){0.f, 0.f, 0.f, 0.f};
        }
        cur = nxt; cA = nA; cB = nB; ++ui;
        if (wr == 1) PG8_BAR;
    }
    PG8_WAIT_V(0);
    PG8_BAR;
#undef PG8_SA
#undef PG8_SB
#undef PG8_STAGE
#undef PG8_LDA
#undef PG8_LDB
#undef PG8_MMA
#undef PG8_WAIT_V
#undef PG8_WAIT_L
#undef PG8_BAR
#undef PG8_SCHED
}
}
using pg8::cvt_pk_bf16;

__device__ __forceinline__ float bf_lo(unsigned u) { return __uint_as_float(u << 16); }
__device__ __forceinline__ float bf_hi(unsigned u) { return __uint_as_float(u & 0xffff0000u); }
__device__ __forceinline__ float sigm_f(float x) { return __builtin_amdgcn_rcpf(1.f + __builtin_amdgcn_exp2f(-LOG2E * x)); }
__device__ __forceinline__ float silu_f(float x) { return x * sigm_f(x); }
__device__ __forceinline__ f32x4 sigm4(const f32x4 v) { f32x4 r; r.x = sigm_f(v.x); r.y = sigm_f(v.y); r.z = sigm_f(v.z); r.w = sigm_f(v.w); return r; }
__device__ __forceinline__ int rowpos(int row) { return row < R_SAMPLE ? (row > R_META ? row - R_META : 0) : (row < R_END ? 16384 + ((row - R_SAMPLE) & 7) : 0); }
__device__ __forceinline__ u32x4 pack8(const f32x4 a, const f32x4 b) { u32x4 w; w.x = cvt_pk_bf16(a[0], a[1]); w.y = cvt_pk_bf16(a[2], a[3]); w.z = cvt_pk_bf16(b[0], b[1]); w.w = cvt_pk_bf16(b[2], b[3]); return w; }

struct Epi1 {
    bf16_t *Q, *Kb, *Vt, *SZA, *BZ, *U, *SGA, *SGB; const float *rope, *qnw, *knw; float* out;
    __device__ __forceinline__ bool keep(const pg8::Unit&) const { return false; }
    __device__ __forceinline__ void operator()(f32x4 (&acc)[2][2][4][2], const pg8::Unit& u, int wr, int wc, int fr, int fq) const {
        const int pn = u.pn, row0 = u.pm * 256 + wr * 64 + fr;
        if (pn < 5) {
            const bool isq = pn < 4; const float* nw = isq ? qnw : knw;
            f32x4 w[2][2];
#pragma unroll
            for (int bj = 0; bj < 2; ++bj)
#pragma unroll
                for (int n = 0; n < 2; ++n) w[bj][n] = *(const f32x4*)(nw + 32 * bj + 8 * fq + 4 * n);
            const float sc = isq ? C2 : 1.f;
#pragma unroll
            for (int ai = 0; ai < 2; ++ai)
#pragma unroll
                for (int m = 0; m < 4; ++m) {
                    const int row = row0 + ai * 128 + m * 16;
                    float ss = 0.f;
#pragma unroll
                    for (int bj = 0; bj < 2; ++bj)
#pragma unroll
                        for (int n = 0; n < 2; ++n) { const f32x4 x = acc[ai][bj][m][n]; ss += (x[0] * x[0] + x[1] * x[1]) + (x[2] * x[2] + x[3] * x[3]); }
                    ss += __shfl_xor(ss, 16); ss += __shfl_xor(ss, 32);
                    const float rinv = 1.0f / sqrtf(ss * (1.f / 64.f) + EPS);
                    const float* rp = rope + (size_t)rowpos(row) * 64 + 8 * fq;
                    f32x4 o1[2], o2[2];
#pragma unroll
                    for (int n = 0; n < 2; ++n) {
                        const f32x4 cs = *(const f32x4*)(rp + 4 * n), sn = *(const f32x4*)(rp + 32 + 4 * n);
                        const f32x4 x1 = acc[ai][0][m][n] * rinv * w[0][n], x2 = acc[ai][1][m][n] * rinv * w[1][n];
                        o1[n] = (x1 * cs - x2 * sn) * sc; o2[n] = (x2 * cs + x1 * sn) * sc;
                    }
                    if (isq) {
                        bf16_t* p = Q + (size_t)row * DM + 64 * (4 * pn + wc) + 8 * fq;
                        *(u32x4*)p = pack8(o1[0], o1[1]); *(u32x4*)(p + 32) = pack8(o2[0], o2[1]);
                    } else {
                        bf16_t* p = Kb + (size_t)row * 256 + 64 * wc + 8 * fq;
                        *(u32x4*)p = pack8(o1[0], o1[1]); *(u32x4*)(p + 32) = pack8(o2[0], o2[1]);
                        if (u.pm >= 64) {
                            float* d = nullptr;
                            if (row >= 16384 && row < R_SAMPLE) d = out + O_NKP + (size_t)(row - 16384) * 256;
                            else if (row >= R_SAMPLE && row < R_END) { const int sr = row - R_SAMPLE; d = out + O_NKS + ((size_t)(sr >> 3) * 128 + 120 + (sr & 7)) * 256; }
                            if (d) { d += 64 * wc + 8 * fq; *(f32x4*)d = o1[0]; *(f32x4*)(d + 4) = o1[1]; *(f32x4*)(d + 32) = o2[0]; *(f32x4*)(d + 36) = o2[1]; }
                        }
                    }
                }
        } else if (pn == 5) {
#pragma unroll
            for (int ai = 0; ai < 2; ++ai)
#pragma unroll
                for (int m = 0; m < 4; ++m) {
                    const int row = row0 + ai * 128 + m * 16;
                    float* d = nullptr;
                    if (u.pm >= 64) {
                        if (row >= 16384 && row < R_SAMPLE) d = out + O_NVP + (size_t)(row - 16384) * 256;
                        else if (row >= R_SAMPLE && row < R_END) { const int sr = row - R_SAMPLE; d = out + O_NVS + ((size_t)(sr >> 3) * 128 + 120 + (sr & 7)) * 256; }
                    }
#pragma unroll
                    for (int bj = 0; bj < 2; ++bj)
#pragma unroll
                        for (int n = 0; n < 2; ++n) {
                            const int c = 128 * bj + 32 * wc + 8 * fq + 4 * n; const f32x4 x = acc[ai][bj][m][n];
                            const unsigned p0 = cvt_pk_bf16(x[0], x[1]), p1 = cvt_pk_bf16(x[2], x[3]);
                            bf16_t* vp = Vt + (size_t)c * MROWS + row;
                            vp[0] = (bf16_t)(p0 & 0xffffu); vp[MROWS] = (bf16_t)(p0 >> 16); vp[2 * (size_t)MROWS] = (bf16_t)(p1 & 0xffffu); vp[3 * (size_t)MROWS] = (bf16_t)(p1 >> 16);
                            if (d) *(f32x4*)(d + c) = x;
                        }
                }
        } else if (pn >= 10 && pn < 26) {
            const int ch = 64 * (pn - 10) + 16 * wc + 4 * fq;
#pragma unroll
            for (int ai = 0; ai < 2; ++ai)
#pragma unroll
                for (int m = 0; m < 4; ++m) {
                    const int row = row0 + ai * 128 + m * 16;
                    const f32x4 b = acc[ai][0][m][0], c = acc[ai][0][m][1], hc = acc[ai][1][m][0], zb = acc[ai][1][m][1];
                    const f32x4 uu = c * hc, bz = b * zb * sigm4(zb);
                    u32x2 wu, wb; wu.x = cvt_pk_bf16(uu[0], uu[1]); wu.y = cvt_pk_bf16(uu[2], uu[3]); wb.x = cvt_pk_bf16(bz[0], bz[1]); wb.y = cvt_pk_bf16(bz[2], bz[3]);
                    *(u32x2*)(U + (size_t)row * DM + ch) = wu; *(u32x2*)(BZ + (size_t)row * DM + ch) = wb;
                    if (u.pm >= 64) {
                        if (row == 16510 || row == 16511) *(f32x4*)(out + O_NCP + (size_t)(row - 16510) * DM + ch) = uu;
                        else if (row >= R_SAMPLE && row < R_END && ((row - R_SAMPLE) & 7) >= 6) { const int sr = row - R_SAMPLE; *(f32x4*)(out + O_NCS + ((size_t)(sr >> 3) * 2 + ((sr & 7) - 6)) * DM + ch) = uu; }
                    }
                }
        } else {
            bf16_t* p0 = SZA; bf16_t* p1 = SGA; bf16_t* p2 = SGB;
            asm volatile("" : "+s"(p0), "+s"(p1), "+s"(p2));
            const bool sil = pn < 10;
            bf16_t* base = pn < 10 ? p0 : (pn < 30 ? p1 : p2); const int colt = (pn < 10 ? pn - 6 : (pn < 30 ? pn - 26 : pn - 30)) * 256;
            const int col0 = colt + 32 * wc + 8 * fq;
#pragma unroll
            for (int ai = 0; ai < 2; ++ai)
#pragma unroll
                for (int m = 0; m < 4; ++m) {
                    bf16_t* rowp = base + (size_t)(row0 + ai * 128 + m * 16) * DM + col0;
#pragma unroll
                    for (int bj = 0; bj < 2; ++bj) {
                        const f32x4 v0 = acc[ai][bj][m][0], v1 = acc[ai][bj][m][1];
                        f32x4 s0 = sigm4(v0), s1 = sigm4(v1);
                        if (sil) { s0 = s0 * v0; s1 = s1 * v1; }
                        *(u32x4*)(rowp + bj * 128) = pack8(s0, s1);
                    }
                }
        }
    }
};

struct Epi2 {
    const bf16_t *SGA, *SGB; bf16_t* MIX;
    __device__ __forceinline__ bool keep(const pg8::Unit& u) const { return u.part == 0; }
    __device__ __forceinline__ void operator()(f32x4 (&acc)[2][2][4][2], const pg8::Unit& u, int wr, int wc, int fr, int fq) const {
        const int row0 = u.pm * 256 + wr * 64 + fr, col0 = u.pn * 256 + 32 * wc + 8 * fq;
#pragma unroll
        for (int ai = 0; ai < 2; ++ai)
#pragma unroll
            for (int m = 0; m < 4; ++m) {
                const size_t off = (size_t)(row0 + ai * 128 + m * 16) * DM + col0;
#pragma unroll
                for (int bj = 0; bj < 2; ++bj) {
                    const u32x4 gb = *(const u32x4*)(SGB + off + bj * 128);
                    f32x4 b0 = {bf_lo(gb.x), bf_hi(gb.x), bf_lo(gb.y), bf_hi(gb.y)}, b1 = {bf_lo(gb.z), bf_hi(gb.z), bf_lo(gb.w), bf_hi(gb.w)};
                    if (u.part == 0) {
                        const u32x4 ga = *(const u32x4*)(SGA + off + bj * 128);
                        const f32x4 a0 = {bf_lo(ga.x), bf_hi(ga.x), bf_lo(ga.y), bf_hi(ga.y)}, a1 = {bf_lo(ga.z), bf_hi(ga.z), bf_lo(ga.w), bf_hi(ga.w)};
#pragma unroll
                        for (int e = 0; e < 4; ++e) { acc[ai][bj][m][0][e] *= a0[e] * __builtin_amdgcn_rcpf(b0[e]); acc[ai][bj][m][1][e] *= a1[e] * __builtin_amdgcn_rcpf(b1[e]); }
                    } else {
                        *(u32x4*)(MIX + off + bj * 128) = pack8(acc[ai][bj][m][0] * b0, acc[ai][bj][m][1] * b1);
                    }
                }
            }
    }
};

struct Epi3 {
    const float *xp, *xs; float* y;
    __device__ __forceinline__ bool keep(const pg8::Unit&) const { return false; }
    __device__ __forceinline__ void operator()(f32x4 (&acc)[2][2][4][2], const pg8::Unit& u, int wr, int wc, int fr, int fq) const {
        const int row0 = u.pm * 256 + wr * 64 + fr, col0 = u.pn * 256 + 32 * wc + 8 * fq;
#pragma unroll
        for (int ai = 0; ai < 2; ++ai)
#pragma unroll
            for (int m = 0; m < 4; ++m) {
                const int gr = row0 + ai * 128 + m * 16;
                const float* xr = (gr < 16384 ? xp + (size_t)gr * DM : xs + (size_t)(gr - 16384) * DM) + col0;
                float* yr = y + (size_t)gr * DM + col0;
#pragma unroll
                for (int bj = 0; bj < 2; ++bj)
#pragma unroll
                    for (int n = 0; n < 2; ++n) *(f32x4*)(yr + bj * 128 + 4 * n) = *(const f32x4*)(xr + bj * 128 + 4 * n) + acc[ai][bj][m][n];
            }
    }
};

__device__ __forceinline__ float wave_sum(float v) {
#pragma unroll
    for (int o = 1; o < 64; o <<= 1) v += __shfl_xor(v, o);
    return v;
}
__device__ __forceinline__ int win_orig_col(int n) {
    const int pn = n >> 8, c = n & 255;
    if (pn < 5) { const int bj = c >> 7, wc = (c >> 5) & 3, j = c & 31; return 64 * (4 * pn + wc) + 32 * bj + j; }
    if (pn >= 10 && pn < 26) { const int t = pn - 10, bj = c >> 7, wc = (c >> 5) & 3, fq = (c >> 3) & 3, nn = (c >> 2) & 1, e = c & 3; return 2560 + 1024 * (2 * bj + nn) + 64 * t + 16 * wc + 4 * fq + e; }
    return n;
}
template <bool PERMUTE>
__device__ __forceinline__ void p0_transpose_item(const float* W, int K, int N, bf16_t* WT, LAS float* scr, int item, int lane) {
    const int nblk = N / 32, kb = item / nblk, nb = item % nblk, k0 = 64 * kb, n0 = 32 * nb;
    const int ncol = PERMUTE ? win_orig_col(n0 + (lane & 31)) : n0 + (lane & 31);
    float tv[32];
#pragma unroll
    for (int i = 0; i < 32; ++i) tv[i] = W[(size_t)(k0 + 2 * i + (lane >> 5)) * N + ncol];
#pragma unroll
    for (int i = 0; i < 32; ++i) scr[(2 * i + (lane >> 5)) * 33 + (lane & 31)] = tv[i];
    asm volatile("s_waitcnt lgkmcnt(0)" ::: "memory");
    const int c = lane & 7;
#pragma unroll
    for (int j = 0; j < 4; ++j) { const int n = (lane >> 3) + 8 * j; const LAS float* s = scr + (8 * c) * 33 + n;
        u32x4 o; o.x = cvt_pk_bf16(s[0 * 33], s[1 * 33]); o.y = cvt_pk_bf16(s[2 * 33], s[3 * 33]); o.z = cvt_pk_bf16(s[4 * 33], s[5 * 33]); o.w = cvt_pk_bf16(s[6 * 33], s[7 * 33]);
        *(u32x4*)(WT + (size_t)(n0 + n) * K + k0 + 8 * c) = o; }
    asm volatile("s_waitcnt lgkmcnt(0)" ::: "memory");
}

struct Args { const float* in[15]; float* out; unsigned char* ws; int ph_lo, ph_hi; };

__device__ __forceinline__ void p0_prologue(const Args& a, LAS unsigned char* lds, int tid, int lane, int wave, int G) {
    LAS float* scr = (LAS float*)(lds + wave * 16384);
    const int gw = blockIdx.x * 8 + wave, NGW = G * 8;
    bf16_t* WIN = (bf16_t*)(a.ws + WS_WIN); bf16_t* WA = (bf16_t*)(a.ws + WS_WA); bf16_t* WB = (bf16_t*)(a.ws + WS_WB); bf16_t* WO = (bf16_t*)(a.ws + WS_WO);
    constexpr int I_IN = 16 * (NIN / 32), I_SQ = 16 * 32, NITEMS = I_IN + 3 * I_SQ;
    for (int it = gw; it < NITEMS; it += NGW) {
        int r = it;
        if (r < I_IN) { p0_transpose_item<true>(a.in[7], DM, NIN, WIN, scr, r, lane); continue; } r -= I_IN;
        if (r < I_SQ) { p0_transpose_item<false>(a.in[12], DM, DM, WA, scr, r, lane); continue; } r -= I_SQ;
        if (r < I_SQ) { p0_transpose_item<false>(a.in[13], DM, DM, WB, scr, r, lane); continue; } r -= I_SQ;
        p0_transpose_item<false>(a.in[14], DM, DM, WO, scr, r, lane);
    }
    bf16_t* XN = (bf16_t*)(a.ws + WS_B0);
    const f32x4* nwp = (const f32x4*)a.in[6] + lane;
    f32x4 nw[4];
#pragma unroll
    for (int j = 0; j < 4; ++j) nw[j] = nwp[64 * j];
    for (int m0 = gw; m0 < MROWS; m0 += 4 * NGW) {
        const float* src[4]; f32x4 v[4][4];
#pragma unroll
        for (int q = 0; q < 4; ++q) {
            const int m = m0 + q * NGW; src[q] = nullptr;
            if (m >= R_PROMPT && m < R_SAMPLE) src[q] = a.in[0] + (size_t)(m - R_PROMPT) * DM;
            else if (m >= R_SAMPLE && m < R_END) src[q] = a.in[1] + (size_t)(m - R_SAMPLE) * DM;
            else if (m >= R_META && m < R_PROMPT) src[q] = a.in[5] + (size_t)(m - R_META) * DM;
#pragma unroll
            for (int j = 0; j < 4; ++j) v[q][j] = src[q] ? ((const f32x4*)src[q] + lane)[64 * j] : (f32x4){0.f, 0.f, 0.f, 0.f};
        }
#pragma unroll
        for (int q = 0; q < 4; ++q) {
            const int m = m0 + q * NGW;
            if (m < MROWS) {
                float s2 = 0.f;
#pragma unroll
                for (int j = 0; j < 4; ++j) s2 += (v[q][j].x * v[q][j].x + v[q][j].y * v[q][j].y) + (v[q][j].z * v[q][j].z + v[q][j].w * v[q][j].w);
                const float r = 1.0f / sqrtf(wave_sum(s2) * (1.f / DM) + EPS);
                unsigned long long* o8 = (unsigned long long*)(XN + (size_t)m * DM) + lane;
#pragma unroll
                for (int j = 0; j < 4; ++j) { const f32x4 y = v[q][j] * r * nw[j]; o8[64 * j] = (unsigned long long)cvt_pk_bf16(y.x, y.y) | ((unsigned long long)cvt_pk_bf16(y.z, y.w) << 32); }
            }
        }
    }
    float* rope = (float*)(a.ws + WS_ROPE);
    for (int i = blockIdx.x * 512 + tid; i < NPOS * 32; i += G * 512) {
        const int pos = i >> 5, j = i & 31;
        double invd = 1.0; for (int q = 0; q < j; ++q) invd *= 0.74989420933245582730;
        const float inv = (float)invd; const float angf = (float)pos * inv; const double ang = (double)angf;
        const double kq = __builtin_rint(ang * 0.63661977236758134308); const int qi = (int)kq;
        double rr = __builtin_fma(-kq, 1.57079632679489655800, ang); rr = __builtin_fma(-kq, 6.12323399573676603587e-17, rr);
        const double r2 = rr * rr;
        double sn = r2 * (1.0 / 6227020800.0) - (1.0 / 39916800.0); sn = sn * r2 + (1.0 / 362880.0); sn = sn * r2 - (1.0 / 5040.0); sn = sn * r2 + (1.0 / 120.0); sn = sn * r2 - (1.0 / 6.0); sn = sn * r2 * rr + rr;
        double cs = r2 * (1.0 / 479001600.0) - (1.0 / 3628800.0); cs = cs * r2 + (1.0 / 40320.0); cs = cs * r2 - (1.0 / 720.0); cs = cs * r2 + (1.0 / 24.0); cs = cs * r2 - 0.5; cs = cs * r2 + 1.0;
        double so, co;
        switch (qi & 3) { case 0: so = sn; co = cs; break; case 1: so = cs; co = -sn; break; case 2: so = -sn; co = -cs; break; default: so = -cs; co = sn; break; }
        rope[(size_t)pos * 64 + j] = (float)co; rope[(size_t)pos * 64 + 32 + j] = (float)so;
    }
}

__device__ __forceinline__ int crow(int r, int hi) { return (r & 3) + 8 * (r >> 2) + 4 * hi; }
__device__ __forceinline__ bf16x8 packp(const f32x16& p, int s) {
    u32x4 w; w.x = cvt_pk_bf16(p[8 * s + 0], p[8 * s + 1]); w.y = cvt_pk_bf16(p[8 * s + 2], p[8 * s + 3]); w.z = cvt_pk_bf16(p[8 * s + 4], p[8 * s + 5]); w.w = cvt_pk_bf16(p[8 * s + 6], p[8 * s + 7]);
    return __builtin_bit_cast(bf16x8, w);
}
__device__ __forceinline__ float sink_softmax5(f32x16 (&S)[5], int qcmp, int hi, float sink2, int minkr) {
    const float NEG = -INFINITY;
#pragma unroll
    for (int r = 0; r < 16; ++r) { const int c = crow(r, hi); if (c < qcmp) S[0][r] = NEG; if (c > qcmp) S[4][r] = NEG; }
    if (minkr > 0) {
#pragma unroll
        for (int kb = 0; kb < 5; ++kb)
#pragma unroll
            for (int r = 0; r < 16; ++r) if (32 * kb + crow(r, hi) < minkr) S[kb][r] = NEG;
    }
    float m = sink2;
#pragma unroll
    for (int kb = 0; kb < 5; ++kb)
#pragma unroll
        for (int r = 0; r < 16; ++r) m = fmaxf(m, S[kb][r]);
    m = fmaxf(m, __shfl_xor(m, 32));
    float l = 0.f;
#pragma unroll
    for (int kb = 0; kb < 5; ++kb)
#pragma unroll
        for (int r = 0; r < 16; ++r) { const float p = __builtin_amdgcn_exp2f(S[kb][r] - m); S[kb][r] = p; l += p; }
    l += __shfl_xor(l, 32);
    l += __builtin_amdgcn_exp2f(sink2 - m);
    return 1.0f / l;
}
__device__ __forceinline__ void attn_store(const f32x16 (&O)[2], float inv_l, int row, int head, int hi, const bf16_t* SZA, bf16_t* QA) {
#pragma unroll
    for (int blk = 0; blk < 2; ++blk)
#pragma unroll
        for (int rr = 0; rr < 4; ++rr) {
            const size_t off = (size_t)row * DM + 64 * head + 32 * blk + 8 * rr + 4 * hi;
            const u32x2 z = *(const u32x2*)(SZA + off);
            u32x2 w; w.x = cvt_pk_bf16(O[blk][4 * rr] * inv_l * bf_lo(z.x), O[blk][4 * rr + 1] * inv_l * bf_hi(z.x)); w.y = cvt_pk_bf16(O[blk][4 * rr + 2] * inv_l * bf_lo(z.y), O[blk][4 * rr + 3] * inv_l * bf_hi(z.y));
            *(u32x2*)(QA + off) = w;
        }
}

__device__ __forceinline__ void attn_prompt_all(LAS unsigned char* lds, int tid, int id0, int G, const bf16_t* Kb, const bf16_t* Vt, bf16_t* QA, const bf16_t* SZA, const float* sinks) {
    const int lane = tid & 63, wid = __builtin_amdgcn_readfirstlane(tid >> 6), ql = lane & 31, hi = lane >> 5;
    LAS unsigned char* Ks = lds; LAS unsigned char* Vs = lds + 27648;
    const int i0 = 32 * (wid & 1);
    u32x4 kst[3], vst[3]; bf16x8 qn[4];
#define ATT_FETCH(id_) do { const int n_ = 1 + ((id_) >> 3), g_ = ((id_) >> 1) & 3, kbase_ = 128 * (n_ - 1) + 64 * ((id_) & 1); \
        _Pragma("unroll") for (int i = 0; i < 3; ++i) { const int ch = tid + 512 * i; \
            { const int row = ch >> 3, c = ch & 7; kst[i] = *(const u32x4*)(Kb + (size_t)(kbase_ + row) * 256 + g_ * 64 + c * 8); } \
            { const int d = ch / 24, c = ch - d * 24; vst[i] = *(const u32x4*)(Vt + (size_t)(g_ * 64 + d) * MROWS + kbase_ + c * 8); } } \
        const int qrow_ = kbase_ + 128 + i0 + ql, hq_ = 4 * g_ + (wid >> 1); \
        _Pragma("unroll") for (int d0 = 0; d0 < 4; ++d0) qn[d0] = *(const bf16x8*)(QA + (size_t)qrow_ * DM + 64 * hq_ + 16 * d0 + 8 * hi); } while (0)
    int id = id0;
    if (id < 1024) ATT_FETCH(id);
    for (; id < 1024; id += G) {
        const int n = 1 + (id >> 3), g = (id >> 1) & 3, half = id & 1;
        const int kbase = 128 * (n - 1) + 64 * half;
#pragma unroll
        for (int i = 0; i < 3; ++i) {
            const int ch = tid + 512 * i;
            { const int row = ch >> 3, c = ch & 7; *(LAS u32x4*)(Ks + row * 144 + c * 16) = kst[i]; }
            { const int d = ch / 24, c = ch - d * 24; LAS u32x2* p = (LAS u32x2*)(Vs + d * 392 + c * 16); p[0] = (u32x2){vst[i].x, vst[i].y}; p[1] = (u32x2){vst[i].z, vst[i].w}; }
        }
        const int hq = 4 * g + (wid >> 1);
        const int qrow = kbase + 128 + i0 + ql;
        bf16x8 qr[4];
#pragma unroll
        for (int d0 = 0; d0 < 4; ++d0) qr[d0] = qn[d0];
        const float sink2 = sinks[hq] * LOG2E;
        __syncthreads();
        if (id + G < 1024) ATT_FETCH(id + G);
        f32x16 S[5];
#pragma unroll
        for (int kb = 0; kb < 5; ++kb) {
            S[kb] = (f32x16){};
#pragma unroll
            for (int d0 = 0; d0 < 4; ++d0) { const bf16x8 a = *(const LAS bf16x8*)(Ks + (i0 + 32 * kb + ql) * 144 + (16 * d0 + 8 * hi) * 2); S[kb] = __builtin_amdgcn_mfma_f32_32x32x16_bf16(a, qr[d0], S[kb], 0, 0, 0); }
        }
        const float inv_l = sink_softmax5(S, ql, hi, sink2, R_META - (kbase + i0));
        f32x16 O[2]; O[0] = (f32x16){}; O[1] = (f32x16){};
#pragma unroll
        for (int kb = 0; kb < 5; ++kb)
#pragma unroll
            for (int s = 0; s < 2; ++s) {
                const bf16x8 pb = packp(S[kb], s);
#pragma unroll
                for (int blk = 0; blk < 2; ++blk) {
                    const LAS unsigned char* vp = Vs + (32 * blk + ql) * 392 + (i0 + 32 * kb + 16 * s + 4 * hi) * 2;
                    const u32x2 lo = *(const LAS u32x2*)vp, hh = *(const LAS u32x2*)(vp + 16);
                    const u32x4 av = {lo.x, lo.y, hh.x, hh.y};
                    O[blk] = __builtin_amdgcn_mfma_f32_32x32x16_bf16(__builtin_bit_cast(bf16x8, av), pb, O[blk], 0, 0, 0);
                }
            }
#pragma unroll
        for (int blk = 0; blk < 2; ++blk)
#pragma unroll
            for (int rr = 0; rr < 4; ++rr) {
                const size_t off = (size_t)qrow * DM + 64 * hq + 32 * blk + 8 * rr + 4 * hi; const u32x2 z = *(const u32x2*)(SZA + off);
                u32x2 w; w.x = cvt_pk_bf16(O[blk][4 * rr] * inv_l * bf_lo(z.x), O[blk][4 * rr + 1] * inv_l * bf_hi(z.x)); w.y = cvt_pk_bf16(O[blk][4 * rr + 2] * inv_l * bf_lo(z.y), O[blk][4 * rr + 3] * inv_l * bf_hi(z.y));
                *(u32x2*)(QA + off) = w;
            }
        __syncthreads();
    }
#undef ATT_FETCH
}

__device__ __forceinline__ bf16x8 cvt8(const f32x4 a, const f32x4 b) { return __builtin_bit_cast(bf16x8, pack8(a, b)); }

__device__ __forceinline__ void attn_sample_unit(int b, int g, int hh, int lane, const float* ck, const float* cv, const bf16_t* Kb, const bf16_t* Vt, bf16_t* QA, const bf16_t* SZA, const float* sinks, float* out) {
    const int ql = lane & 31, hi = lane >> 5, t = ql & 7; const bool cp = (hh == 0);
    const int row = R_SAMPLE + 8 * b + t, head = 4 * g + hh;
    bf16x8 qr[4];
#pragma unroll
    for (int d0 = 0; d0 < 4; ++d0) qr[d0] = *(const bf16x8*)(QA + (size_t)row * DM + 64 * head + 16 * d0 + 8 * hi);
    const float sink2 = sinks[head] * LOG2E;
    const float* ckb = ck + (size_t)b * 128 * 256 + g * 64; const float* cvb = cv + (size_t)b * 128 * 256 + g * 64;
    float* oks = out + O_NKS + (size_t)b * 128 * 256 + g * 64; float* ovs = out + O_NVS + (size_t)b * 128 * 256 + g * 64;
    float m = sink2, l = hi ? 0.f : 1.f;
    f32x16 O[2]; O[0] = (f32x16){}; O[1] = (f32x16){};
    const float NEG = -INFINITY;
#pragma unroll 1
    for (int kb = 0; kb < 5; ++kb) {
        f32x16 S = (f32x16){};
        if (kb < 4) {
            const int s = 32 * kb + ql;
#pragma unroll
            for (int d0 = 0; d0 < 4; ++d0) {
                const float* p = ckb + (size_t)s * 256 + 16 * d0 + 8 * hi; const f32x4 x0 = *(const f32x4*)p, x1 = *(const f32x4*)(p + 4);
                if (cp && s >= 8) { float* o = oks + (size_t)(s - 8) * 256 + 16 * d0 + 8 * hi; *(f32x4*)o = x0; *(f32x4*)(o + 4) = x1; }
                S = __builtin_amdgcn_mfma_f32_32x32x16_bf16(cvt8(x0, x1), qr[d0], S, 0, 0, 0);
            }
        } else {
#pragma unroll
            for (int d0 = 0; d0 < 4; ++d0) {
                u32x4 kv = {0u, 0u, 0u, 0u};
                if (ql < 8) kv = *(const u32x4*)(Kb + (size_t)(R_SAMPLE + 8 * b + ql) * 256 + g * 64 + 16 * d0 + 8 * hi);
                S = __builtin_amdgcn_mfma_f32_32x32x16_bf16(__builtin_bit_cast(bf16x8, kv), qr[d0], S, 0, 0, 0);
            }
        }
        if (kb == 0) {
#pragma unroll
            for (int r = 0; r < 16; ++r) if (crow(r, hi) < t) S[r] = NEG;
        }
        if (kb == 4) {
#pragma unroll
            for (int r = 0; r < 16; ++r) if (crow(r, hi) > t) S[r] = NEG;
        }
        float mb = S[0];
#pragma unroll
        for (int r = 1; r < 16; ++r) mb = fmaxf(mb, S[r]);
        mb = fmaxf(mb, __shfl_xor(mb, 32));
        const float mn = fmaxf(m, mb), alpha = __builtin_amdgcn_exp2f(m - mn); m = mn;
        float ps = 0.f;
#pragma unroll
        for (int r = 0; r < 16; ++r) { const float p = __builtin_amdgcn_exp2f(S[r] - mn); S[r] = p; ps += p; }
        l = l * alpha + ps;
        O[0] = O[0] * alpha; O[1] = O[1] * alpha;
        if (kb < 4) {
#pragma unroll
            for (int s2 = 0; s2 < 2; ++s2) {
                const bf16x8 pb = packp(S, s2);
#pragma unroll
                for (int blk = 0; blk < 2; ++blk) {
                    const int d = 32 * blk + ql;
                    f32x4 v0, v1;
                    const int kk = 32 * kb + 16 * s2 + 4 * hi;
                    const float* vsrc = cvb + (size_t)kk * 256 + d; float* vdst = ovs + (size_t)kk * 256 + d - 8 * 256;
                    v0.x = vsrc[0]; v0.y = vsrc[256]; v0.z = vsrc[512]; v0.w = vsrc[768]; v1.x = vsrc[2048]; v1.y = vsrc[2304]; v1.z = vsrc[2560]; v1.w = vsrc[2816];
                    if (cp && kk >= 8) { vdst[0] = v0.x; vdst[256] = v0.y; vdst[512] = v0.z; vdst[768] = v0.w; }
                    if (cp) { vdst[2048] = v1.x; vdst[2304] = v1.y; vdst[2560] = v1.z; vdst[2816] = v1.w; }
                    O[blk] = __builtin_amdgcn_mfma_f32_32x32x16_bf16(cvt8(v0, v1), pb, O[blk], 0, 0, 0);
                }
            }
        } else {
            const bf16x8 pb = packp(S, 0);
#pragma unroll
            for (int blk = 0; blk < 2; ++blk) {
                const int d = 32 * blk + ql;
                const u32x2 lo = *(const u32x2*)(Vt + (size_t)(g * 64 + d) * MROWS + R_SAMPLE + 8 * b + 4 * hi);
                const u32x4 av = {lo.x, lo.y, 0u, 0u};
                O[blk] = __builtin_amdgcn_mfma_f32_32x32x16_bf16(__builtin_bit_cast(bf16x8, av), pb, O[blk], 0, 0, 0);
            }
        }
    }
    l += __shfl_xor(l, 32);
    if (ql < 8) attn_store(O, 1.0f / l, row, head, hi, SZA, QA);
}

__device__ __forceinline__ void attn_sample_wg(LAS unsigned char* lds, int tid, int id, const float* ck, const float* cv, const bf16_t* Kb, const bf16_t* Vt, bf16_t* QA, const bf16_t* SZA, const float* sinks, float* out) {
    const int lane = tid & 63, wid = __builtin_amdgcn_readfirstlane(tid >> 6), ql = lane & 31, hi = lane >> 5, t = ql & 7;
    const int b = id >> 1, gp = id & 1;
    constexpr int KSG = 160 * 144, VSG = 64 * 328;
    LAS unsigned char* Ks = lds; LAS unsigned char* Vs = lds + 2 * KSG;
    const float* ckb = ck + (size_t)b * 128 * 256 + gp * 128; const float* cvb = cv + (size_t)b * 128 * 256 + gp * 128;
    float* oks = out + O_NKS + (size_t)b * 128 * 256 + gp * 128; float* ovs = out + O_NVS + (size_t)b * 128 * 256 + gp * 128;
#pragma unroll
    for (int i = 0; i < 8; ++i) {
        const int idx = tid + 512 * i, srow = idx >> 5, c4 = idx & 31, gl = c4 >> 4, d = (c4 & 15) * 4;
        const f32x4 k4 = *(const f32x4*)(ckb + (size_t)srow * 256 + c4 * 4), v4 = *(const f32x4*)(cvb + (size_t)srow * 256 + c4 * 4);
        if (srow >= 8) { *(f32x4*)(oks + (size_t)(srow - 8) * 256 + c4 * 4) = k4; *(f32x4*)(ovs + (size_t)(srow - 8) * 256 + c4 * 4) = v4; }
        u32x2 kw; kw.x = cvt_pk_bf16(k4.x, k4.y); kw.y = cvt_pk_bf16(k4.z, k4.w);
        *(LAS u32x2*)(Ks + gl * KSG + srow * 144 + d * 2) = kw;
        const unsigned v01 = cvt_pk_bf16(v4.x, v4.y), v23 = cvt_pk_bf16(v4.z, v4.w);
        LAS bf16_t* vp = (LAS bf16_t*)(Vs + gl * VSG + d * 328 + srow * 2);
        vp[0] = (bf16_t)(v01 & 0xffffu); vp[164] = (bf16_t)(v01 >> 16); vp[328] = (bf16_t)(v23 & 0xffffu); vp[492] = (bf16_t)(v23 >> 16);
    }
    if (tid < 128) {
        const int j = tid >> 4, c8 = tid & 15, gl = c8 >> 3, d = (c8 & 7) * 8;
        *(LAS u32x4*)(Ks + gl * KSG + (128 + j) * 144 + d * 2) = *(const u32x4*)(Kb + (size_t)(R_SAMPLE + 8 * b + j) * 256 + (2 * gp + gl) * 64 + d);
    } else if (tid < 256) {
        const int gl = (tid - 128) >> 6, d = (tid - 128) & 63;
        const u32x4 v = *(const u32x4*)(Vt + (size_t)((2 * gp + gl) * 64 + d) * MROWS + R_SAMPLE + 8 * b);
        LAS u32x2* p = (LAS u32x2*)(Vs + gl * VSG + d * 328 + 256); p[0] = (u32x2){v.x, v.y}; p[1] = (u32x2){v.z, v.w};
    } else if (tid < 384) {
        const int gl = (tid - 256) >> 6, d = (tid - 256) & 63;
        LAS u32x2* p = (LAS u32x2*)(Vs + gl * VSG + d * 328 + 272);
#pragma unroll
        for (int q = 0; q < 6; ++q) p[q] = (u32x2){0u, 0u};
    }
    const int gl = wid >> 2, hh = wid & 3, head = 4 * (2 * gp + gl) + hh, row = R_SAMPLE + 8 * b + t;
    bf16x8 qr[4];
#pragma unroll
    for (int d0 = 0; d0 < 4; ++d0) qr[d0] = *(const bf16x8*)(QA + (size_t)row * DM + 64 * head + 16 * d0 + 8 * hi);
    const float sink2 = sinks[head] * LOG2E;
    __syncthreads();
    const LAS unsigned char* Kg = Ks + gl * KSG; const LAS unsigned char* Vg = Vs + gl * VSG;
    f32x16 S[5];
#pragma unroll
    for (int kb = 0; kb < 5; ++kb) {
        S[kb] = (f32x16){};
#pragma unroll
        for (int d0 = 0; d0 < 4; ++d0) { const bf16x8 a = *(const LAS bf16x8*)(Kg + (32 * kb + ql) * 144 + (16 * d0 + 8 * hi) * 2); S[kb] = __builtin_amdgcn_mfma_f32_32x32x16_bf16(a, qr[d0], S[kb], 0, 0, 0); }
    }
    const float inv_l = sink_softmax5(S, t, hi, sink2, 0);
    f32x16 O[2]; O[0] = (f32x16){}; O[1] = (f32x16){};
#pragma unroll
    for (int kb = 0; kb < 5; ++kb)
#pragma unroll
        for (int s2 = 0; s2 < 2; ++s2) {
            const bf16x8 pb = packp(S[kb], s2);
#pragma unroll
            for (int blk = 0; blk < 2; ++blk) {
                const LAS unsigned char* vp = Vg + (32 * blk + ql) * 328 + (32 * kb + 16 * s2 + 4 * hi) * 2;
                const u32x2 lo = *(const LAS u32x2*)vp, h2 = *(const LAS u32x2*)(vp + 16);
                const u32x4 av = {lo.x, lo.y, h2.x, h2.y};
                O[blk] = __builtin_amdgcn_mfma_f32_32x32x16_bf16(__builtin_bit_cast(bf16x8, av), pb, O[blk], 0, 0, 0);
            }
        }
    if (ql < 8) attn_store(O, inv_l, row, head, hi, SZA, QA);
    __syncthreads();
}

__device__ __forceinline__ void conv_pass(int gtid, int nthr, int item_lo, int item_hi, const bf16_t* U, bf16_t* BZ, const float* cw, const float* state) {
    const int ch = (gtid & 127) * 8;
    float w0[8], w1[8], w2[8];
#pragma unroll
    for (int e = 0; e < 8; ++e) { w0[e] = cw[ch + e]; w1[e] = cw[DM + ch + e]; w2[e] = cw[2 * DM + ch + e]; }
    for (int item = item_lo + (gtid >> 7); item < item_hi; item += nthr >> 7) {
        const int r0 = R_PROMPT + 8 * item;
        float um2[8], um1[8];
        if (r0 < R_SAMPLE) {
            const u32x4 a = *(const u32x4*)(U + (size_t)(r0 - 2) * DM + ch), b = *(const u32x4*)(U + (size_t)(r0 - 1) * DM + ch);
            um2[0] = bf_lo(a.x); um2[1] = bf_hi(a.x); um2[2] = bf_lo(a.y); um2[3] = bf_hi(a.y); um2[4] = bf_lo(a.z); um2[5] = bf_hi(a.z); um2[6] = bf_lo(a.w); um2[7] = bf_hi(a.w);
            um1[0] = bf_lo(b.x); um1[1] = bf_hi(b.x); um1[2] = bf_lo(b.y); um1[3] = bf_hi(b.y); um1[4] = bf_lo(b.z); um1[5] = bf_hi(b.z); um1[6] = bf_lo(b.w); um1[7] = bf_hi(b.w);
        } else {
            const float* st = state + (size_t)((r0 - R_SAMPLE) >> 3) * 2 * DM + ch;
#pragma unroll
            for (int e = 0; e < 8; ++e) { um2[e] = st[e]; um1[e] = st[DM + e]; }
        }
#pragma unroll
        for (int i = 0; i < 8; ++i) {
            const size_t off = (size_t)(r0 + i) * DM + ch;
            const u32x4 a = *(const u32x4*)(U + off), z = *(const u32x4*)(BZ + off);
            float uc[8], bz[8], o[8];
            uc[0] = bf_lo(a.x); uc[1] = bf_hi(a.x); uc[2] = bf_lo(a.y); uc[3] = bf_hi(a.y); uc[4] = bf_lo(a.z); uc[5] = bf_hi(a.z); uc[6] = bf_lo(a.w); uc[7] = bf_hi(a.w);
            bz[0] = bf_lo(z.x); bz[1] = bf_hi(z.x); bz[2] = bf_lo(z.y); bz[3] = bf_hi(z.y); bz[4] = bf_lo(z.z); bz[5] = bf_hi(z.z); bz[6] = bf_lo(z.w); bz[7] = bf_hi(z.w);
#pragma unroll
            for (int e = 0; e < 8; ++e) { o[e] = bz[e] * (w0[e] * um2[e] + w1[e] * um1[e] + w2[e] * uc[e]); um2[e] = um1[e]; um1[e] = uc[e]; }
            u32x4 w; w.x = cvt_pk_bf16(o[0], o[1]); w.y = cvt_pk_bf16(o[2], o[3]); w.z = cvt_pk_bf16(o[4], o[5]); w.w = cvt_pk_bf16(o[6], o[7]);
            *(u32x4*)(BZ + off) = w;
        }
    }
}


#define XB_TMO      128
#define XB_XCNT(j)  (256  + 64 * (j))
#define XB_XSUB(j)  (1280 + 64 * (j))
#define XB_XGEN(j)  (2304 + 64 * (j))
#define XB_TOP      3328
#define XB_TOPGEN   3392
#define XCD_BAR_WORDS 3456
#define XB_SPIN_CAP (1u << 18)
__device__ __forceinline__ unsigned xb_ld(unsigned* p)              { return __hip_atomic_load(p, __ATOMIC_RELAXED, __HIP_MEMORY_SCOPE_AGENT); }
__device__ __forceinline__ unsigned xb_add(unsigned* p, unsigned v) { return __hip_atomic_fetch_add(p, v, __ATOMIC_RELAXED, __HIP_MEMORY_SCOPE_AGENT); }
__device__ __forceinline__ unsigned xb_xcc_id() { return (unsigned)__builtin_amdgcn_s_getreg((3 << 11) | 20) & 0xFu; }
#define XB_SPIN(cond, bar) do { unsigned _sp = 0; while (cond) { __builtin_amdgcn_s_sleep(1); \
    if ((++_sp & 255u) == 0u) { if (xb_ld(&(bar)[XB_TMO])) break; if (_sp > XB_SPIN_CAP) { atomicAdd(&(bar)[XB_TMO], 1u); break; } } } } while (0)
struct XcdBarrier { unsigned* bar; unsigned x; volatile LAS unsigned* st; };
__device__ __forceinline__ XcdBarrier xcd_barrier_post(unsigned* bar, volatile LAS unsigned* st) {
    XcdBarrier b; b.bar = bar; b.x = xb_xcc_id(); b.st = st;
    if (threadIdx.x == 0) (void)xb_add(&bar[XB_XCNT(b.x)], 1u);
    return b;
}
__device__ __forceinline__ void xcd_barrier_complete(unsigned* bar, unsigned x, unsigned& nloc, unsigned& nx) {
    const unsigned G = gridDim.x * gridDim.y * gridDim.z;
    unsigned sum, cnt, mine, sp = 0u;
    for (;;) {
        sum = 0u; cnt = 0u; mine = 0u;
#pragma unroll
        for (unsigned j = 0; j < 16; ++j) { const unsigned c = xb_ld(&bar[XB_XCNT(j)]); sum += c; cnt += (c > 0u) ? 1u : 0u; mine = (j == x) ? c : mine; }
        if (sum == G) break;
        __builtin_amdgcn_s_sleep(1);
        if ((++sp & 255u) == 0u) { if (xb_ld(&bar[XB_TMO])) break; if (sp > XB_SPIN_CAP) { atomicAdd(&bar[XB_TMO], 1u); break; } }
    }
    nloc = mine > 0u ? mine : 1u; nx = cnt > 0u ? cnt : 1u;
}
__device__ __forceinline__ void xcd_barrier(const XcdBarrier& b) {
    asm volatile("s_waitcnt vmcnt(0)" ::: "memory");
    __syncthreads();
    if (threadIdx.x == 0) {
        unsigned* bar = b.bar;
        __builtin_amdgcn_s_waitcnt(0);
        unsigned nloc = b.st[0], nx = b.st[1];
        if (nloc == 0u) { xcd_barrier_complete(bar, b.x, nloc, nx); b.st[0] = nloc; b.st[1] = nx; }
        const unsigned old = xb_add(&bar[XB_XSUB(b.x)], 1u);
        const unsigned gen = old / nloc;
        if (old + 1u == (gen + 1u) * nloc) {
            __builtin_amdgcn_fence(__ATOMIC_RELEASE, "agent");
            asm volatile("s_waitcnt vmcnt(0)" ::: "memory");
            const unsigned og = xb_add(&bar[XB_TOP], 1u);
            const unsigned tg = og / nx;
            if (og + 1u == (tg + 1u) * nx) xb_add(&bar[XB_TOPGEN], 1u);
            else XB_SPIN(xb_ld(&bar[XB_TOPGEN]) == tg, bar);
            __builtin_amdgcn_fence(__ATOMIC_ACQUIRE, "agent");
            xb_add(&bar[XB_XGEN(b.x)], 1u);
            asm volatile("s_waitcnt vmcnt(0)" ::: "memory");
        } else {
            XB_SPIN(xb_ld(&bar[XB_XGEN(b.x)]) == gen, bar);
            __builtin_amdgcn_fence(__ATOMIC_ACQUIRE, "agent");
            asm volatile("s_waitcnt vmcnt(0)" ::: "memory");
        }
    }
    __syncthreads();
}

__device__ __forceinline__ void sub_barrier(unsigned* word, unsigned nwg) {
    asm volatile("s_waitcnt vmcnt(0)" ::: "memory");
    __syncthreads();
    if (threadIdx.x == 0) {
        __builtin_amdgcn_s_waitcnt(0);
        __builtin_amdgcn_fence(__ATOMIC_RELEASE, "agent");
        asm volatile("s_waitcnt vmcnt(0)" ::: "memory");
        xb_add(word, 1u);
        unsigned sp = 0; while (xb_ld(word) < nwg) { __builtin_amdgcn_s_sleep(1); if (++sp > (1u << 22)) break; }
        __builtin_amdgcn_fence(__ATOMIC_ACQUIRE, "agent");
        asm volatile("s_waitcnt vmcnt(0)" ::: "memory");
    }
    __syncthreads();
}

typedef const __attribute__((address_space(4))) Args* CArgs;
__device__ __forceinline__ CArgs fresh_args() { CArgs p = (CArgs)__builtin_amdgcn_kernarg_segment_ptr(); asm volatile("" : "+s"(p)); return p; }
#define PTRS() CArgs A = fresh_args(); unsigned char* ws = A->ws; \
    bf16_t* XN = (bf16_t*)(ws + WS_B0); bf16_t* QA = (bf16_t*)(ws + WS_QA); bf16_t* BZ = (bf16_t*)(ws + WS_BZ); bf16_t* SZA = (bf16_t*)(ws + WS_SZA); \
    bf16_t* Ub = (bf16_t*)(ws + WS_U); bf16_t* SGB = (bf16_t*)(ws + WS_SGB); bf16_t* Kb = (bf16_t*)(ws + WS_K); bf16_t* Vt = (bf16_t*)(ws + WS_VT); \
    bf16_t* SGA = (bf16_t*)A->out; float* rope = (float*)(ws + WS_ROPE); \
    (void)XN; (void)QA; (void)BZ; (void)SZA; (void)Ub; (void)SGB; (void)Kb; (void)Vt; (void)SGA; (void)rope
#define G2_DECL() const pg8::Gemm g2{QA + (size_t)R_PROMPT * DM, (const bf16_t*)(ws + WS_WA), M23, DM, DM, BUFB, 2097152}; const Epi2 E2{SGA + (size_t)R_PROMPT * DM, SGB + (size_t)R_PROMPT * DM, XN}
#define G3_DECL() const pg8::Gemm g3{XN, (const bf16_t*)(ws + WS_WO), M23, DM, DM, 0, 0}; const Epi3 E3{A->in[0], A->in[1], A->out + O_Y}
__global__ void __launch_bounds__(512, 2) hybrid_fwd(Args a_unused) {
    extern __shared__ __attribute__((aligned(16))) unsigned char lds_raw[];
    LAS unsigned char* lds = (LAS unsigned char*)lds_raw;
    const int G = gridDim.x;
#define TIDS() int tid = threadIdx.x; asm volatile("" : "+v"(tid)); const int lane = tid & 63, wave = __builtin_amdgcn_readfirstlane(tid >> 6); (void)lane; (void)wave
#define GSYNC() xcd_barrier(xbar)
    volatile LAS unsigned* MISC = (volatile LAS unsigned*)(lds + 131072);
    if (threadIdx.x < 4) MISC[threadIdx.x] = 0u;
    __syncthreads();
    XcdBarrier xbar;
    { CArgs A = fresh_args(); xbar = xcd_barrier_post((unsigned*)(A->ws + WS_CTL), MISC);
      if (A->ph_lo > 1000) cg::this_grid().sync(); }
    const bool split = (G >= 64);
    constexpr int NSPL = 16;
    { TIDS(); CArgs A = fresh_args(); Args pa; pa.in[0] = A->in[0]; pa.in[1] = A->in[1]; pa.in[5] = A->in[5]; pa.in[6] = A->in[6]; pa.in[7] = A->in[7]; pa.in[12] = A->in[12]; pa.in[13] = A->in[13]; pa.in[14] = A->in[14]; pa.ws = A->ws; p0_prologue(pa, lds, tid, lane, wave, G); }
    GSYNC();
    {
        PTRS();
        pg8::Gemm g{XN, (const bf16_t*)(ws + WS_WIN), MROWS, NIN, DM, 0, 0}; pg8::StaticOrder S; S.init(split ? 58 * 256 : MROWS, NIN, G, (int)blockIdx.x, 1); S.special = split ? 1 : 0;
        Epi1 E{QA, Kb, Vt, SZA, BZ, Ub, SGA, SGB, rope, A->in[8], A->in[9], A->out};
        pg8::gemm_phase<Epi1>(lds, g, S, E);
    }
    GSYNC();
    {
        TIDS(); PTRS();
        for (int id = blockIdx.x; id < 256; id += G) attn_sample_wg(lds, tid, id, A->in[2], A->in[3], Kb, Vt, QA, SZA, A->in[10], A->out);
        conv_pass(blockIdx.x * 512 + tid, G * 512, 2048, M23 / 8, Ub, BZ, A->in[11], A->in[4]);
    }
    GSYNC();
#if CHAIN_LATE
    if (split && blockIdx.x < NSPL) {
#else
    if (split && blockIdx.x < NSPL) {
#endif
#if !CHAIN_LATE
        { PTRS(); G2_DECL(); pg8::StaticOrder S; S.init(M23, DM, G, (int)blockIdx.x, 2, 256 + (int)blockIdx.x); pg8::gemm_phase<Epi2>(lds, g2, S, E2); }
        { CArgs A = fresh_args(); sub_barrier((unsigned*)(A->ws + WS_CTL) + 8192, NSPL); }
        { PTRS(); G3_DECL(); pg8::StaticOrder S; S.init(M23, DM, G, (int)blockIdx.x, 1, 256 + (int)blockIdx.x); pg8::gemm_phase<Epi3>(lds, g3, S, E3); }
#if REP_MASK & 64
        { CArgs A = fresh_args(); sub_barrier((unsigned*)(A->ws + WS_CTL) + 8192 + 64, NSPL); }
        { PTRS(); G2_DECL(); pg8::StaticOrder S; S.init(M23, DM, G, (int)blockIdx.x, 2, 256 + (int)blockIdx.x); pg8::gemm_phase<Epi2>(lds, g2, S, E2); }
        { CArgs A = fresh_args(); sub_barrier((unsigned*)(A->ws + WS_CTL) + 8192 + 128, NSPL); }
        { PTRS(); G3_DECL(); pg8::StaticOrder S; S.init(M23, DM, G, (int)blockIdx.x, 1, 256 + (int)blockIdx.x); pg8::gemm_phase<Epi3>(lds, g3, S, E3); }
#endif
#endif
    } else {
        TIDS(); PTRS();
        const int vc = split ? (int)blockIdx.x - NSPL : (int)blockIdx.x, VG = split ? G - NSPL : G;
        if (split && vc < 42) {
            const int dpm = vc < 40 ? 58 + (vc >> 3) : 63, dpn = vc < 40 ? 26 + (vc & 7) : 32 + (vc - 40);
            pg8::Gemm g{XN, (const bf16_t*)(ws + WS_WIN), MROWS, NIN, DM, 0, 0}; pg8::StaticOrder S; S.init(MROWS, NIN, G, (int)blockIdx.x, 1, dpm * 34 + dpn);
            Epi1 E{QA, Kb, Vt, SZA, BZ, Ub, SGA, SGB, rope, A->in[8], A->in[9], A->out};
            pg8::gemm_phase<Epi1>(lds, g, S, E);
        }
        attn_prompt_all(lds, tid, vc, VG, Kb, Vt, QA, SZA, A->in[10]);
        conv_pass(vc * 512 + tid, VG * 512, 0, 2048, Ub, BZ, A->in[11], A->in[4]);
    }
    GSYNC();
#if CHAIN_LATE
    if (split && blockIdx.x < NSPL) {
        { PTRS(); G2_DECL(); pg8::StaticOrder S; S.init(M23, DM, G, (int)blockIdx.x, 2, 256 + (int)blockIdx.x); pg8::gemm_phase<Epi2>(lds, g2, S, E2); }
        { CArgs A = fresh_args(); sub_barrier((unsigned*)(A->ws + WS_CTL) + 8192, NSPL); }
        { PTRS(); G3_DECL(); pg8::StaticOrder S; S.init(M23, DM, G, (int)blockIdx.x, 1, 256 + (int)blockIdx.x); pg8::gemm_phase<Epi3>(lds, g3, S, E3); }
    }
    GSYNC();
#endif
    { PTRS(); G2_DECL(); pg8::StaticOrder S; S.init(split ? 16384 : M23, DM, G, (int)blockIdx.x, 2); pg8::gemm_phase<Epi2>(lds, g2, S, E2); }
    GSYNC();
#if REP_MASK & 8
    { PTRS(); G2_DECL(); pg8::StaticOrder S; S.init(split ? 16384 : M23, DM, G, (int)blockIdx.x, 2); pg8::gemm_phase<Epi2>(lds, g2, S, E2); }
    GSYNC();
#endif
    { PTRS(); G3_DECL(); pg8::StaticOrder S; S.init(split ? 16384 : M23, DM, G, (int)blockIdx.x, 1); pg8::gemm_phase<Epi3>(lds, g3, S, E3); }
#if REP_MASK & 16
    GSYNC();
    { PTRS(); G3_DECL(); pg8::StaticOrder S; S.init(split ? 16384 : M23, DM, G, (int)blockIdx.x, 1); pg8::gemm_phase<Epi3>(lds, g3, S, E3); }
#endif
#undef GSYNC
}

#ifndef DBG_DUMP
#define DBG_DUMP 0
#endif
__global__ void dbg_dump(const bf16_t* src, float* dst, size_t n) {
    for (size_t i = (size_t)blockIdx.x * blockDim.x + threadIdx.x; i < n; i += (size_t)gridDim.x * blockDim.x) dst[i] = __uint_as_float((unsigned)src[i] << 16);
}
extern "C" void kernel_launch(void* const* d_in, const int* in_sizes, int n_in, void* d_out, int out_size, void* d_ws, size_t ws_size, hipStream_t stream) {
    static int grid = 0;
    if (grid == 0) {
        int dev = 0, cus = 0, per_cu = 0;
        if (n_in != 15 || ws_size < WS_END) { fprintf(stderr, "kernel_launch: unexpected inputs (n_in %d, ws %zu)\n", n_in, ws_size); grid = -1; return; }
        if (hipGetDevice(&dev) != hipSuccess || hipDeviceGetAttribute(&cus, hipDeviceAttributeMultiprocessorCount, dev) != hipSuccess) { grid = -1; return; }
        if (hipFuncSetAttribute((const void*)hybrid_fwd, hipFuncAttributeMaxDynamicSharedMemorySize, LDS_BYTES) != hipSuccess) { fprintf(stderr, "kernel_launch: hipFuncSetAttribute failed\n"); grid = -1; return; }
        if (hipOccupancyMaxActiveBlocksPerMultiprocessor(&per_cu, (const void*)hybrid_fwd, 512, LDS_BYTES) != hipSuccess || per_cu < 1) { fprintf(stderr, "kernel_launch: occupancy query gives %d\n", per_cu); per_cu = 1; }
        (void)hipGetLastError();
        grid = cus * 1;
    }
    if (grid < 0) return;
    Args a{};
    for (int i = 0; i < 15; ++i) a.in[i] = (const float*)d_in[i];
    a.out = (float*)d_out; a.ws = (unsigned char*)d_ws;
    if (hipMemsetAsync((char*)d_ws + WS_CTL, 0, CTL_BYTES, stream) != hipSuccess) { fprintf(stderr, "kernel_launch: memset of the barrier words failed\n"); return; }
    a.ph_lo = 0; a.ph_hi = 5;
    void* args[] = {&a};
    hipError_t e = hipLaunchCooperativeKernel((const void*)hybrid_fwd, dim3(grid), dim3(512), args, LDS_BYTES, stream);
    if (e != hipSuccess) fprintf(stderr, "cooperative launch failed: %s (grid %d)\n", hipGetErrorString(e), grid);
}
```

```cpp
#include <hip/hip_runtime.h>
#include <hip/hip_cooperative_groups.h>
#include <cstdio>
#include <cstdint>
namespace cg = cooperative_groups;

#ifndef CHAIN_LATE
#define CHAIN_LATE 0
#endif
#ifndef PROBE_BLK
#define PROBE_BLK 32
#endif
#ifndef PROBE_PH
#define PROBE_PH -1
#endif
#ifndef REP_MASK
#define REP_MASK 0
#endif
#ifndef DBG_NPH
#define DBG_NPH 5
#define DBG_DUMP 0
#endif
#ifndef MK_N_LAUNCHES
#define MK_N_LAUNCHES 1
#endif

#define LAS __attribute__((address_space(3)))
typedef unsigned short bf16_t;
typedef short bf16x8 __attribute__((ext_vector_type(8)));
typedef float f32x4 __attribute__((ext_vector_type(4)));
typedef float f32x16 __attribute__((ext_vector_type(16)));
typedef unsigned u32x4 __attribute__((ext_vector_type(4)));
typedef unsigned u32x2 __attribute__((ext_vector_type(2)));

constexpr int DM = 1024, NIN = 8704;
constexpr int R_META = 112, R_PROMPT = 128, R_SAMPLE = 16512, R_END = 17536, MROWS = 17664;
constexpr int M23 = 17408;
constexpr int NPOS = 16400;
constexpr float EPS = 1e-6f;
constexpr float LOG2E = 1.4426950408889634f;
constexpr float C2 = 0.125f * LOG2E;
constexpr size_t O_Y = 0, O_NKP = 17825792, O_NVP = 17858560, O_NCP = 17891328, O_NKS = 17893376, O_NVS = 22087680, O_NCS = 26281984;
constexpr size_t BUFB = (size_t)MROWS * DM * 2;
constexpr size_t WS_WIN = 0, WS_WA = (size_t)NIN * DM * 2, WS_WB = WS_WA + 2097152, WS_WO = WS_WB + 2097152;
constexpr size_t WS_B0 = 25165824;
constexpr size_t WS_QA = WS_B0 + BUFB, WS_BZ = WS_QA + BUFB, WS_SZA = WS_BZ + BUFB, WS_U = WS_SZA + BUFB, WS_SGB = WS_U + BUFB;
constexpr size_t WS_K = WS_SGB + BUFB, WS_VT = WS_K + (size_t)MROWS * 256 * 2, WS_ROPE = WS_VT + (size_t)MROWS * 256 * 2, WS_END = WS_ROPE + (size_t)NPOS * 64 * 4;
constexpr size_t WS_CTL = 265289728, CTL_BYTES = 65536;
static_assert(WS_END <= WS_CTL && WS_CTL + CTL_BYTES <= 268435456, "d_ws map");

constexpr int LDS_BYTES = 147456;

namespace pg8 {
constexpr int BM = 256, BK = 64, HALF = 128, HTB = HALF * BK * 2, STAGE_BYTES = 8 * HTB, NXCD = 8, WGM = 8;
__host__ __device__ __forceinline__ int lds_byte(int r, int c) { const int st = (r >> 4) * 2 + (c >> 5), rr = r & 15, cc = c & 31, ob = rr * 64 + cc * 2; return st * 1024 + (ob ^ (((ob >> 9) & 1) << 5)); }
__host__ __device__ __forceinline__ void stage_rc(int b, int& R, int& C) { const int st = b / 1024, sb = b % 1024, swz = sb ^ (((sb >> 9) & 1) << 5); R = (st >> 1) * 16 + swz / 64; C = (st & 1) * 32 + (swz % 64) / 2; }
__host__ __device__ __forceinline__ int perm32(int rho) { const int n = rho >> 4, i = rho & 15; return 8 * (i >> 2) + 4 * n + (i & 3); }

struct Unit { int pm, pn, part; };
struct Gemm { const bf16_t* A; const bf16_t* Bt; int M, N, K; size_t partA, partB; int ld; };

struct StaticOrder {
    int nM, nN, nwg, G, c, np, direct, special;
    __host__ __device__ void init(int M, int N, int G_, int c_, int np_, int direct_ = -1) { nM = M / BM; nN = N / BM; nwg = nM * nN; G = G_; c = c_; np = np_; direct = direct_; special = 0; }
    __host__ __device__ static void swz(int wgid, int nM_, int nN_, int& pm, int& pn) {
        const int nwg_ = nM_ * nN_;
        { const int q = nwg_ / NXCD, r = nwg_ % NXCD, xcd = wgid % NXCD, off = wgid / NXCD; wgid = (xcd < r ? xcd * (q + 1) : r * (q + 1) + (xcd - r) * q) + off; }
        const int nig = WGM * nN_, gid = wgid / nig, fm = gid * WGM, gsz = (nM_ - fm) < WGM ? (nM_ - fm) : WGM;
        pm = fm + ((wgid % nig) % gsz); pn = (wgid % nig) / gsz;
    }
    __host__ __device__ bool next(int i, Unit& u) const {
        const int it = (np == 2) ? (i >> 1) : i; u.part = (np == 2) ? (i & 1) : 0;
        if (direct >= 0) { if (it > 0) return false; u.pm = direct / nN; u.pn = direct % nN; return true; }
        const long L = (long)it * G + c;
        if (special) {
            if (L >= 2048) return false;
            int l = (int)L;
            if (l < 884) { swz(l, 26, 34, u.pm, u.pn); return true; } l -= 884;
            if (l < 1118) { swz(l, 43, 26, u.pm, u.pn); u.pm += 26; return true; } l -= 1118;
            if (l < 40) { u.pm = 64 + (l >> 3); u.pn = 26 + (l & 7); return true; } l -= 40;
            u.pm = 26; u.pn = 26 + l; return true;
        }
        if (L >= nwg) return false;
        swz((int)L, nM, nN, u.pm, u.pn); return true;
    }
};

typedef float f32x2_t __attribute__((ext_vector_type(2))); typedef __bf16 bf16x2_t __attribute__((ext_vector_type(2)));
__device__ __forceinline__ unsigned cvt_pk_bf16(float lo, float hi) { const f32x2_t v = {lo, hi}; const bf16x2_t b = __builtin_convertvector(v, bf16x2_t); return __builtin_bit_cast(unsigned, b); }

template <class Epi>
__device__ __forceinline__ void gemm_phase(LAS unsigned char* lds, const Gemm g, const StaticOrder& S, const Epi& E) {
    int tid_ = threadIdx.x; asm volatile("" : "+v"(tid_));
    const int tid = tid_, wid = __builtin_amdgcn_readfirstlane(tid >> 6), lane = tid & 63, wr = wid >> 2, wc = wid & 3, fr = lane & 15, fq = lane >> 4;
    const int K = g.ld ? g.ld : g.K, nt = g.K / BK;
    unsigned voffA[2], voffB[2];
#pragma unroll
    for (int i = 0; i < 2; ++i) { int R, C; stage_rc(tid * 16 + i * 8192, R, C); const int Rb = ((R & ~31) + perm32(R & 31));
        voffA[i] = (unsigned)(R * K + C) * 2u; voffB[i] = (unsigned)(Rb * K + C) * 2u; }
    const size_t kstep = (size_t)(BK * 2);
    const size_t hstep = (size_t)HALF * K * 2;
    const size_t tstep = 2 * hstep;
    const unsigned ldsw = (unsigned)wid * 1024u;
    const int aoff = lds_byte(wr * 64 + fr, fq * 8), boff = lds_byte(wc * 32 + fr, fq * 8);
#define PG8_SA(b, h) (((b) * 2 + (h)) * HTB)
#define PG8_SB(b, h) ((4 + (b) * 2 + (h)) * HTB)
#define PG8_STAGE(bufoff, gbase, voff) do { _Pragma("unroll") for (int _i = 0; _i < 2; ++_i) \
        __builtin_amdgcn_global_load_lds((const unsigned*)((const char*)(gbase) + (voff)[_i]), (LAS unsigned*)(lds + (bufoff) + ldsw + _i * 8192), 16, 0, 0); } while (0)
#define PG8_LDA(dst, b, h) do { _Pragma("unroll") for (int m = 0; m < 4; ++m) _Pragma("unroll") for (int k = 0; k < 2; ++k) dst[m][k] = *(const LAS bf16x8*)(lds + PG8_SA(b, h) + aoff + m * 2048 + k * 1024); } while (0)
#define PG8_LDB(dst, b, h) do { _Pragma("unroll") for (int n = 0; n < 2; ++n) _Pragma("unroll") for (int k = 0; k < 2; ++k) dst[n][k] = *(const LAS bf16x8*)(lds + PG8_SB(b, h) + boff + n * 2048 + k * 1024); } while (0)
#define PG8_MMA(ai, bj, At, Bt) do { __builtin_amdgcn_s_setprio(1); _Pragma("unroll") for (int m = 0; m < 4; ++m) _Pragma("unroll") for (int n = 0; n < 2; ++n) _Pragma("unroll") for (int k = 0; k < 2; ++k) \
        acc[ai][bj][m][n] = __builtin_amdgcn_mfma_f32_16x16x32_bf16(Bt[n][k], At[m][k], acc[ai][bj][m][n], 0, 0, 0); __builtin_amdgcn_s_setprio(0); } while (0)
#define PG8_WAIT_V(n) asm volatile("s_waitcnt vmcnt(" #n ")" ::: "memory")
#define PG8_WAIT_L(n) asm volatile("s_waitcnt lgkmcnt(" #n ")" ::: "memory")
#define PG8_BAR __builtin_amdgcn_s_barrier()
#define PG8_SCHED __builtin_amdgcn_sched_barrier(0)
    Unit cur, nxt; int ui = 0;
    if (!S.next(0, cur)) return;
    f32x4 acc[2][2][4][2];
#pragma unroll
    for (int a = 0; a < 2; ++a)
#pragma unroll
        for (int b = 0; b < 2; ++b)
#pragma unroll
            for (int m = 0; m < 4; ++m)
#pragma unroll
                for (int n = 0; n < 2; ++n) acc[a][b][m][n] = (f32x4){0.f, 0.f, 0.f, 0.f};
    bf16x8 At[4][2], B0[2][2], B1[2][2];
    const char* cA = (const char*)g.A + (size_t)cur.pm * tstep + (size_t)cur.part * g.partA; const char* cB = (const char*)g.Bt + (size_t)cur.pn * tstep + (size_t)cur.part * g.partB;
    PG8_STAGE(PG8_SB(0, 0), cB, voffB); PG8_STAGE(PG8_SB(0, 1), cB + hstep, voffB); PG8_STAGE(PG8_SA(0, 0), cA, voffA); PG8_STAGE(PG8_SA(0, 1), cA + hstep, voffA);
    if (wr == 1) PG8_BAR;
    PG8_WAIT_V(2); PG8_BAR;
    PG8_STAGE(PG8_SB(1, 0), cB + kstep, voffB); PG8_STAGE(PG8_SA(1, 0), cA + kstep, voffA); PG8_STAGE(PG8_SB(1, 1), cB + hstep + kstep, voffB);
    PG8_WAIT_V(6); PG8_BAR;
    for (;;) {
        const bool has_next = S.next(ui + 1, nxt);
        const char* nA = has_next ? (const char*)g.A + (size_t)nxt.pm * tstep + (size_t)nxt.part * g.partA : cA; const char* nB = has_next ? (const char*)g.Bt + (size_t)nxt.pn * tstep + (size_t)nxt.part * g.partB : cB;
        for (int t = 0; t < nt; t += 2) {
            const bool last = (t == nt - 2);
            const char* a1 = cA + (size_t)(t + 1) * kstep;
            const char* a2 = last ? nA : cA + (size_t)(t + 2) * kstep; const char* b2 = last ? nB : cB + (size_t)(t + 2) * kstep;
            const char* a3 = a2 + kstep; const char* b3 = b2 + kstep;
            PG8_LDB(B0, 0, 0); PG8_LDB(B1, 0, 1); PG8_SCHED; PG8_LDA(At, 0, 0); PG8_STAGE(PG8_SA(1, 1), a1 + hstep, voffA);
            PG8_WAIT_V(8); PG8_WAIT_L(0); PG8_BAR; PG8_MMA(0, 0, At, B0); PG8_MMA(0, 1, At, B1); PG8_BAR; PG8_SCHED;
            PG8_LDA(At, 0, 1); PG8_STAGE(PG8_SB(0, 0), b2, voffB); PG8_STAGE(PG8_SB(0, 1), b2 + hstep, voffB); PG8_STAGE(PG8_SA(0, 0), a2, voffA);
            PG8_WAIT_V(8); PG8_WAIT_L(0); PG8_BAR; PG8_MMA(1, 0, At, B0); PG8_MMA(1, 1, At, B1); PG8_BAR; PG8_SCHED;
            PG8_LDB(B0, 1, 0); PG8_LDB(B1, 1, 1); PG8_SCHED; PG8_LDA(At, 1, 0); PG8_STAGE(PG8_SA(0, 1), a2 + hstep, voffA);
            PG8_WAIT_V(8); PG8_WAIT_L(0); PG8_BAR; PG8_MMA(0, 0, At, B0); PG8_MMA(0, 1, At, B1); PG8_BAR; PG8_SCHED;
            PG8_LDA(At, 1, 1); PG8_STAGE(PG8_SB(1, 0), b3, voffB); PG8_STAGE(PG8_SB(1, 1), b3 + hstep, voffB); PG8_STAGE(PG8_SA(1, 0), a3, voffA);
            PG8_WAIT_V(8); PG8_WAIT_L(0); PG8_BAR; PG8_MMA(1, 0, At, B0); PG8_MMA(1, 1, At, B1); PG8_BAR; PG8_SCHED;
        }
        if (wr == 0) PG8_BAR;
        { Unit eu = cur; int ewr = wr, ewc = wc, efr = fr, efq = fq;
          asm volatile("" : "+s"(eu.pm), "+s"(eu.pn), "+s"(eu.part), "+s"(ewr), "+s"(ewc), "+v"(efr), "+v"(efq));
          E(acc, eu, ewr, ewc, efr, efq); }
        if (!has_next) break;
        if (!E.keep(cur)) {
#pragma unroll
        for (int a = 0; a < 2; ++a)
#pragma unroll
            for (int b = 0; b < 2; ++b)
#pragma unroll
                for (int m = 0; m < 4; ++m)
#pragma unroll
                    for (int n = 0; n < 2; ++n) acc[a][b][m][n] = (f32x4){0.f, 0.f, 0.f, 0.f};
        }
        cur = nxt; cA = nA; cB = nB; ++ui;
        if (wr == 1) PG8_BAR;
    }
    PG8_WAIT_V(0);
    PG8_BAR;
#undef PG8_SA
#undef PG8_SB
#undef PG8_STAGE
#undef PG8_LDA
#undef PG8_LDB
#undef PG8_MMA
#undef PG8_WAIT_V
#undef PG8_WAIT_L
#undef PG8_BAR
#undef PG8_SCHED
}
}
using pg8::cvt_pk_bf16;

__device__ __forceinline__ unsigned xb_ld(unsigned* p)              { return __hip_atomic_load(p, __ATOMIC_RELAXED, __HIP_MEMORY_SCOPE_AGENT); }
__device__ __forceinline__ unsigned xb_add(unsigned* p, unsigned v) { return __hip_atomic_fetch_add(p, v, __ATOMIC_RELAXED, __HIP_MEMORY_SCOPE_AGENT); }
__device__ __forceinline__ float bf_lo(unsigned u) { return __uint_as_float(u << 16); }
__device__ __forceinline__ float bf_hi(unsigned u) { return __uint_as_float(u & 0xffff0000u); }
__device__ __forceinline__ float sigm_f(float x) { return __builtin_amdgcn_rcpf(1.f + __builtin_amdgcn_exp2f(-LOG2E * x)); }
__device__ __forceinline__ float silu_f(float x) { return x * sigm_f(x); }
__device__ __forceinline__ f32x4 sigm4(const f32x4 v) { f32x4 r; r.x = sigm_f(v.x); r.y = sigm_f(v.y); r.z = sigm_f(v.z); r.w = sigm_f(v.w); return r; }
__device__ __forceinline__ f32x4 onepexp4(const f32x4 v) { f32x4 r; r.x = 1.f + __builtin_amdgcn_exp2f(-LOG2E * v.x); r.y = 1.f + __builtin_amdgcn_exp2f(-LOG2E * v.y); r.z = 1.f + __builtin_amdgcn_exp2f(-LOG2E * v.z); r.w = 1.f + __builtin_amdgcn_exp2f(-LOG2E * v.w); return r; }
__device__ __forceinline__ f32x4 rcp4(const f32x4 v) { f32x4 r; r.x = __builtin_amdgcn_rcpf(v.x); r.y = __builtin_amdgcn_rcpf(v.y); r.z = __builtin_amdgcn_rcpf(v.z); r.w = __builtin_amdgcn_rcpf(v.w); return r; }
__device__ __forceinline__ void gate4(const f32x4 ga, const f32x4 gb, f32x4& r, f32x4& sb) { const f32x4 ea = onepexp4(ga), eb = onepexp4(gb); sb = rcp4(eb); r = rcp4(ea) * eb; }
__device__ __forceinline__ int rowpos(int row) { return row < R_SAMPLE ? (row > R_META ? row - R_META : 0) : (row < R_END ? 16384 + ((row - R_SAMPLE) & 7) : 0); }
__device__ __forceinline__ u32x4 pack8(const f32x4 a, const f32x4 b) { u32x4 w; w.x = cvt_pk_bf16(a[0], a[1]); w.y = cvt_pk_bf16(a[2], a[3]); w.z = cvt_pk_bf16(b[0], b[1]); w.w = cvt_pk_bf16(b[2], b[3]); return w; }

struct Epi1 {
    bf16_t *Q, *Kb, *Vt, *SZA, *BZ, *U, *SGA, *SGB; const float *rope, *qnw, *knw; float* out;
    __device__ __forceinline__ bool keep(const pg8::Unit&) const { return false; }
    __device__ __forceinline__ void operator()(f32x4 (&acc)[2][2][4][2], const pg8::Unit& u, int wr, int wc, int fr, int fq) const {
        const int pn = u.pn, row0 = u.pm * 256 + wr * 64 + fr;
        if (pn < 5) {
            const bool isq = pn < 4; const float* nw = isq ? qnw : knw;
            f32x4 w[2][2];
#pragma unroll
            for (int bj = 0; bj < 2; ++bj)
#pragma unroll
                for (int n = 0; n < 2; ++n) w[bj][n] = *(const f32x4*)(nw + 32 * bj + 8 * fq + 4 * n);
            const float sc = isq ? C2 : 1.f;
#pragma unroll
            for (int ai = 0; ai < 2; ++ai)
#pragma unroll
                for (int m = 0; m < 4; ++m) {
                    const int row = row0 + ai * 128 + m * 16;
                    float ss = 0.f;
#pragma unroll
                    for (int bj = 0; bj < 2; ++bj)
#pragma unroll
                        for (int n = 0; n < 2; ++n) { const f32x4 x = acc[ai][bj][m][n]; ss += (x[0] * x[0] + x[1] * x[1]) + (x[2] * x[2] + x[3] * x[3]); }
                    ss += __shfl_xor(ss, 16); ss += __shfl_xor(ss, 32);
                    const float rinv = 1.0f / sqrtf(ss * (1.f / 64.f) + EPS);
                    const float* rp = rope + (size_t)rowpos(row) * 64 + 8 * fq;
                    f32x4 o1[2], o2[2];
#pragma unroll
                    for (int n = 0; n < 2; ++n) {
                        const f32x4 cs = *(const f32x4*)(rp + 4 * n), sn = *(const f32x4*)(rp + 32 + 4 * n);
                        const f32x4 x1 = acc[ai][0][m][n] * rinv * w[0][n], x2 = acc[ai][1][m][n] * rinv * w[1][n];
                        o1[n] = (x1 * cs - x2 * sn) * sc; o2[n] = (x2 * cs + x1 * sn) * sc;
                    }
                    if (isq) {
                        bf16_t* p = Q + (size_t)row * DM + 64 * (4 * pn + wc) + 8 * fq;
                        *(u32x4*)p = pack8(o1[0], o1[1]); *(u32x4*)(p + 32) = pack8(o2[0], o2[1]);
                    } else {
                        bf16_t* p = Kb + (size_t)row * 256 + 64 * wc + 8 * fq;
                        *(u32x4*)p = pack8(o1[0], o1[1]); *(u32x4*)(p + 32) = pack8(o2[0], o2[1]);
                        if (u.pm >= 64) {
                            float* d = nullptr;
                            if (row >= 16384 && row < R_SAMPLE) d = out + O_NKP + (size_t)(row - 16384) * 256;
                            else if (row >= R_SAMPLE && row < R_END) { const int sr = row - R_SAMPLE; d = out + O_NKS + ((size_t)(sr >> 3) * 128 + 120 + (sr & 7)) * 256; }
                            if (d) { d += 64 * wc + 8 * fq; *(f32x4*)d = o1[0]; *(f32x4*)(d + 4) = o1[1]; *(f32x4*)(d + 32) = o2[0]; *(f32x4*)(d + 36) = o2[1]; }
                        }
                    }
                }
        } else if (pn == 5) {
#pragma unroll
            for (int ai = 0; ai < 2; ++ai)
#pragma unroll
                for (int m = 0; m < 4; ++m) {
                    const int row = row0 + ai * 128 + m * 16;
                    float* d = nullptr;
                    if (u.pm >= 64) {
                        if (row >= 16384 && row < R_SAMPLE) d = out + O_NVP + (size_t)(row - 16384) * 256;
                        else if (row >= R_SAMPLE && row < R_END) { const int sr = row - R_SAMPLE; d = out + O_NVS + ((size_t)(sr >> 3) * 128 + 120 + (sr & 7)) * 256; }
                    }
#pragma unroll
                    for (int bj = 0; bj < 2; ++bj)
#pragma unroll
                        for (int n = 0; n < 2; ++n) {
                            const int c = 128 * bj + 32 * wc + 8 * fq + 4 * n; const f32x4 x = acc[ai][bj][m][n];
                            const unsigned p0 = cvt_pk_bf16(x[0], x[1]), p1 = cvt_pk_bf16(x[2], x[3]);
                            bf16_t* vp = Vt + (size_t)c * MROWS + row;
                            vp[0] = (bf16_t)(p0 & 0xffffu); vp[MROWS] = (bf16_t)(p0 >> 16); vp[2 * (size_t)MROWS] = (bf16_t)(p1 & 0xffffu); vp[3 * (size_t)MROWS] = (bf16_t)(p1 >> 16);
                            if (d) *(f32x4*)(d + c) = x;
                        }
                }
        } else if (pn >= 10 && pn < 26) {
            const int ch = 64 * (pn - 10) + 16 * wc + 4 * fq;
#pragma unroll
            for (int ai = 0; ai < 2; ++ai)
#pragma unroll
                for (int m = 0; m < 4; ++m) {
                    const int row = row0 + ai * 128 + m * 16;
                    const f32x4 b = acc[ai][0][m][0], c = acc[ai][0][m][1], hc = acc[ai][1][m][0], zb = acc[ai][1][m][1];
                    const f32x4 uu = c * hc, bz = b * zb * sigm4(zb);
                    u32x2 wu, wb; wu.x = cvt_pk_bf16(uu[0], uu[1]); wu.y = cvt_pk_bf16(uu[2], uu[3]); wb.x = cvt_pk_bf16(bz[0], bz[1]); wb.y = cvt_pk_bf16(bz[2], bz[3]);
                    *(u32x2*)(U + (size_t)row * DM + ch) = wu; *(u32x2*)(BZ + (size_t)row * DM + ch) = wb;
                    if (u.pm >= 64) {
                        if (row == 16510 || row == 16511) *(f32x4*)(out + O_NCP + (size_t)(row - 16510) * DM + ch) = uu;
                        else if (row >= R_SAMPLE && row < R_END && ((row - R_SAMPLE) & 7) >= 6) { const int sr = row - R_SAMPLE; *(f32x4*)(out + O_NCS + ((size_t)(sr >> 3) * 2 + ((sr & 7) - 6)) * DM + ch) = uu; }
                    }
                }
        } else if (pn < 10) {
            const int col0 = (pn - 6) * 256 + 32 * wc + 8 * fq;
#pragma unroll
            for (int ai = 0; ai < 2; ++ai)
#pragma unroll
                for (int m = 0; m < 4; ++m) {
                    bf16_t* rowp = SZA + (size_t)(row0 + ai * 128 + m * 16) * DM + col0;
#pragma unroll
                    for (int bj = 0; bj < 2; ++bj) {
                        const f32x4 v0 = acc[ai][bj][m][0], v1 = acc[ai][bj][m][1];
                        *(u32x4*)(rowp + bj * 128) = pack8(sigm4(v0) * v0, sigm4(v1) * v1);
                    }
                }
        } else {
            const int col0 = (pn - 26) * 128 + 32 * wc + 8 * fq;
#pragma unroll
            for (int ai = 0; ai < 2; ++ai)
#pragma unroll
                for (int m = 0; m < 4; ++m) {
                    const size_t off = (size_t)(row0 + ai * 128 + m * 16) * DM + col0;
#pragma unroll
                    for (int n = 0; n < 2; ++n) {
                        f32x4 r0, s0; gate4(acc[ai][0][m][n], acc[ai][1][m][n], r0, s0);
                        u32x2 wr_, ws_; wr_.x = cvt_pk_bf16(r0.x, r0.y); wr_.y = cvt_pk_bf16(r0.z, r0.w); ws_.x = cvt_pk_bf16(s0.x, s0.y); ws_.y = cvt_pk_bf16(s0.z, s0.w);
                        *(u32x2*)(SGA + off + 4 * n) = wr_; *(u32x2*)(SGB + off + 4 * n) = ws_;
                        __builtin_amdgcn_sched_barrier(0);
                    }
                }
        }
    }
};

struct Epi2 {
    const bf16_t *SGA, *SGB; bf16_t* MIX;
    __device__ __forceinline__ bool keep(const pg8::Unit& u) const { return u.part == 0; }
    __device__ __forceinline__ void operator()(f32x4 (&acc)[2][2][4][2], const pg8::Unit& u, int wr, int wc, int fr, int fq) const {
        const int row0 = u.pm * 256 + wr * 64 + fr, col0 = u.pn * 256 + 32 * wc + 8 * fq;
        const bf16_t* p0 = SGA; const bf16_t* p1 = SGB; asm volatile("" : "+s"(p0), "+s"(p1));
        const bf16_t* G = u.part == 0 ? p0 : p1;
        u32x4 gv[2][4][2];
#pragma unroll
        for (int ai = 0; ai < 2; ++ai)
#pragma unroll
            for (int m = 0; m < 4; ++m)
#pragma unroll
                for (int bj = 0; bj < 2; ++bj) gv[ai][m][bj] = *(const u32x4*)(G + (size_t)(row0 + ai * 128 + m * 16) * DM + col0 + bj * 128);
#pragma unroll
        for (int ai = 0; ai < 2; ++ai)
#pragma unroll
            for (int m = 0; m < 4; ++m) {
                const size_t off = (size_t)(row0 + ai * 128 + m * 16) * DM + col0;
#pragma unroll
                for (int bj = 0; bj < 2; ++bj) {
                    const u32x4 gb = gv[ai][m][bj];
                    const f32x4 b0 = {bf_lo(gb.x), bf_hi(gb.x), bf_lo(gb.y), bf_hi(gb.y)}, b1 = {bf_lo(gb.z), bf_hi(gb.z), bf_lo(gb.w), bf_hi(gb.w)};
                    if (u.part == 0) { acc[ai][bj][m][0] = acc[ai][bj][m][0] * b0; acc[ai][bj][m][1] = acc[ai][bj][m][1] * b1; }
                    else *(u32x4*)(MIX + off + bj * 128) = pack8(acc[ai][bj][m][0] * b0, acc[ai][bj][m][1] * b1);
                }
            }
    }
};

template <bool GATE> struct EpiPart {
    const bf16_t* SGA; float* scr; const bf16_t* SGB;
    __device__ __forceinline__ bool keep(const pg8::Unit&) const { return false; }
    __device__ __forceinline__ void operator()(f32x4 (&acc)[2][2][4][2], const pg8::Unit& u, int wr, int wc, int fr, int fq) const {
        const int row0 = u.pm * 256 + wr * 64 + fr, col0 = u.pn * 256 + 32 * wc + 8 * fq, lr0 = wr * 64 + fr, lc0 = 32 * wc + 8 * fq;
#pragma unroll
        for (int ai = 0; ai < 2; ++ai)
#pragma unroll
            for (int m = 0; m < 4; ++m) {
                const size_t off = (size_t)(row0 + ai * 128 + m * 16) * DM + col0;
                bf16_t* sp = (bf16_t*)scr + (size_t)(lr0 + ai * 128 + m * 16) * 256 + lc0;
#pragma unroll
                for (int bj = 0; bj < 2; ++bj) {
                    f32x4 a0 = {1.f, 1.f, 1.f, 1.f}, a1 = a0;
                    if (GATE) { const u32x4 ga = *(const u32x4*)(SGA + off + bj * 128), gb = *(const u32x4*)(SGB + off + bj * 128);
                        a0 = (f32x4){bf_lo(ga.x) * bf_lo(gb.x), bf_hi(ga.x) * bf_hi(gb.x), bf_lo(ga.y) * bf_lo(gb.y), bf_hi(ga.y) * bf_hi(gb.y)};
                        a1 = (f32x4){bf_lo(ga.z) * bf_lo(gb.z), bf_hi(ga.z) * bf_hi(gb.z), bf_lo(ga.w) * bf_lo(gb.w), bf_hi(ga.w) * bf_hi(gb.w)}; }
                    *(u32x4*)(sp + bj * 128) = pack8(acc[ai][bj][m][0] * a0, acc[ai][bj][m][1] * a1);
                }
            }
    }
};
__device__ __forceinline__ void wait_count(unsigned* cnt, unsigned want) {
    unsigned sp = 0; while (xb_ld(cnt) < want) { __builtin_amdgcn_s_sleep(1); if (++sp > (1u << 22)) break; }
    __builtin_amdgcn_fence(__ATOMIC_ACQUIRE, "agent");
    asm volatile("s_waitcnt vmcnt(0)" ::: "memory");
}
struct Epi2b {
    const bf16_t* SGB; const float* scr; bf16_t* MIX; unsigned* cnt; const bf16_t* SGA;
    __device__ __forceinline__ bool keep(const pg8::Unit&) const { return false; }
    __device__ __forceinline__ void operator()(f32x4 (&acc)[2][2][4][2], const pg8::Unit& u, int wr, int wc, int fr, int fq) const {
        const int row0 = u.pm * 256 + wr * 64 + fr, col0 = u.pn * 256 + 32 * wc + 8 * fq, lr0 = wr * 64 + fr, lc0 = 32 * wc + 8 * fq;
        wait_count(cnt, 1u);
#pragma unroll
        for (int ai = 0; ai < 2; ++ai)
#pragma unroll
            for (int m = 0; m < 4; ++m) {
                const size_t off = (size_t)(row0 + ai * 128 + m * 16) * DM + col0;
                const bf16_t* sp = (const bf16_t*)scr + (size_t)(lr0 + ai * 128 + m * 16) * 256 + lc0;
#pragma unroll
                for (int bj = 0; bj < 2; ++bj) {
                    const u32x4 gb = *(const u32x4*)(SGB + off + bj * 128), ga = *(const u32x4*)(SGA + off + bj * 128);
                    const f32x4 b0 = {bf_lo(gb.x), bf_hi(gb.x), bf_lo(gb.y), bf_hi(gb.y)}, b1 = {bf_lo(gb.z), bf_hi(gb.z), bf_lo(gb.w), bf_hi(gb.w)};
                    const f32x4 r0 = {bf_lo(ga.x), bf_hi(ga.x), bf_lo(ga.y), bf_hi(ga.y)}, r1 = {bf_lo(ga.z), bf_hi(ga.z), bf_lo(ga.w), bf_hi(ga.w)};
                    const u32x4 pp = *(const u32x4*)(sp + bj * 128); const f32x4 p0 = {bf_lo(pp.x), bf_hi(pp.x), bf_lo(pp.y), bf_hi(pp.y)}, p1 = {bf_lo(pp.z), bf_hi(pp.z), bf_lo(pp.w), bf_hi(pp.w)};
                    *(u32x4*)(MIX + off + bj * 128) = pack8((p0 * r0 + acc[ai][bj][m][0]) * b0, (p1 * r1 + acc[ai][bj][m][1]) * b1);
                }
            }
    }
};
struct Epi3b {
    const float *xp, *xs; float* y; const float* scr; unsigned* cnt;
    __device__ __forceinline__ bool keep(const pg8::Unit&) const { return false; }
    __device__ __forceinline__ void operator()(f32x4 (&acc)[2][2][4][2], const pg8::Unit& u, int wr, int wc, int fr, int fq) const {
        const int row0 = u.pm * 256 + wr * 64 + fr, col0 = u.pn * 256 + 32 * wc + 8 * fq, lr0 = wr * 64 + fr, lc0 = 32 * wc + 8 * fq;
        wait_count(cnt, 1u);
#pragma unroll
        for (int ai = 0; ai < 2; ++ai)
#pragma unroll
            for (int m = 0; m < 4; ++m) {
                const int gr = row0 + ai * 128 + m * 16;
                const float* xr = (gr < 16384 ? xp + (size_t)gr * DM : xs + (size_t)(gr - 16384) * DM) + col0;
                float* yr = y + (size_t)gr * DM + col0;
                const bf16_t* sp = (const bf16_t*)scr + (size_t)(lr0 + ai * 128 + m * 16) * 256 + lc0;
#pragma unroll
                for (int bj = 0; bj < 2; ++bj) {
                    const u32x4 pp = *(const u32x4*)(sp + bj * 128); const f32x4 p0 = {bf_lo(pp.x), bf_hi(pp.x), bf_lo(pp.y), bf_hi(pp.y)}, p1 = {bf_lo(pp.z), bf_hi(pp.z), bf_lo(pp.w), bf_hi(pp.w)};
                    *(f32x4*)(yr + bj * 128) = *(const f32x4*)(xr + bj * 128) + p0 + acc[ai][bj][m][0]; *(f32x4*)(yr + bj * 128 + 4) = *(const f32x4*)(xr + bj * 128 + 4) + p1 + acc[ai][bj][m][1];
                }
            }
    }
};
__device__ __forceinline__ void publish_count(unsigned* cnt) {
    asm volatile("s_waitcnt vmcnt(0)" ::: "memory");
    __syncthreads();
    if (threadIdx.x == 0) { __builtin_amdgcn_fence(__ATOMIC_RELEASE, "agent"); asm volatile("s_waitcnt vmcnt(0)" ::: "memory"); xb_add(cnt, 1u); }
}

struct Epi3 {
    const float *xp, *xs; float* y;
    __device__ __forceinline__ bool keep(const pg8::Unit&) const { return false; }
    __device__ __forceinline__ void operator()(f32x4 (&acc)[2][2][4][2], const pg8::Unit& u, int wr, int wc, int fr, int fq) const {
        const int row0 = u.pm * 256 + wr * 64 + fr, col0 = u.pn * 256 + 32 * wc + 8 * fq;
#pragma unroll
        for (int ai = 0; ai < 2; ++ai) {
            f32x4 xv[4][2][2];
#pragma unroll
            for (int m = 0; m < 4; ++m) {
                const int gr = row0 + ai * 128 + m * 16;
                const float* xr = (gr < 16384 ? xp + (size_t)gr * DM : xs + (size_t)(gr - 16384) * DM) + col0;
#pragma unroll
                for (int bj = 0; bj < 2; ++bj)
#pragma unroll
                    for (int n = 0; n < 2; ++n) xv[m][bj][n] = *(const f32x4*)(xr + bj * 128 + 4 * n);
            }
#pragma unroll
            for (int m = 0; m < 4; ++m) {
                float* yr = y + (size_t)(row0 + ai * 128 + m * 16) * DM + col0;
#pragma unroll
                for (int bj = 0; bj < 2; ++bj)
#pragma unroll
                    for (int n = 0; n < 2; ++n) *(f32x4*)(yr + bj * 128 + 4 * n) = xv[m][bj][n] + acc[ai][bj][m][n];
            }
            asm volatile("" ::: "memory");
        }
    }
};

__device__ __forceinline__ float wave_sum(float v) {
#pragma unroll
    for (int o = 1; o < 64; o <<= 1) v += __shfl_xor(v, o);
    return v;
}
__device__ __forceinline__ int win_orig_col(int n) {
    const int pn = n >> 8, c = n & 255;
    if (pn < 5) { const int bj = c >> 7, wc = (c >> 5) & 3, j = c & 31; return 64 * (4 * pn + wc) + 32 * bj + j; }
    if (pn >= 10 && pn < 26) { const int t = pn - 10, bj = c >> 7, wc = (c >> 5) & 3, fq = (c >> 3) & 3, nn = (c >> 2) & 1, e = c & 3; return 2560 + 1024 * (2 * bj + nn) + 64 * t + 16 * wc + 4 * fq + e; }
    if (pn >= 26) { const int t = pn - 26, bj = c >> 7, rest = c & 127; return 6656 + 1024 * bj + 128 * t + rest; }
    return n;
}
template <bool PERMUTE>
__device__ __forceinline__ void p0_transpose_item(const float* W, int K, int N, bf16_t* WT, LAS float* scr, int item, int lane) {
    const int nblk = N / 32, kb = item / nblk, nb = item % nblk, k0 = 64 * kb, n0 = 32 * nb;
    const int ncol = PERMUTE ? win_orig_col(n0 + (lane & 31)) : n0 + (lane & 31);
    float tv[32];
#pragma unroll
    for (int i = 0; i < 32; ++i) tv[i] = __builtin_nontemporal_load(W + (size_t)(k0 + 2 * i + (lane >> 5)) * N + ncol);
#pragma unroll
    for (int i = 0; i < 32; ++i) scr[(2 * i + (lane >> 5)) * 33 + (lane & 31)] = tv[i];
    asm volatile("s_waitcnt lgkmcnt(0)" ::: "memory");
    const int c = lane & 7;
#pragma unroll
    for (int j = 0; j < 4; ++j) { const int n = (lane >> 3) + 8 * j; const LAS float* s = scr + (8 * c) * 33 + n;
        u32x4 o; o.x = cvt_pk_bf16(s[0 * 33], s[1 * 33]); o.y = cvt_pk_bf16(s[2 * 33], s[3 * 33]); o.z = cvt_pk_bf16(s[4 * 33], s[5 * 33]); o.w = cvt_pk_bf16(s[6 * 33], s[7 * 33]);
        *(u32x4*)(WT + (size_t)(n0 + n) * K + k0 + 8 * c) = o; }
    asm volatile("s_waitcnt lgkmcnt(0)" ::: "memory");
}

struct Args { const float* in[15]; float* out; unsigned char* ws; int ph_lo, ph_hi; };

__device__ __forceinline__ void p0_prologue(const Args& a, LAS unsigned char* lds, int tid, int lane, int wave, int G) {
    LAS float* scr = (LAS float*)(lds + wave * 16384);
    const int gw = blockIdx.x * 8 + wave, NGW = G * 8;
    bf16_t* WIN = (bf16_t*)(a.ws + WS_WIN); bf16_t* WA = (bf16_t*)(a.ws + WS_WA); bf16_t* WB = (bf16_t*)(a.ws + WS_WB); bf16_t* WO = (bf16_t*)(a.ws + WS_WO);
    constexpr int I_IN = 16 * (NIN / 32), I_SQ = 16 * 32, NITEMS = I_IN + 3 * I_SQ;
    for (int it = gw; it < NITEMS; it += NGW) {
        int r = it;
        if (r < I_IN) { p0_transpose_item<true>(a.in[7], DM, NIN, WIN, scr, r, lane); continue; } r -= I_IN;
        if (r < I_SQ) { p0_transpose_item<false>(a.in[12], DM, DM, WA, scr, r, lane); continue; } r -= I_SQ;
        if (r < I_SQ) { p0_transpose_item<false>(a.in[13], DM, DM, WB, scr, r, lane); continue; } r -= I_SQ;
        p0_transpose_item<false>(a.in[14], DM, DM, WO, scr, r, lane);
    }
    bf16_t* XN = (bf16_t*)(a.ws + WS_B0);
    const f32x4* nwp = (const f32x4*)a.in[6] + lane;
    f32x4 nw[4];
#pragma unroll
    for (int j = 0; j < 4; ++j) nw[j] = nwp[64 * j];
    for (int m0 = gw; m0 < MROWS; m0 += 4 * NGW) {
        const float* src[4]; f32x4 v[4][4];
#pragma unroll
        for (int q = 0; q < 4; ++q) {
            const int m = m0 + q * NGW; src[q] = nullptr;
            if (m >= R_PROMPT && m < R_SAMPLE) src[q] = a.in[0] + (size_t)(m - R_PROMPT) * DM;
            else if (m >= R_SAMPLE && m < R_END) src[q] = a.in[1] + (size_t)(m - R_SAMPLE) * DM;
            else if (m >= R_META && m < R_PROMPT) src[q] = a.in[5] + (size_t)(m - R_META) * DM;
#pragma unroll
            for (int j = 0; j < 4; ++j) v[q][j] = src[q] ? __builtin_nontemporal_load((const f32x4*)src[q] + lane + 64 * j) : (f32x4){0.f, 0.f, 0.f, 0.f};
        }
#pragma unroll
        for (int q = 0; q < 4; ++q) {
            const int m = m0 + q * NGW;
            if (m < MROWS) {
                float s2 = 0.f;
#pragma unroll
                for (int j = 0; j < 4; ++j) s2 += (v[q][j].x * v[q][j].x + v[q][j].y * v[q][j].y) + (v[q][j].z * v[q][j].z + v[q][j].w * v[q][j].w);
                const float r = 1.0f / sqrtf(wave_sum(s2) * (1.f / DM) + EPS);
                unsigned long long* o8 = (unsigned long long*)(XN + (size_t)m * DM) + lane;
#pragma unroll
                for (int j = 0; j < 4; ++j) { const f32x4 y = v[q][j] * r * nw[j]; o8[64 * j] = (unsigned long long)cvt_pk_bf16(y.x, y.y) | ((unsigned long long)cvt_pk_bf16(y.z, y.w) << 32); }
            }
        }
    }
    float* rope = (float*)(a.ws + WS_ROPE);
    for (int i = blockIdx.x * 512 + tid; i < NPOS * 32; i += G * 512) {
        const int pos = i >> 5, j = i & 31;
        double invd = 1.0; for (int q = 0; q < j; ++q) invd *= 0.74989420933245582730;
        const float inv = (float)invd; const float angf = (float)pos * inv; const double ang = (double)angf;
        const double kq = __builtin_rint(ang * 0.63661977236758134308); const int qi = (int)kq;
        double rr = __builtin_fma(-kq, 1.57079632679489655800, ang); rr = __builtin_fma(-kq, 6.12323399573676603587e-17, rr);
        const double r2 = rr * rr;
        double sn = r2 * (1.0 / 6227020800.0) - (1.0 / 39916800.0); sn = sn * r2 + (1.0 / 362880.0); sn = sn * r2 - (1.0 / 5040.0); sn = sn * r2 + (1.0 / 120.0); sn = sn * r2 - (1.0 / 6.0); sn = sn * r2 * rr + rr;
        double cs = r2 * (1.0 / 479001600.0) - (1.0 / 3628800.0); cs = cs * r2 + (1.0 / 40320.0); cs = cs * r2 - (1.0 / 720.0); cs = cs * r2 + (1.0 / 24.0); cs = cs * r2 - 0.5; cs = cs * r2 + 1.0;
        double so, co;
        switch (qi & 3) { case 0: so = sn; co = cs; break; case 1: so = cs; co = -sn; break; case 2: so = -sn; co = -cs; break; default: so = -cs; co = sn; break; }
        rope[(size_t)pos * 64 + j] = (float)co; rope[(size_t)pos * 64 + 32 + j] = (float)so;
    }
}

__device__ __forceinline__ int crow(int r, int hi) { return (r & 3) + 8 * (r >> 2) + 4 * hi; }
__device__ __forceinline__ bf16x8 packp(const f32x16& p, int s) {
    u32x4 w; w.x = cvt_pk_bf16(p[8 * s + 0], p[8 * s + 1]); w.y = cvt_pk_bf16(p[8 * s + 2], p[8 * s + 3]); w.z = cvt_pk_bf16(p[8 * s + 4], p[8 * s + 5]); w.w = cvt_pk_bf16(p[8 * s + 6], p[8 * s + 7]);
    return __builtin_bit_cast(bf16x8, w);
}
__device__ __forceinline__ float sink_softmax5(f32x16 (&S)[5], int qcmp, int hi, float sink2, int minkr) {
    const float NEG = -INFINITY;
#pragma unroll
    for (int r = 0; r < 16; ++r) { const int c = crow(r, hi); if (c < qcmp) S[0][r] = NEG; if (c > qcmp) S[4][r] = NEG; }
    if (minkr > 0) {
#pragma unroll
        for (int kb = 0; kb < 5; ++kb)
#pragma unroll
            for (int r = 0; r < 16; ++r) if (32 * kb + crow(r, hi) < minkr) S[kb][r] = NEG;
    }
    float m = sink2;
#pragma unroll
    for (int kb = 0; kb < 5; ++kb)
#pragma unroll
        for (int r = 0; r < 16; ++r) m = fmaxf(m, S[kb][r]);
    m = fmaxf(m, __shfl_xor(m, 32));
    float l = 0.f;
#pragma unroll
    for (int kb = 0; kb < 5; ++kb)
#pragma unroll
        for (int r = 0; r < 16; ++r) { const float p = __builtin_amdgcn_exp2f(S[kb][r] - m); S[kb][r] = p; l += p; }
    l += __shfl_xor(l, 32);
    l += __builtin_amdgcn_exp2f(sink2 - m);
    return 1.0f / l;
}
__device__ __forceinline__ void attn_store(const f32x16 (&O)[2], float inv_l, int row, int head, int hi, const bf16_t* SZA, bf16_t* QA) {
#pragma unroll
    for (int blk = 0; blk < 2; ++blk)
#pragma unroll
        for (int rr = 0; rr < 4; ++rr) {
            const size_t off = (size_t)row * DM + 64 * head + 32 * blk + 8 * rr + 4 * hi;
            const u32x2 z = *(const u32x2*)(SZA + off);
            u32x2 w; w.x = cvt_pk_bf16(O[blk][4 * rr] * inv_l * bf_lo(z.x), O[blk][4 * rr + 1] * inv_l * bf_hi(z.x)); w.y = cvt_pk_bf16(O[blk][4 * rr + 2] * inv_l * bf_lo(z.y), O[blk][4 * rr + 3] * inv_l * bf_hi(z.y));
            *(u32x2*)(QA + off) = w;
        }
}

__device__ __forceinline__ void attn_prompt_all(LAS unsigned char* lds, int tid, int id0, int G, int idEnd, const bf16_t* Kb, const bf16_t* Vt, bf16_t* QA, const bf16_t* SZA, const float* sinks) {
    const int lane = tid & 63, wid = __builtin_amdgcn_readfirstlane(tid >> 6), ql = lane & 31, hi = lane >> 5;
    LAS unsigned char* Ks = lds; LAS unsigned char* Vs = lds + 27648;
    const int i0 = 32 * (wid & 1);
    u32x4 kst[3], vst[3];
#define ATT_FETCH(id_) do { const int n_ = 1 + ((id_) >> 3), g_ = ((id_) >> 1) & 3, kbase_ = 128 * (n_ - 1) + 64 * ((id_) & 1); \
        _Pragma("unroll") for (int i = 0; i < 3; ++i) { const int ch = tid + 512 * i; \
            { const int row = ch >> 3, c = ch & 7; kst[i] = *(const u32x4*)(Kb + (size_t)(kbase_ + row) * 256 + g_ * 64 + c * 8); } \
            { const int d = ch / 24, c = ch - d * 24; vst[i] = *(const u32x4*)(Vt + (size_t)(g_ * 64 + d) * MROWS + kbase_ + c * 8); } } \
        } while (0)
    int id = id0;
    if (id < idEnd) ATT_FETCH(id);
    for (; id < idEnd; id += G) {
        const int n = 1 + (id >> 3), g = (id >> 1) & 3, half = id & 1;
        const int kbase = 128 * (n - 1) + 64 * half;
#pragma unroll
        for (int i = 0; i < 3; ++i) {
            const int ch = tid + 512 * i;
            { const int row = ch >> 3, c = ch & 7; *(LAS u32x4*)(Ks + row * 144 + c * 16) = kst[i]; }
            { const int d = ch / 24, c = ch - d * 24; LAS u32x2* p = (LAS u32x2*)(Vs + d * 392 + c * 16); p[0] = (u32x2){vst[i].x, vst[i].y}; p[1] = (u32x2){vst[i].z, vst[i].w}; }
        }
        const int hq = 4 * g + (wid >> 1);
        const int qrow = kbase + 128 + i0 + ql;
        bf16x8 qr[4];
#pragma unroll
        for (int d0 = 0; d0 < 4; ++d0) qr[d0] = *(const bf16x8*)(QA + (size_t)qrow * DM + 64 * hq + 16 * d0 + 8 * hi);
        const float sink2 = sinks[hq] * LOG2E;
        __syncthreads();
        u32x2 zz[2][4];
#pragma unroll
        for (int blk = 0; blk < 2; ++blk)
#pragma unroll
            for (int rr = 0; rr < 4; ++rr) zz[blk][rr] = *(const u32x2*)(SZA + (size_t)qrow * DM + 64 * hq + 32 * blk + 8 * rr + 4 * hi);
        if (id + G < idEnd) ATT_FETCH(id + G);
        const int minkr = R_META - (kbase + i0);
        float mrun = sink2, lrun = hi ? 0.f : 1.f;
        f32x16 O[2]; O[0] = (f32x16){}; O[1] = (f32x16){};
#pragma unroll
        for (int kb = 0; kb < 5; ++kb) {
            f32x16 S = (f32x16){};
#pragma unroll
            for (int d0 = 0; d0 < 4; ++d0) { const bf16x8 a = *(const LAS bf16x8*)(Ks + (i0 + 32 * kb + ql) * 144 + (16 * d0 + 8 * hi) * 2); S = __builtin_amdgcn_mfma_f32_32x32x16_bf16(a, qr[d0], S, 0, 0, 0); }
            if (kb == 0) {
#pragma unroll
                for (int r = 0; r < 16; ++r) if (crow(r, hi) < ql) S[r] = -INFINITY;
            }
            if (kb == 4) {
#pragma unroll
                for (int r = 0; r < 16; ++r) if (crow(r, hi) > ql) S[r] = -INFINITY;
            }
            if (minkr > 32 * kb) {
#pragma unroll
                for (int r = 0; r < 16; ++r) if (32 * kb + crow(r, hi) < minkr) S[r] = -INFINITY;
            }
            float mb = S[0];
#pragma unroll
            for (int r = 1; r < 16; ++r) mb = fmaxf(mb, S[r]);
            mb = fmaxf(mb, __shfl_xor(mb, 32));
            const float mn = fmaxf(mrun, mb), alpha = __builtin_amdgcn_exp2f(mrun - mn); mrun = mn;
            float ps = 0.f;
#pragma unroll
            for (int r = 0; r < 16; ++r) { const float p = __builtin_amdgcn_exp2f(S[r] - mn); S[r] = p; ps += p; }
            lrun = lrun * alpha + ps;
            O[0] = O[0] * alpha; O[1] = O[1] * alpha;
#pragma unroll
            for (int s = 0; s < 2; ++s) {
                const bf16x8 pb = packp(S, s);
#pragma unroll
                for (int blk = 0; blk < 2; ++blk) {
                    const LAS unsigned char* vp = Vs + (32 * blk + ql) * 392 + (i0 + 32 * kb + 16 * s + 4 * hi) * 2;
                    const u32x2 lo = *(const LAS u32x2*)vp, hh = *(const LAS u32x2*)(vp + 16);
                    const u32x4 av = {lo.x, lo.y, hh.x, hh.y};
                    O[blk] = __builtin_amdgcn_mfma_f32_32x32x16_bf16(__builtin_bit_cast(bf16x8, av), pb, O[blk], 0, 0, 0);
                }
            }
        }
        lrun += __shfl_xor(lrun, 32);
        const float inv_l = 1.0f / lrun;
#pragma unroll
        for (int blk = 0; blk < 2; ++blk)
#pragma unroll
            for (int rr = 0; rr < 4; ++rr) {
                const size_t off = (size_t)qrow * DM + 64 * hq + 32 * blk + 8 * rr + 4 * hi; const u32x2 z = zz[blk][rr];
                u32x2 w; w.x = cvt_pk_bf16(O[blk][4 * rr] * inv_l * bf_lo(z.x), O[blk][4 * rr + 1] * inv_l * bf_hi(z.x)); w.y = cvt_pk_bf16(O[blk][4 * rr + 2] * inv_l * bf_lo(z.y), O[blk][4 * rr + 3] * inv_l * bf_hi(z.y));
                *(u32x2*)(QA + off) = w;
            }
        __syncthreads();
    }
#undef ATT_FETCH
}

__device__ __forceinline__ bf16x8 cvt8(const f32x4 a, const f32x4 b) { return __builtin_bit_cast(bf16x8, pack8(a, b)); }

__device__ __forceinline__ void attn_sample_unit(int b, int g, int hh, int lane, const float* ck, const float* cv, const bf16_t* Kb, const bf16_t* Vt, bf16_t* QA, const bf16_t* SZA, const float* sinks, float* out) {
    const int ql = lane & 31, hi = lane >> 5, t = ql & 7; const bool cp = (hh == 0);
    const int row = R_SAMPLE + 8 * b + t, head = 4 * g + hh;
    bf16x8 qr[4];
#pragma unroll
    for (int d0 = 0; d0 < 4; ++d0) qr[d0] = *(const bf16x8*)(QA + (size_t)row * DM + 64 * head + 16 * d0 + 8 * hi);
    const float sink2 = sinks[head] * LOG2E;
    const float* ckb = ck + (size_t)b * 128 * 256 + g * 64; const float* cvb = cv + (size_t)b * 128 * 256 + g * 64;
    float* oks = out + O_NKS + (size_t)b * 128 * 256 + g * 64; float* ovs = out + O_NVS + (size_t)b * 128 * 256 + g * 64;
    float m = sink2, l = hi ? 0.f : 1.f;
    f32x16 O[2]; O[0] = (f32x16){}; O[1] = (f32x16){};
    const float NEG = -INFINITY;
#pragma unroll 1
    for (int kb = 0; kb < 5; ++kb) {
        f32x16 S = (f32x16){};
        if (kb < 4) {
            const int s = 32 * kb + ql;
#pragma unroll
            for (int d0 = 0; d0 < 4; ++d0) {
                const float* p = ckb + (size_t)s * 256 + 16 * d0 + 8 * hi; const f32x4 x0 = *(const f32x4*)p, x1 = *(const f32x4*)(p + 4);
                if (cp && s >= 8) { float* o = oks + (size_t)(s - 8) * 256 + 16 * d0 + 8 * hi; *(f32x4*)o = x0; *(f32x4*)(o + 4) = x1; }
                S = __builtin_amdgcn_mfma_f32_32x32x16_bf16(cvt8(x0, x1), qr[d0], S, 0, 0, 0);
            }
        } else {
#pragma unroll
            for (int d0 = 0; d0 < 4; ++d0) {
                u32x4 kv = {0u, 0u, 0u, 0u};
                if (ql < 8) kv = *(const u32x4*)(Kb + (size_t)(R_SAMPLE + 8 * b + ql) * 256 + g * 64 + 16 * d0 + 8 * hi);
                S = __builtin_amdgcn_mfma_f32_32x32x16_bf16(__builtin_bit_cast(bf16x8, kv), qr[d0], S, 0, 0, 0);
            }
        }
        if (kb == 0) {
#pragma unroll
            for (int r = 0; r < 16; ++r) if (crow(r, hi) < t) S[r] = NEG;
        }
        if (kb == 4) {
#pragma unroll
            for (int r = 0; r < 16; ++r) if (crow(r, hi) > t) S[r] = NEG;
        }
        float mb = S[0];
#pragma unroll
        for (int r = 1; r < 16; ++r) mb = fmaxf(mb, S[r]);
        mb = fmaxf(mb, __shfl_xor(mb, 32));
        const float mn = fmaxf(m, mb), alpha = __builtin_amdgcn_exp2f(m - mn); m = mn;
        float ps = 0.f;
#pragma unroll
        for (int r = 0; r < 16; ++r) { const float p = __builtin_amdgcn_exp2f(S[r] - mn); S[r] = p; ps += p; }
        l = l * alpha + ps;
        O[0] = O[0] * alpha; O[1] = O[1] * alpha;
        if (kb < 4) {
#pragma unroll
            for (int s2 = 0; s2 < 2; ++s2) {
                const bf16x8 pb = packp(S, s2);
#pragma unroll
                for (int blk = 0; blk < 2; ++blk) {
                    const int d = 32 * blk + ql;
                    f32x4 v0, v1;
                    const int kk = 32 * kb + 16 * s2 + 4 * hi;
                    const float* vsrc = cvb + (size_t)kk * 256 + d; float* vdst = ovs + (size_t)kk * 256 + d - 8 * 256;
                    v0.x = vsrc[0]; v0.y = vsrc[256]; v0.z = vsrc[512]; v0.w = vsrc[768]; v1.x = vsrc[2048]; v1.y = vsrc[2304]; v1.z = vsrc[2560]; v1.w = vsrc[2816];
                    if (cp && kk >= 8) { vdst[0] = v0.x; vdst[256] = v0.y; vdst[512] = v0.z; vdst[768] = v0.w; }
                    if (cp) { vdst[2048] = v1.x; vdst[2304] = v1.y; vdst[2560] = v1.z; vdst[2816] = v1.w; }
                    O[blk] = __builtin_amdgcn_mfma_f32_32x32x16_bf16(cvt8(v0, v1), pb, O[blk], 0, 0, 0);
                }
            }
        } else {
            const bf16x8 pb = packp(S, 0);
#pragma unroll
            for (int blk = 0; blk < 2; ++blk) {
                const int d = 32 * blk + ql;
                const u32x2 lo = *(const u32x2*)(Vt + (size_t)(g * 64 + d) * MROWS + R_SAMPLE + 8 * b + 4 * hi);
                const u32x4 av = {lo.x, lo.y, 0u, 0u};
                O[blk] = __builtin_amdgcn_mfma_f32_32x32x16_bf16(__builtin_bit_cast(bf16x8, av), pb, O[blk], 0, 0, 0);
            }
        }
    }
    l += __shfl_xor(l, 32);
    if (ql < 8) attn_store(O, 1.0f / l, row, head, hi, SZA, QA);
}

__device__ __forceinline__ void attn_sample_wg(LAS unsigned char* lds, int tid, int id, const float* ck, const float* cv, const bf16_t* Kb, const bf16_t* Vt, bf16_t* QA, const bf16_t* SZA, const float* sinks, float* out) {
    const int lane = tid & 63, wid = __builtin_amdgcn_readfirstlane(tid >> 6), ql = lane & 31, hi = lane >> 5, t = ql & 7;
    const int b = id >> 1, gp = id & 1;
    constexpr int KSG = 160 * 144, VSG = 64 * 328;
    LAS unsigned char* Ks = lds; LAS unsigned char* Vs = lds + 2 * KSG;
    const float* ckb = ck + (size_t)b * 128 * 256 + gp * 128; const float* cvb = cv + (size_t)b * 128 * 256 + gp * 128;
    float* oks = out + O_NKS + (size_t)b * 128 * 256 + gp * 128; float* ovs = out + O_NVS + (size_t)b * 128 * 256 + gp * 128;
#pragma unroll
    for (int i = 0; i < 8; ++i) {
        const int idx = tid + 512 * i, srow = idx >> 5, c4 = idx & 31, gl = c4 >> 4, d = (c4 & 15) * 4;
        const f32x4 k4 = *(const f32x4*)(ckb + (size_t)srow * 256 + c4 * 4), v4 = *(const f32x4*)(cvb + (size_t)srow * 256 + c4 * 4);
        if (srow >= 8) { *(f32x4*)(oks + (size_t)(srow - 8) * 256 + c4 * 4) = k4; *(f32x4*)(ovs + (size_t)(srow - 8) * 256 + c4 * 4) = v4; }
        u32x2 kw; kw.x = cvt_pk_bf16(k4.x, k4.y); kw.y = cvt_pk_bf16(k4.z, k4.w);
        *(LAS u32x2*)(Ks + gl * KSG + srow * 144 + d * 2) = kw;
        const unsigned v01 = cvt_pk_bf16(v4.x, v4.y), v23 = cvt_pk_bf16(v4.z, v4.w);
        LAS bf16_t* vp = (LAS bf16_t*)(Vs + gl * VSG + d * 328 + srow * 2);
        vp[0] = (bf16_t)(v01 & 0xffffu); vp[164] = (bf16_t)(v01 >> 16); vp[328] = (bf16_t)(v23 & 0xffffu); vp[492] = (bf16_t)(v23 >> 16);
    }
    if (tid < 128) {
        const int j = tid >> 4, c8 = tid & 15, gl = c8 >> 3, d = (c8 & 7) * 8;
        *(LAS u32x4*)(Ks + gl * KSG + (128 + j) * 144 + d * 2) = *(const u32x4*)(Kb + (size_t)(R_SAMPLE + 8 * b + j) * 256 + (2 * gp + gl) * 64 + d);
    } else if (tid < 256) {
        const int gl = (tid - 128) >> 6, d = (tid - 128) & 63;
        const u32x4 v = *(const u32x4*)(Vt + (size_t)((2 * gp + gl) * 64 + d) * MROWS + R_SAMPLE + 8 * b);
        LAS u32x2* p = (LAS u32x2*)(Vs + gl * VSG + d * 328 + 256); p[0] = (u32x2){v.x, v.y}; p[1] = (u32x2){v.z, v.w};
    } else if (tid < 384) {
        const int gl = (tid - 256) >> 6, d = (tid - 256) & 63;
        LAS u32x2* p = (LAS u32x2*)(Vs + gl * VSG + d * 328 + 272);
#pragma unroll
        for (int q = 0; q < 6; ++q) p[q] = (u32x2){0u, 0u};
    }
    const int gl = wid >> 2, hh = wid & 3, head = 4 * (2 * gp + gl) + hh, row = R_SAMPLE + 8 * b + t;
    bf16x8 qr[4];
#pragma unroll
    for (int d0 = 0; d0 < 4; ++d0) qr[d0] = *(const bf16x8*)(QA + (size_t)row * DM + 64 * head + 16 * d0 + 8 * hi);
    const float sink2 = sinks[head] * LOG2E;
    __syncthreads();
    const LAS unsigned char* Kg = Ks + gl * KSG; const LAS unsigned char* Vg = Vs + gl * VSG;
    f32x16 S[5];
#pragma unroll
    for (int kb = 0; kb < 5; ++kb) {
        S[kb] = (f32x16){};
#pragma unroll
        for (int d0 = 0; d0 < 4; ++d0) { const bf16x8 a = *(const LAS bf16x8*)(Kg + (32 * kb + ql) * 144 + (16 * d0 + 8 * hi) * 2); S[kb] = __builtin_amdgcn_mfma_f32_32x32x16_bf16(a, qr[d0], S[kb], 0, 0, 0); }
    }
    const float inv_l = sink_softmax5(S, t, hi, sink2, 0);
    f32x16 O[2]; O[0] = (f32x16){}; O[1] = (f32x16){};
#pragma unroll
    for (int kb = 0; kb < 5; ++kb)
#pragma unroll
        for (int s2 = 0; s2 < 2; ++s2) {
            const bf16x8 pb = packp(S[kb], s2);
#pragma unroll
            for (int blk = 0; blk < 2; ++blk) {
                const LAS unsigned char* vp = Vg + (32 * blk + ql) * 328 + (32 * kb + 16 * s2 + 4 * hi) * 2;
                const u32x2 lo = *(const LAS u32x2*)vp, h2 = *(const LAS u32x2*)(vp + 16);
                const u32x4 av = {lo.x, lo.y, h2.x, h2.y};
                O[blk] = __builtin_amdgcn_mfma_f32_32x32x16_bf16(__builtin_bit_cast(bf16x8, av), pb, O[blk], 0, 0, 0);
            }
        }
    if (ql < 8) attn_store(O, inv_l, row, head, hi, SZA, QA);
    __syncthreads();
}

__device__ __forceinline__ void conv_pass(int gtid, int nthr, int item_lo, int item_hi, const bf16_t* U, bf16_t* BZ, const float* cw, const float* state) {
    const int ch = (gtid & 127) * 8;
    float w0[8], w1[8], w2[8];
#pragma unroll
    for (int e = 0; e < 8; ++e) { w0[e] = cw[ch + e]; w1[e] = cw[DM + ch + e]; w2[e] = cw[2 * DM + ch + e]; }
    for (int item = item_lo + (gtid >> 7); item < item_hi; item += nthr >> 7) {
        const int r0 = R_PROMPT + 8 * item;
        float um2[8], um1[8];
        if (r0 < R_SAMPLE) {
            const u32x4 a = *(const u32x4*)(U + (size_t)(r0 - 2) * DM + ch), b = *(const u32x4*)(U + (size_t)(r0 - 1) * DM + ch);
            um2[0] = bf_lo(a.x); um2[1] = bf_hi(a.x); um2[2] = bf_lo(a.y); um2[3] = bf_hi(a.y); um2[4] = bf_lo(a.z); um2[5] = bf_hi(a.z); um2[6] = bf_lo(a.w); um2[7] = bf_hi(a.w);
            um1[0] = bf_lo(b.x); um1[1] = bf_hi(b.x); um1[2] = bf_lo(b.y); um1[3] = bf_hi(b.y); um1[4] = bf_lo(b.z); um1[5] = bf_hi(b.z); um1[6] = bf_lo(b.w); um1[7] = bf_hi(b.w);
        } else {
            const float* st = state + (size_t)((r0 - R_SAMPLE) >> 3) * 2 * DM + ch;
#pragma unroll
            for (int e = 0; e < 8; ++e) { um2[e] = st[e]; um1[e] = st[DM + e]; }
        }
#pragma unroll
        for (int i = 0; i < 8; ++i) {
            const size_t off = (size_t)(r0 + i) * DM + ch;
            const u32x4 a = *(const u32x4*)(U + off), z = *(const u32x4*)(BZ + off);
            float uc[8], bz[8], o[8];
            uc[0] = bf_lo(a.x); uc[1] = bf_hi(a.x); uc[2] = bf_lo(a.y); uc[3] = bf_hi(a.y); uc[4] = bf_lo(a.z); uc[5] = bf_hi(a.z); uc[6] = bf_lo(a.w); uc[7] = bf_hi(a.w);
            bz[0] = bf_lo(z.x); bz[1] = bf_hi(z.x); bz[2] = bf_lo(z.y); bz[3] = bf_hi(z.y); bz[4] = bf_lo(z.z); bz[5] = bf_hi(z.z); bz[6] = bf_lo(z.w); bz[7] = bf_hi(z.w);
#pragma unroll
            for (int e = 0; e < 8; ++e) { o[e] = bz[e] * (w0[e] * um2[e] + w1[e] * um1[e] + w2[e] * uc[e]); um2[e] = um1[e]; um1[e] = uc[e]; }
            u32x4 w; w.x = cvt_pk_bf16(o[0], o[1]); w.y = cvt_pk_bf16(o[2], o[3]); w.z = cvt_pk_bf16(o[4], o[5]); w.w = cvt_pk_bf16(o[6], o[7]);
            *(u32x4*)(BZ + off) = w;
        }
    }
}


#define XB_TMO      128
#define XB_XCNT(j)  (256  + 64 * (j))
#define XB_XSUB(j)  (1280 + 64 * (j))
#define XB_XGEN(j)  (2304 + 64 * (j))
#define XB_TOP      3328
#define XB_TOPGEN   3392
#define XCD_BAR_WORDS 3456
#define XB_SPIN_CAP (1u << 18)
__device__ __forceinline__ unsigned xb_xcc_id() { return (unsigned)__builtin_amdgcn_s_getreg((3 << 11) | 20) & 0xFu; }
#define XB_SPIN(cond, bar) do { unsigned _sp = 0; while (cond) { __builtin_amdgcn_s_sleep(1); \
    if ((++_sp & 255u) == 0u) { if (xb_ld(&(bar)[XB_TMO])) break; if (_sp > XB_SPIN_CAP) { atomicAdd(&(bar)[XB_TMO], 1u); break; } } } } while (0)
struct XcdBarrier { unsigned* bar; unsigned x; volatile LAS unsigned* st; };
__device__ __forceinline__ XcdBarrier xcd_barrier_post(unsigned* bar, volatile LAS unsigned* st) {
    XcdBarrier b; b.bar = bar; b.x = xb_xcc_id(); b.st = st;
    if (threadIdx.x == 0) (void)xb_add(&bar[XB_XCNT(b.x)], 1u);
    return b;
}
__device__ __forceinline__ void xcd_barrier_complete(unsigned* bar, unsigned x, unsigned& nloc, unsigned& nx) {
    const unsigned G = gridDim.x * gridDim.y * gridDim.z;
    unsigned sum, cnt, mine, sp = 0u;
    for (;;) {
        sum = 0u; cnt = 0u; mine = 0u;
#pragma unroll
        for (unsigned j = 0; j < 16; ++j) { const unsigned c = xb_ld(&bar[XB_XCNT(j)]); sum += c; cnt += (c > 0u) ? 1u : 0u; mine = (j == x) ? c : mine; }
        if (sum == G) break;
        __builtin_amdgcn_s_sleep(1);
        if ((++sp & 255u) == 0u) { if (xb_ld(&bar[XB_TMO])) break; if (sp > XB_SPIN_CAP) { atomicAdd(&bar[XB_TMO], 1u); break; } }
    }
    nloc = mine > 0u ? mine : 1u; nx = cnt > 0u ? cnt : 1u;
}
__device__ __forceinline__ void xcd_barrier(const XcdBarrier& b) {
    asm volatile("s_waitcnt vmcnt(0)" ::: "memory");
    __syncthreads();
    if (threadIdx.x == 0) {
        unsigned* bar = b.bar;
        __builtin_amdgcn_s_waitcnt(0);
        unsigned nloc = b.st[0], nx = b.st[1];
        if (nloc == 0u) { xcd_barrier_complete(bar, b.x, nloc, nx); b.st[0] = nloc; b.st[1] = nx; }
        const unsigned old = xb_add(&bar[XB_XSUB(b.x)], 1u);
        const unsigned gen = old / nloc;
        if (old + 1u == (gen + 1u) * nloc) {
            __builtin_amdgcn_fence(__ATOMIC_RELEASE, "agent");
            asm volatile("s_waitcnt vmcnt(0)" ::: "memory");
            const unsigned og = xb_add(&bar[XB_TOP], 1u);
            const unsigned tg = og / nx;
            if (og + 1u == (tg + 1u) * nx) xb_add(&bar[XB_TOPGEN], 1u);
            else XB_SPIN(xb_ld(&bar[XB_TOPGEN]) == tg, bar);
            __builtin_amdgcn_fence(__ATOMIC_ACQUIRE, "agent");
            xb_add(&bar[XB_XGEN(b.x)], 1u);
            asm volatile("s_waitcnt vmcnt(0)" ::: "memory");
        } else {
            XB_SPIN(xb_ld(&bar[XB_XGEN(b.x)]) == gen, bar);
            __builtin_amdgcn_fence(__ATOMIC_ACQUIRE, "agent");
            asm volatile("s_waitcnt vmcnt(0)" ::: "memory");
        }
    }
    __syncthreads();
}

__device__ __forceinline__ void sub_barrier(unsigned* word, unsigned nwg) {
    asm volatile("s_waitcnt vmcnt(0)" ::: "memory");
    __syncthreads();
    if (threadIdx.x == 0) {
        __builtin_amdgcn_s_waitcnt(0);
        __builtin_amdgcn_fence(__ATOMIC_RELEASE, "agent");
        asm volatile("s_waitcnt vmcnt(0)" ::: "memory");
        xb_add(word, 1u);
        unsigned sp = 0; while (xb_ld(word) < nwg) { __builtin_amdgcn_s_sleep(1); if (++sp > (1u << 22)) break; }
        __builtin_amdgcn_fence(__ATOMIC_ACQUIRE, "agent");
        asm volatile("s_waitcnt vmcnt(0)" ::: "memory");
    }
    __syncthreads();
}

typedef const __attribute__((address_space(4))) Args* CArgs;
__device__ __forceinline__ CArgs fresh_args() { CArgs p = (CArgs)__builtin_amdgcn_kernarg_segment_ptr(); asm volatile("" : "+s"(p)); return p; }
#define PTRS() CArgs A = fresh_args(); unsigned char* ws = A->ws; \
    bf16_t* XN = (bf16_t*)(ws + WS_B0); bf16_t* QA = (bf16_t*)(ws + WS_QA); bf16_t* BZ = (bf16_t*)(ws + WS_BZ); bf16_t* SZA = (bf16_t*)(ws + WS_SZA); \
    bf16_t* Ub = (bf16_t*)(ws + WS_U); bf16_t* SGB = (bf16_t*)(ws + WS_SGB); bf16_t* Kb = (bf16_t*)(ws + WS_K); bf16_t* Vt = (bf16_t*)(ws + WS_VT); \
    bf16_t* SGA = (bf16_t*)A->out; float* rope = (float*)(ws + WS_ROPE); \
    (void)XN; (void)QA; (void)BZ; (void)SZA; (void)Ub; (void)SGB; (void)Kb; (void)Vt; (void)SGA; (void)rope
#define G2_DECL() const pg8::Gemm g2{QA + (size_t)R_PROMPT * DM, (const bf16_t*)(ws + WS_WA), M23, DM, DM, BUFB, 2097152}; const Epi2 E2{SGA + (size_t)R_PROMPT * DM, SGB + (size_t)R_PROMPT * DM, XN}
#define G3_DECL() const pg8::Gemm g3{XN, (const bf16_t*)(ws + WS_WO), M23, DM, DM, 0, 0}; const Epi3 E3{A->in[0], A->in[1], A->out + O_Y}
__global__ void __launch_bounds__(512, 2) hybrid_fwd(Args a_unused) {
    extern __shared__ __attribute__((aligned(16))) unsigned char lds_raw[];
    LAS unsigned char* lds = (LAS unsigned char*)lds_raw;
    const int G = gridDim.x;
#define TIDS() int tid = threadIdx.x; asm volatile("" : "+v"(tid)); const int lane = tid & 63, wave = __builtin_amdgcn_readfirstlane(tid >> 6); (void)lane; (void)wave
#define GSYNC() xcd_barrier(xbar)
    volatile LAS unsigned* MISC = (volatile LAS unsigned*)(lds + 131072);
    if (threadIdx.x < 4) MISC[threadIdx.x] = 0u;
    __syncthreads();
    XcdBarrier xbar;
    { CArgs A = fresh_args(); xbar = xcd_barrier_post((unsigned*)(A->ws + WS_CTL), MISC);
      if (A->ph_lo > 1000) cg::this_grid().sync(); }
    unsigned long long pt0 = 0, pt1 = 0; (void)pt0; (void)pt1;
#define PSTAMP0(k) do { if (PROBE_PH == (k)) pt0 = __builtin_amdgcn_s_memrealtime(); } while (0)
#define PSTAMP1(k) do { if (PROBE_PH == (k)) pt1 = __builtin_amdgcn_s_memrealtime(); } while (0)
    const bool split = (G == 256);
    constexpr int NSPL = 16;
    PSTAMP0(0);
    { TIDS(); CArgs A = fresh_args(); Args pa; pa.in[0] = A->in[0]; pa.in[1] = A->in[1]; pa.in[5] = A->in[5]; pa.in[6] = A->in[6]; pa.in[7] = A->in[7]; pa.in[12] = A->in[12]; pa.in[13] = A->in[13]; pa.in[14] = A->in[14]; pa.ws = A->ws; p0_prologue(pa, lds, tid, lane, wave, G); }
    GSYNC();
    PSTAMP1(0); PSTAMP0(1);
    {
        PTRS();
        pg8::Gemm g{XN, (const bf16_t*)(ws + WS_WIN), MROWS, NIN, DM, 0, 0}; pg8::StaticOrder S; S.init(MROWS, NIN, G, (int)blockIdx.x, 1); S.special = split ? 1 : 0;
        Epi1 E{QA, Kb, Vt, SZA, BZ, Ub, SGA, SGB, rope, A->in[8], A->in[9], A->out};
        pg8::gemm_phase<Epi1>(lds, g, S, E);
    }
    GSYNC();
    PSTAMP1(1); PSTAMP0(2);
    {
        TIDS(); PTRS();
        for (int id = blockIdx.x; id < 256; id += G) attn_sample_wg(lds, tid, id, A->in[2], A->in[3], Kb, Vt, QA, SZA, A->in[10], A->out);
        conv_pass(blockIdx.x * 512 + tid, G * 512, 2048, M23 / 8, Ub, BZ, A->in[11], A->in[4]);
    }
    GSYNC();
    PSTAMP1(2); PSTAMP0(3); if (PROBE_PH == 6) pt0 = __builtin_amdgcn_s_memrealtime();
    if (split && blockIdx.x < 2 * NSPL) {
        const int c = (int)blockIdx.x, tj = c & (NSPL - 1);
#define SPL_PTRS() PTRS(); float* scr1 = (float*)(ws + WS_B0) + (size_t)tj * 65536; float* scr2 = (float*)(ws + WS_B0) + (size_t)(NSPL + tj) * 65536; \
        unsigned* cnt1 = (unsigned*)(ws + WS_CTL) + 9216 + 64 * tj; unsigned* cnt2 = (unsigned*)(ws + WS_CTL) + 10240 + 64 * tj; unsigned* bar32 = (unsigned*)(ws + WS_CTL) + 8192; \
        (void)scr1; (void)scr2; (void)cnt1; (void)cnt2; (void)bar32
        if (c < NSPL) {
            { SPL_PTRS(); const pg8::Gemm ga{QA + (size_t)R_PROMPT * DM, (const bf16_t*)(ws + WS_WA), M23, DM, DM, 0, 0, 0};
              const EpiPart<false> Ea{nullptr, scr1, nullptr};
              pg8::StaticOrder S; S.init(M23, DM, G, c, 1, 256 + tj); pg8::gemm_phase<EpiPart<false>>(lds, ga, S, Ea); publish_count(cnt1); }
            { SPL_PTRS(); sub_barrier(bar32, 2 * NSPL); }
            { SPL_PTRS(); const pg8::Gemm g3a{XN, (const bf16_t*)(ws + WS_WO), M23, DM, 512, 0, 0, DM};
              const EpiPart<false> Ea{nullptr, scr2, nullptr};
              pg8::StaticOrder S; S.init(M23, DM, G, c, 1, 256 + tj); pg8::gemm_phase<EpiPart<false>>(lds, g3a, S, Ea); publish_count(cnt2); }
        } else {
            { SPL_PTRS(); const pg8::Gemm gb{BZ + (size_t)R_PROMPT * DM, (const bf16_t*)(ws + WS_WB), M23, DM, DM, 0, 0, 0};
              const Epi2b Eb{SGB + (size_t)R_PROMPT * DM, scr1, XN, cnt1, SGA + (size_t)R_PROMPT * DM};
              pg8::StaticOrder S; S.init(M23, DM, G, c, 1, 256 + tj); pg8::gemm_phase<Epi2b>(lds, gb, S, Eb); }
            { SPL_PTRS(); sub_barrier(bar32, 2 * NSPL); }
            { SPL_PTRS(); const pg8::Gemm g3b{XN + 512, (const bf16_t*)(ws + WS_WO) + 512, M23, DM, 512, 0, 0, DM};
              const Epi3b Eb{A->in[0], A->in[1], A->out + O_Y, scr2, cnt2};
              pg8::StaticOrder S; S.init(M23, DM, G, c, 1, 256 + tj); pg8::gemm_phase<Epi3b>(lds, g3b, S, Eb); }
        }
#undef SPL_PTRS
    } else {
        TIDS(); PTRS();
        const int vc = split ? (int)blockIdx.x - 2 * NSPL : (int)blockIdx.x, VG = split ? G - 2 * NSPL : G;
        if (split) {
            const int nd = vc < 150 ? 1 : 2, j0 = vc < 150 ? vc : 150 + 2 * (vc - 150);
            for (int k = 0; k < nd; ++k) {
                const int j = j0 + k, q = j - 2, dpm = j < 2 ? 26 : 27 + (q >> 3), dpn = j < 2 ? 32 + j : 26 + (q & 7);
                pg8::Gemm g{XN, (const bf16_t*)(ws + WS_WIN), MROWS, NIN, DM, 0, 0}; pg8::StaticOrder S; S.init(MROWS, NIN, G, (int)blockIdx.x, 1, dpm * 34 + dpn);
                Epi1 E{QA, Kb, Vt, SZA, BZ, Ub, SGA, SGB, rope, A->in[8], A->in[9], A->out};
                pg8::gemm_phase<Epi1>(lds, g, S, E);
            }
        }
        {
            const int a0 = !split ? vc : (vc < 150 ? 5 * vc : (vc < 172 ? 750 + 3 * (vc - 150) : 816 + 4 * (vc - 172))), na = vc < 150 ? 5 : (vc < 172 ? 3 : 4);
            attn_prompt_all(lds, tid, a0, split ? 1 : VG, split ? a0 + na : 1024, Kb, Vt, QA, SZA, A->in[10]);
        }
        { int tid2 = threadIdx.x; asm volatile("" : "+v"(tid2)); conv_pass(vc * 512 + tid2, VG * 512, 0, 2048, Ub, BZ, A->in[11], A->in[4]); }
    }
    if (PROBE_PH == 6) pt1 = __builtin_amdgcn_s_memrealtime();
    GSYNC();
    PSTAMP1(3); PSTAMP0(4);
    { PTRS(); G2_DECL(); pg8::StaticOrder S; S.init(split ? 16384 : M23, DM, G, (int)blockIdx.x, 2); pg8::gemm_phase<Epi2>(lds, g2, S, E2); }
    GSYNC();
#if REP_MASK & 8
    { PTRS(); G2_DECL(); pg8::StaticOrder S; S.init(split ? 16384 : M23, DM, G, (int)blockIdx.x, 2); pg8::gemm_phase<Epi2>(lds, g2, S, E2); }
    GSYNC();
#endif
    PSTAMP1(4); PSTAMP0(5);
    { PTRS(); G3_DECL(); pg8::StaticOrder S; S.init(split ? 16384 : M23, DM, G, (int)blockIdx.x, 1); pg8::gemm_phase<Epi3>(lds, g3, S, E3); }
#if REP_MASK & 16
    GSYNC();
    { PTRS(); G3_DECL(); pg8::StaticOrder S; S.init(split ? 16384 : M23, DM, G, (int)blockIdx.x, 1); pg8::gemm_phase<Epi3>(lds, g3, S, E3); }
#endif
    PSTAMP1(5);
    if (PROBE_PH >= 0 && blockIdx.x == PROBE_BLK) { const unsigned long long te = __builtin_amdgcn_s_memrealtime(); while (__builtin_amdgcn_s_memrealtime() - te < pt1 - pt0) __builtin_amdgcn_s_sleep(8); }
#undef GSYNC
}

#ifndef DBG_DUMP
#define DBG_DUMP 0
#endif
__global__ void dbg_dump(const bf16_t* src, float* dst, size_t n) {
    for (size_t i = (size_t)blockIdx.x * blockDim.x + threadIdx.x; i < n; i += (size_t)gridDim.x * blockDim.x) dst[i] = __uint_as_float((unsigned)src[i] << 16);
}
extern "C" void kernel_launch(void* const* d_in, const int* in_sizes, int n_in, void* d_out, int out_size, void* d_ws, size_t ws_size, hipStream_t stream) {
    static int grid = 0;
    if (grid == 0) {
        int dev = 0, cus = 0, per_cu = 0;
        if (n_in != 15 || ws_size < WS_END) { fprintf(stderr, "kernel_launch: unexpected inputs (n_in %d, ws %zu)\n", n_in, ws_size); grid = -1; return; }
        if (hipGetDevice(&dev) != hipSuccess || hipDeviceGetAttribute(&cus, hipDeviceAttributeMultiprocessorCount, dev) != hipSuccess) { grid = -1; return; }
        if (hipFuncSetAttribute((const void*)hybrid_fwd, hipFuncAttributeMaxDynamicSharedMemorySize, LDS_BYTES) != hipSuccess) { fprintf(stderr, "kernel_launch: hipFuncSetAttribute failed\n"); grid = -1; return; }
        if (hipOccupancyMaxActiveBlocksPerMultiprocessor(&per_cu, (const void*)hybrid_fwd, 512, LDS_BYTES) != hipSuccess || per_cu < 1) { fprintf(stderr, "kernel_launch: occupancy query gives %d\n", per_cu); per_cu = 1; }
        (void)hipGetLastError();
        grid = cus * 1;
    }
    if (grid < 0) return;
    Args a{};
    for (int i = 0; i < 15; ++i) a.in[i] = (const float*)d_in[i];
    a.out = (float*)d_out; a.ws = (unsigned char*)d_ws;
    if (hipMemsetAsync((char*)d_ws + WS_CTL, 0, CTL_BYTES, stream) != hipSuccess) { fprintf(stderr, "kernel_launch: memset of the barrier words failed\n"); return; }
    a.ph_lo = 0; a.ph_hi = 5;
    void* args[] = {&a};
    hipError_t e = hipLaunchCooperativeKernel((const void*)hybrid_fwd, dim3(grid), dim3(512), args, LDS_BYTES, stream);
    if (e != hipSuccess) fprintf(stderr, "cooperative launch failed: %s (grid %d)\n", hipGetErrorString(e), grid);
}
```

```cpp
#include <hip/hip_runtime.h>
#include <hip/hip_cooperative_groups.h>
#include <cstdio>
#include <cstdint>
namespace cg = cooperative_groups;

#ifndef CHAIN_LATE
#define CHAIN_LATE 0
#endif
#ifndef PROBE_BLK
#define PROBE_BLK 32
#endif
#ifndef PROBE_PH
#define PROBE_PH -1
#endif
#ifndef REP_MASK
#define REP_MASK 0
#endif
#ifndef DBG_NPH
#define DBG_NPH 5
#define DBG_DUMP 0
#endif
#ifndef MK_N_LAUNCHES
#define MK_N_LAUNCHES 1
#endif

#define LAS __attribute__((address_space(3)))
typedef unsigned short bf16_t;
typedef short bf16x8 __attribute__((ext_vector_type(8)));
typedef float f32x4 __attribute__((ext_vector_type(4)));
typedef float f32x16 __attribute__((ext_vector_type(16)));
typedef unsigned u32x4 __attribute__((ext_vector_type(4)));
typedef unsigned u32x2 __attribute__((ext_vector_type(2)));

constexpr int DM = 1024, NIN = 8704;
constexpr int R_META = 112, R_PROMPT = 128, R_SAMPLE = 16512, R_END = 17536, MROWS = 17664;
constexpr int M23 = 17408;
constexpr int NPOS = 16400;
constexpr float EPS = 1e-6f;
constexpr float LOG2E = 1.4426950408889634f;
constexpr float C2 = 0.125f * LOG2E;
constexpr size_t O_Y = 0, O_NKP = 17825792, O_NVP = 17858560, O_NCP = 17891328, O_NKS = 17893376, O_NVS = 22087680, O_NCS = 26281984;
constexpr size_t BUFB = (size_t)MROWS * DM * 2;
constexpr size_t WS_WIN = 0, WS_WA = (size_t)NIN * DM * 2, WS_WB = WS_WA + 2097152, WS_WO = WS_WB + 2097152;
constexpr size_t WS_B0 = 25165824;
constexpr size_t WS_QA = WS_B0 + BUFB, WS_BZ = WS_QA + BUFB, WS_SZA = WS_BZ + BUFB, WS_U = WS_SZA + BUFB, WS_SGB = WS_U + BUFB;
constexpr size_t WS_K = WS_SGB + BUFB, WS_VT = WS_K + (size_t)MROWS * 256 * 2, WS_ROPE = WS_VT + (size_t)MROWS * 256 * 2, WS_END = WS_ROPE + (size_t)NPOS * 64 * 4;
constexpr size_t WS_CTL = 265289728, CTL_BYTES = 65536;
static_assert(WS_END <= WS_CTL && WS_CTL + CTL_BYTES <= 268435456, "d_ws map");

constexpr int LDS_BYTES = 147456;

namespace pg8 {
constexpr int BM = 256, BK = 64, HALF = 128, HTB = HALF * BK * 2, STAGE_BYTES = 8 * HTB, NXCD = 8, WGM = 8;
__host__ __device__ __forceinline__ int lds_byte(int r, int c) { const int st = (r >> 4) * 2 + (c >> 5), rr = r & 15, cc = c & 31, ob = rr * 64 + cc * 2; return st * 1024 + (ob ^ (((ob >> 9) & 1) << 5)); }
__host__ __device__ __forceinline__ void stage_rc(int b, int& R, int& C) { const int st = b / 1024, sb = b % 1024, swz = sb ^ (((sb >> 9) & 1) << 5); R = (st >> 1) * 16 + swz / 64; C = (st & 1) * 32 + (swz % 64) / 2; }
__host__ __device__ __forceinline__ int perm32(int rho) { const int n = rho >> 4, i = rho & 15; return 8 * (i >> 2) + 4 * n + (i & 3); }

struct Unit { int pm, pn, part; };
struct Gemm { const bf16_t* A; const bf16_t* Bt; int M, N, K; size_t partA, partB; int ld; };

struct StaticOrder {
    int nM, nN, nwg, G, c, np, direct, special;
    __host__ __device__ void init(int M, int N, int G_, int c_, int np_, int direct_ = -1) { nM = M / BM; nN = N / BM; nwg = nM * nN; G = G_; c = c_; np = np_; direct = direct_; special = 0; }
    __host__ __device__ static void swz(int wgid, int nM_, int nN_, int& pm, int& pn) {
        const int nwg_ = nM_ * nN_;
        { const int q = nwg_ / NXCD, r = nwg_ % NXCD, xcd = wgid % NXCD, off = wgid / NXCD; wgid = (xcd < r ? xcd * (q + 1) : r * (q + 1) + (xcd - r) * q) + off; }
        const int nig = WGM * nN_, gid = wgid / nig, fm = gid * WGM, gsz = (nM_ - fm) < WGM ? (nM_ - fm) : WGM;
        pm = fm + ((wgid % nig) % gsz); pn = (wgid % nig) / gsz;
    }
    __host__ __device__ bool next(int i, Unit& u) const {
        const int it = (np == 2) ? (i >> 1) : i; u.part = (np == 2) ? (i & 1) : 0;
        if (direct >= 0) { if (it > 0) return false; u.pm = direct / nN; u.pn = direct % nN; return true; }
        const long L = (long)it * G + c;
        if (special) {
            if (L >= 2048) return false;
            int l = (int)L;
            if (l < 884) { swz(l, 26, 34, u.pm, u.pn); return true; } l -= 884;
            if (l < 1118) { swz(l, 43, 26, u.pm, u.pn); u.pm += 26; return true; } l -= 1118;
            if (l < 40) { u.pm = 64 + (l >> 3); u.pn = 26 + (l & 7); return true; } l -= 40;
            u.pm = 26; u.pn = 26 + l; return true;
        }
        if (L >= nwg) return false;
        swz((int)L, nM, nN, u.pm, u.pn); return true;
    }
};

typedef float f32x2_t __attribute__((ext_vector_type(2))); typedef __bf16 bf16x2_t __attribute__((ext_vector_type(2)));
__device__ __forceinline__ unsigned cvt_pk_bf16(float lo, float hi) { const f32x2_t v = {lo, hi}; const bf16x2_t b = __builtin_convertvector(v, bf16x2_t); return __builtin_bit_cast(unsigned, b); }

template <class Epi>
__device__ __forceinline__ void gemm_phase(LAS unsigned char* lds, const Gemm g, const StaticOrder& S, const Epi& E) {
    int tid_ = threadIdx.x; asm volatile("" : "+v"(tid_));
    const int tid = tid_, wid = __builtin_amdgcn_readfirstlane(tid >> 6), lane = tid & 63, wr = wid >> 2, wc = wid & 3, fr = lane & 15, fq = lane >> 4;
    const int K = g.ld ? g.ld : g.K, nt = g.K / BK;
    unsigned voffA[2], voffB[2];
#pragma unroll
    for (int i = 0; i < 2; ++i) { int R, C; stage_rc(tid * 16 + i * 8192, R, C); const int Rb = ((R & ~31) + perm32(R & 31));
        voffA[i] = (unsigned)(R * K + C) * 2u; voffB[i] = (unsigned)(Rb * K + C) * 2u; }
    const size_t kstep = (size_t)(BK * 2);
    const size_t hstep = (size_t)HALF * K * 2;
    const size_t tstep = 2 * hstep;
    const unsigned ldsw = (unsigned)wid * 1024u;
    const int aoff = lds_byte(wr * 64 + fr, fq * 8), boff = lds_byte(wc * 32 + fr, fq * 8);
#define PG8_SA(b, h) (((b) * 2 + (h)) * HTB)
#define PG8_SB(b, h) ((4 + (b) * 2 + (h)) * HTB)
#define PG8_STAGE(bufoff, gbase, voff) do { _Pragma("unroll") for (int _i = 0; _i < 2; ++_i) \
        __builtin_amdgcn_global_load_lds((const unsigned*)((const char*)(gbase) + (voff)[_i]), (LAS unsigned*)(lds + (bufoff) + ldsw + _i * 8192), 16, 0, 0); } while (0)
#define PG8_LDA(dst, b, h) do { _Pragma("unroll") for (int m = 0; m < 4; ++m) _Pragma("unroll") for (int k = 0; k < 2; ++k) dst[m][k] = *(const LAS bf16x8*)(lds + PG8_SA(b, h) + aoff + m * 2048 + k * 1024); } while (0)
#define PG8_LDB(dst, b, h) do { _Pragma("unroll") for (int n = 0; n < 2; ++n) _Pragma("unroll") for (int k = 0; k < 2; ++k) dst[n][k] = *(const LAS bf16x8*)(lds + PG8_SB(b, h) + boff + n * 2048 + k * 1024); } while (0)
#define PG8_MMA(ai, bj, At, Bt) do { __builtin_amdgcn_s_setprio(1); _Pragma("unroll") for (int m = 0; m < 4; ++m) _Pragma("unroll") for (int n = 0; n < 2; ++n) _Pragma("unroll") for (int k = 0; k < 2; ++k) \
        acc[ai][bj][m][n] = __builtin_amdgcn_mfma_f32_16x16x32_bf16(Bt[n][k], At[m][k], acc[ai][bj][m][n], 0, 0, 0); __builtin_amdgcn_s_setprio(0); } while (0)
#define PG8_WAIT_V(n) asm volatile("s_waitcnt vmcnt(" #n ")" ::: "memory")
#define PG8_WAIT_L(n) asm volatile("s_waitcnt lgkmcnt(" #n ")" ::: "memory")
#define PG8_BAR __builtin_amdgcn_s_barrier()
#define PG8_SCHED __builtin_amdgcn_sched_barrier(0)
    Unit cur, nxt; int ui = 0;
    if (!S.next(0, cur)) return;
    f32x4 acc[2][2][4][2];
#pragma unroll
    for (int a = 0; a < 2; ++a)
#pragma unroll
        for (int b = 0; b < 2; ++b)
#pragma unroll
            for (int m = 0; m < 4; ++m)
#pragma unroll
                for (int n = 0; n < 2; ++n) acc[a][b][m][n] = (f32x4){0.f, 0.f, 0.f, 0.f};
    bf16x8 At[4][2], B0[2][2], B1[2][2];
    const char* cA = (const char*)g.A + (size_t)cur.pm * tstep + (size_t)cur.part * g.partA; const char* cB = (const char*)g.Bt + (size_t)cur.pn * tstep + (size_t)cur.part * g.partB;
    PG8_STAGE(PG8_SB(0, 0), cB, voffB); PG8_STAGE(PG8_SB(0, 1), cB + hstep, voffB); PG8_STAGE(PG8_SA(0, 0), cA, voffA); PG8_STAGE(PG8_SA(0, 1), cA + hstep, voffA);
    if (wr == 1) PG8_BAR;
    PG8_WAIT_V(2); PG8_BAR;
    PG8_STAGE(PG8_SB(1, 0), cB + kstep, voffB); PG8_STAGE(PG8_SA(1, 0), cA + kstep, voffA); PG8_STAGE(PG8_SB(1, 1), cB + hstep + kstep, voffB);
    PG8_WAIT_V(6); PG8_BAR;
    for (;;) {
        const bool has_next = S.next(ui + 1, nxt);
        const char* nA = has_next ? (const char*)g.A + (size_t)nxt.pm * tstep + (size_t)nxt.part * g.partA : cA; const char* nB = has_next ? (const char*)g.Bt + (size_t)nxt.pn * tstep + (size_t)nxt.part * g.partB : cB;
        for (int t = 0; t < nt; t += 2) {
            const bool last = (t == nt - 2);
            const char* a1 = cA + (size_t)(t + 1) * kstep;
            const char* a2 = last ? nA : cA + (size_t)(t + 2) * kstep; const char* b2 = last ? nB : cB + (size_t)(t + 2) * kstep;
            const char* a3 = a2 + kstep; const char* b3 = b2 + kstep;
            PG8_LDB(B0, 0, 0); PG8_LDB(B1, 0, 1); PG8_SCHED; PG8_LDA(At, 0, 0); PG8_STAGE(PG8_SA(1, 1), a1 + hstep, voffA);
            PG8_WAIT_V(8); PG8_WAIT_L(0); PG8_BAR; PG8_MMA(0, 0, At, B0); PG8_MMA(0, 1, At, B1); PG8_BAR; PG8_SCHED;
            PG8_LDA(At, 0, 1); PG8_STAGE(PG8_SB(0, 0), b2, voffB); PG8_STAGE(PG8_SB(0, 1), b2 + hstep, voffB); PG8_STAGE(PG8_SA(0, 0), a2, voffA);
            PG8_WAIT_V(8); PG8_WAIT_L(0); PG8_BAR; PG8_MMA(1, 0, At, B0); PG8_MMA(1, 1, At, B1); PG8_BAR; PG8_SCHED;
            PG8_LDB(B0, 1, 0); PG8_LDB(B1, 1, 1); PG8_SCHED; PG8_LDA(At, 1, 0); PG8_STAGE(PG8_SA(0, 1), a2 + hstep, voffA);
            PG8_WAIT_V(8); PG8_WAIT_L(0); PG8_BAR; PG8_MMA(0, 0, At, B0); PG8_MMA(0, 1, At, B1); PG8_BAR; PG8_SCHED;
            PG8_LDA(At, 1, 1); PG8_STAGE(PG8_SB(1, 0), b3, voffB); PG8_STAGE(PG8_SB(1, 1), b3 + hstep, voffB); PG8_STAGE(PG8_SA(1, 0), a3, voffA);
            PG8_WAIT_V(8); PG8_WAIT_L(0); PG8_BAR; PG8_MMA(1, 0, At, B0); PG8_MMA(1, 1, At, B1); PG8_BAR; PG8_SCHED;
        }
        if (wr == 0) PG8_BAR;
        { Unit eu = cur; int ewr = wr, ewc = wc, efr = fr, efq = fq;
          asm volatile("" : "+s"(eu.pm), "+s"(eu.pn), "+s"(eu.part), "+s"(ewr), "+s"(ewc), "+v"(efr), "+v"(efq));
          E(acc, eu, ewr, ewc, efr, efq); }
        if (!has_next) break;
        if (!E.keep(cur)) {
#pragma unroll
        for (int a = 0; a < 2; ++a)
#pragma unroll
            for (int b = 0; b < 2; ++b)
#pragma unroll
                for (int m = 0; m < 4; ++m)
#pragma unroll
                    for (int n = 0; n < 2; ++n) acc[a][b][m][n] = (f32x4){0.f, 0.f, 0.f, 0.f};
        }
        cur = nxt; cA = nA; cB = nB; ++ui;
        if (wr == 1) PG8_BAR;
    }
    PG8_WAIT_V(0);
    PG8_BAR;
#undef PG8_SA
#undef PG8_SB
#undef PG8_STAGE
#undef PG8_LDA
#undef PG8_LDB
#undef PG8_MMA
#undef PG8_WAIT_V
#undef PG8_WAIT_L
#undef PG8_BAR
#undef PG8_SCHED
}
}
using pg8::cvt_pk_bf16;

__device__ __forceinline__ unsigned xb_ld(unsigned* p)              { return __hip_atomic_load(p, __ATOMIC_RELAXED, __HIP_MEMORY_SCOPE_AGENT); }
__device__ __forceinline__ unsigned xb_add(unsigned* p, unsigned v) { return __hip_atomic_fetch_add(p, v, __ATOMIC_RELAXED, __HIP_MEMORY_SCOPE_AGENT); }
__device__ __forceinline__ float bf_lo(unsigned u) { return __uint_as_float(u << 16); }
__device__ __forceinline__ float bf_hi(unsigned u) { return __uint_as_float(u & 0xffff0000u); }
__device__ __forceinline__ float sigm_f(float x) { return __builtin_amdgcn_rcpf(1.f + __builtin_amdgcn_exp2f(-LOG2E * x)); }
__device__ __forceinline__ float silu_f(float x) { return x * sigm_f(x); }
__device__ __forceinline__ f32x4 sigm4(const f32x4 v) { f32x4 r; r.x = sigm_f(v.x); r.y = sigm_f(v.y); r.z = sigm_f(v.z); r.w = sigm_f(v.w); return r; }
__device__ __forceinline__ f32x4 onepexp4(const f32x4 v) { f32x4 r; r.x = 1.f + __builtin_amdgcn_exp2f(-LOG2E * v.x); r.y = 1.f + __builtin_amdgcn_exp2f(-LOG2E * v.y); r.z = 1.f + __builtin_amdgcn_exp2f(-LOG2E * v.z); r.w = 1.f + __builtin_amdgcn_exp2f(-LOG2E * v.w); return r; }
__device__ __forceinline__ f32x4 rcp4(const f32x4 v) { f32x4 r; r.x = __builtin_amdgcn_rcpf(v.x); r.y = __builtin_amdgcn_rcpf(v.y); r.z = __builtin_amdgcn_rcpf(v.z); r.w = __builtin_amdgcn_rcpf(v.w); return r; }
__device__ __forceinline__ void gate4(const f32x4 ga, const f32x4 gb, f32x4& r, f32x4& sb) { const f32x4 ea = onepexp4(ga), eb = onepexp4(gb); sb = rcp4(eb); r = rcp4(ea) * eb; }
__device__ __forceinline__ int rowpos(int row) { return row < R_SAMPLE ? (row > R_META ? row - R_META : 0) : (row < R_END ? 16384 + ((row - R_SAMPLE) & 7) : 0); }
__device__ __forceinline__ u32x4 pack8(const f32x4 a, const f32x4 b) { u32x4 w; w.x = cvt_pk_bf16(a[0], a[1]); w.y = cvt_pk_bf16(a[2], a[3]); w.z = cvt_pk_bf16(b[0], b[1]); w.w = cvt_pk_bf16(b[2], b[3]); return w; }

struct Epi1 {
    bf16_t *Q, *Kb, *Vt, *SZA, *BZ, *U, *SGA, *SGB; const float *rope, *qnw, *knw; float* out;
    __device__ __forceinline__ bool keep(const pg8::Unit&) const { return false; }
    __device__ __forceinline__ void operator()(f32x4 (&acc)[2][2][4][2], const pg8::Unit& u, int wr, int wc, int fr, int fq) const {
        const int pn = u.pn, row0 = u.pm * 256 + wr * 64 + fr;
        if (pn < 5) {
            const bool isq = pn < 4; const float* nw = isq ? qnw : knw;
            f32x4 w[2][2];
#pragma unroll
            for (int bj = 0; bj < 2; ++bj)
#pragma unroll
                for (int n = 0; n < 2; ++n) w[bj][n] = *(const f32x4*)(nw + 32 * bj + 8 * fq + 4 * n);
            const float sc = isq ? C2 : 1.f;
#pragma unroll
            for (int ai = 0; ai < 2; ++ai)
#pragma unroll
                for (int m = 0; m < 4; ++m) {
                    const int row = row0 + ai * 128 + m * 16;
                    float ss = 0.f;
#pragma unroll
                    for (int bj = 0; bj < 2; ++bj)
#pragma unroll
                        for (int n = 0; n < 2; ++n) { const f32x4 x = acc[ai][bj][m][n]; ss += (x[0] * x[0] + x[1] * x[1]) + (x[2] * x[2] + x[3] * x[3]); }
                    ss += __shfl_xor(ss, 16); ss += __shfl_xor(ss, 32);
                    const float rinv = 1.0f / sqrtf(ss * (1.f / 64.f) + EPS);
                    const float* rp = rope + (size_t)rowpos(row) * 64 + 8 * fq;
                    f32x4 o1[2], o2[2];
#pragma unroll
                    for (int n = 0; n < 2; ++n) {
                        const f32x4 cs = *(const f32x4*)(rp + 4 * n), sn = *(const f32x4*)(rp + 32 + 4 * n);
                        const f32x4 x1 = acc[ai][0][m][n] * rinv * w[0][n], x2 = acc[ai][1][m][n] * rinv * w[1][n];
                        o1[n] = (x1 * cs - x2 * sn) * sc; o2[n] = (x2 * cs + x1 * sn) * sc;
                    }
                    if (isq) {
                        bf16_t* p = Q + (size_t)row * DM + 64 * (4 * pn + wc) + 8 * fq;
                        *(u32x4*)p = pack8(o1[0], o1[1]); *(u32x4*)(p + 32) = pack8(o2[0], o2[1]);
                    } else {
                        bf16_t* p = Kb + (size_t)row * 256 + 64 * wc + 8 * fq;
                        *(u32x4*)p = pack8(o1[0], o1[1]); *(u32x4*)(p + 32) = pack8(o2[0], o2[1]);
                        if (u.pm >= 64) {
                            float* d = nullptr;
                            if (row >= 16384 && row < R_SAMPLE) d = out + O_NKP + (size_t)(row - 16384) * 256;
                            else if (row >= R_SAMPLE && row < R_END) { const int sr = row - R_SAMPLE; d = out + O_NKS + ((size_t)(sr >> 3) * 128 + 120 + (sr & 7)) * 256; }
                            if (d) { d += 64 * wc + 8 * fq; *(f32x4*)d = o1[0]; *(f32x4*)(d + 4) = o1[1]; *(f32x4*)(d + 32) = o2[0]; *(f32x4*)(d + 36) = o2[1]; }
                        }
                    }
                }
        } else if (pn == 5) {
#pragma unroll
            for (int ai = 0; ai < 2; ++ai)
#pragma unroll
                for (int m = 0; m < 4; ++m) {
                    const int row = row0 + ai * 128 + m * 16;
                    float* d = nullptr;
                    if (u.pm >= 64) {
                        if (row >= 16384 && row < R_SAMPLE) d = out + O_NVP + (size_t)(row - 16384) * 256;
                        else if (row >= R_SAMPLE && row < R_END) { const int sr = row - R_SAMPLE; d = out + O_NVS + ((size_t)(sr >> 3) * 128 + 120 + (sr & 7)) * 256; }
                    }
#pragma unroll
                    for (int bj = 0; bj < 2; ++bj)
#pragma unroll
                        for (int n = 0; n < 2; ++n) {
                            const int c = 128 * bj + 32 * wc + 8 * fq + 4 * n; const f32x4 x = acc[ai][bj][m][n];
                            const unsigned p0 = cvt_pk_bf16(x[0], x[1]), p1 = cvt_pk_bf16(x[2], x[3]);
                            bf16_t* vp = Vt + (size_t)c * MROWS + row;
                            vp[0] = (bf16_t)(p0 & 0xffffu); vp[MROWS] = (bf16_t)(p0 >> 16); vp[2 * (size_t)MROWS] = (bf16_t)(p1 & 0xffffu); vp[3 * (size_t)MROWS] = (bf16_t)(p1 >> 16);
                            if (d) *(f32x4*)(d + c) = x;
                        }
                }
        } else if (pn >= 10 && pn < 26) {
            const int ch = 64 * (pn - 10) + 16 * wc + 4 * fq;
#pragma unroll
            for (int ai = 0; ai < 2; ++ai)
#pragma unroll
                for (int m = 0; m < 4; ++m) {
                    const int row = row0 + ai * 128 + m * 16;
                    const f32x4 b = acc[ai][0][m][0], c = acc[ai][0][m][1], hc = acc[ai][1][m][0], zb = acc[ai][1][m][1];
                    const f32x4 uu = c * hc, bz = b * zb * sigm4(zb);
                    u32x2 wu, wb; wu.x = cvt_pk_bf16(uu[0], uu[1]); wu.y = cvt_pk_bf16(uu[2], uu[3]); wb.x = cvt_pk_bf16(bz[0], bz[1]); wb.y = cvt_pk_bf16(bz[2], bz[3]);
                    *(u32x2*)(U + (size_t)row * DM + ch) = wu; *(u32x2*)(BZ + (size_t)row * DM + ch) = wb;
                    if (u.pm >= 64) {
                        if (row == 16510 || row == 16511) *(f32x4*)(out + O_NCP + (size_t)(row - 16510) * DM + ch) = uu;
                        else if (row >= R_SAMPLE && row < R_END && ((row - R_SAMPLE) & 7) >= 6) { const int sr = row - R_SAMPLE; *(f32x4*)(out + O_NCS + ((size_t)(sr >> 3) * 2 + ((sr & 7) - 6)) * DM + ch) = uu; }
                    }
                }
        } else if (pn < 10) {
            const int col0 = (pn - 6) * 256 + 32 * wc + 8 * fq;
#pragma unroll
            for (int ai = 0; ai < 2; ++ai)
#pragma unroll
                for (int m = 0; m < 4; ++m) {
                    bf16_t* rowp = SZA + (size_t)(row0 + ai * 128 + m * 16) * DM + col0;
#pragma unroll
                    for (int bj = 0; bj < 2; ++bj) {
                        const f32x4 v0 = acc[ai][bj][m][0], v1 = acc[ai][bj][m][1];
                        *(u32x4*)(rowp + bj * 128) = pack8(sigm4(v0) * v0, sigm4(v1) * v1);
                    }
                }
        } else {
            const int col0 = (pn - 26) * 128 + 32 * wc + 8 * fq;
#pragma unroll
            for (int ai = 0; ai < 2; ++ai)
#pragma unroll
                for (int m = 0; m < 4; ++m) {
                    const size_t off = (size_t)(row0 + ai * 128 + m * 16) * DM + col0;
#pragma unroll
                    for (int n = 0; n < 2; ++n) {
                        f32x4 r0, s0; gate4(acc[ai][0][m][n], acc[ai][1][m][n], r0, s0);
                        u32x2 wr_, ws_; wr_.x = cvt_pk_bf16(r0.x, r0.y); wr_.y = cvt_pk_bf16(r0.z, r0.w); ws_.x = cvt_pk_bf16(s0.x, s0.y); ws_.y = cvt_pk_bf16(s0.z, s0.w);
                        *(u32x2*)(SGA + off + 4 * n) = wr_; *(u32x2*)(SGB + off + 4 * n) = ws_;
                        __builtin_amdgcn_sched_barrier(0);
                    }
                }
        }
    }
};

struct Epi2 {
    const bf16_t *SGA, *SGB; bf16_t* MIX;
    __device__ __forceinline__ bool keep(const pg8::Unit& u) const { return u.part == 0; }
    __device__ __forceinline__ void operator()(f32x4 (&acc)[2][2][4][2], const pg8::Unit& u, int wr, int wc, int fr, int fq) const {
        const int row0 = u.pm * 256 + wr * 64 + fr, col0 = u.pn * 256 + 32 * wc + 8 * fq;
        const bf16_t* p0 = SGA; const bf16_t* p1 = SGB; asm volatile("" : "+s"(p0), "+s"(p1));
        const bf16_t* G = u.part == 0 ? p0 : p1;
        u32x4 gv[2][4][2];
#pragma unroll
        for (int ai = 0; ai < 2; ++ai)
#pragma unroll
            for (int m = 0; m < 4; ++m)
#pragma unroll
                for (int bj = 0; bj < 2; ++bj) gv[ai][m][bj] = *(const u32x4*)(G + (size_t)(row0 + ai * 128 + m * 16) * DM + col0 + bj * 128);
#pragma unroll
        for (int ai = 0; ai < 2; ++ai)
#pragma unroll
            for (int m = 0; m < 4; ++m) {
                const size_t off = (size_t)(row0 + ai * 128 + m * 16) * DM + col0;
#pragma unroll
                for (int bj = 0; bj < 2; ++bj) {
                    const u32x4 gb = gv[ai][m][bj];
                    const f32x4 b0 = {bf_lo(gb.x), bf_hi(gb.x), bf_lo(gb.y), bf_hi(gb.y)}, b1 = {bf_lo(gb.z), bf_hi(gb.z), bf_lo(gb.w), bf_hi(gb.w)};
                    if (u.part == 0) { acc[ai][bj][m][0] = acc[ai][bj][m][0] * b0; acc[ai][bj][m][1] = acc[ai][bj][m][1] * b1; }
                    else *(u32x4*)(MIX + off + bj * 128) = pack8(acc[ai][bj][m][0] * b0, acc[ai][bj][m][1] * b1);
                }
            }
    }
};

template <bool GATE> struct EpiPart {
    const bf16_t* SGA; float* scr; const bf16_t* SGB;
    __device__ __forceinline__ bool keep(const pg8::Unit&) const { return false; }
    __device__ __forceinline__ void operator()(f32x4 (&acc)[2][2][4][2], const pg8::Unit& u, int wr, int wc, int fr, int fq) const {
        const int row0 = u.pm * 256 + wr * 64 + fr, col0 = u.pn * 256 + 32 * wc + 8 * fq, lr0 = wr * 64 + fr, lc0 = 32 * wc + 8 * fq;
#pragma unroll
        for (int ai = 0; ai < 2; ++ai)
#pragma unroll
            for (int m = 0; m < 4; ++m) {
                const size_t off = (size_t)(row0 + ai * 128 + m * 16) * DM + col0;
                bf16_t* sp = (bf16_t*)scr + (size_t)(lr0 + ai * 128 + m * 16) * 256 + lc0;
#pragma unroll
                for (int bj = 0; bj < 2; ++bj) {
                    f32x4 a0 = {1.f, 1.f, 1.f, 1.f}, a1 = a0;
                    if (GATE) { const u32x4 ga = *(const u32x4*)(SGA + off + bj * 128), gb = *(const u32x4*)(SGB + off + bj * 128);
                        a0 = (f32x4){bf_lo(ga.x) * bf_lo(gb.x), bf_hi(ga.x) * bf_hi(gb.x), bf_lo(ga.y) * bf_lo(gb.y), bf_hi(ga.y) * bf_hi(gb.y)};
                        a1 = (f32x4){bf_lo(ga.z) * bf_lo(gb.z), bf_hi(ga.z) * bf_hi(gb.z), bf_lo(ga.w) * bf_lo(gb.w), bf_hi(ga.w) * bf_hi(gb.w)}; }
                    *(u32x4*)(sp + bj * 128) = pack8(acc[ai][bj][m][0] * a0, acc[ai][bj][m][1] * a1);
                }
            }
    }
};
__device__ __forceinline__ void wait_count(unsigned* cnt, unsigned want) {
    unsigned sp = 0; while (xb_ld(cnt) < want) { __builtin_amdgcn_s_sleep(1); if (++sp > (1u << 22)) break; }
    __builtin_amdgcn_fence(__ATOMIC_ACQUIRE, "agent");
    asm volatile("s_waitcnt vmcnt(0)" ::: "memory");
}
struct Epi2b {
    const bf16_t* SGB; const float* scr; bf16_t* MIX; unsigned* cnt;
    __device__ __forceinline__ bool keep(const pg8::Unit&) const { return false; }
    __device__ __forceinline__ void operator()(f32x4 (&acc)[2][2][4][2], const pg8::Unit& u, int wr, int wc, int fr, int fq) const {
        const int row0 = u.pm * 256 + wr * 64 + fr, col0 = u.pn * 256 + 32 * wc + 8 * fq, lr0 = wr * 64 + fr, lc0 = 32 * wc + 8 * fq;
        u32x4 gbv[4][2];
#pragma unroll
        for (int m = 0; m < 4; ++m)
#pragma unroll
            for (int bj = 0; bj < 2; ++bj) gbv[m][bj] = *(const u32x4*)(SGB + (size_t)(row0 + m * 16) * DM + col0 + bj * 128);
        wait_count(cnt, 1u);
#pragma unroll
        for (int ai = 0; ai < 2; ++ai) {
            u32x4 ppv[4][2];
#pragma unroll
            for (int m = 0; m < 4; ++m) { const bf16_t* sp = (const bf16_t*)scr + (size_t)(lr0 + ai * 128 + m * 16) * 256 + lc0;
#pragma unroll
                for (int bj = 0; bj < 2; ++bj) { ppv[m][bj] = *(const u32x4*)(sp + bj * 128); if (ai == 1) gbv[m][bj] = *(const u32x4*)(SGB + (size_t)(row0 + 128 + m * 16) * DM + col0 + bj * 128); } }
#pragma unroll
            for (int m = 0; m < 4; ++m) { const size_t off = (size_t)(row0 + ai * 128 + m * 16) * DM + col0;
#pragma unroll
                for (int bj = 0; bj < 2; ++bj) {
                    const u32x4 gb = gbv[m][bj], pp = ppv[m][bj];
                    const f32x4 b0 = {bf_lo(gb.x), bf_hi(gb.x), bf_lo(gb.y), bf_hi(gb.y)}, b1 = {bf_lo(gb.z), bf_hi(gb.z), bf_lo(gb.w), bf_hi(gb.w)};
                    const f32x4 p0 = {bf_lo(pp.x), bf_hi(pp.x), bf_lo(pp.y), bf_hi(pp.y)}, p1 = {bf_lo(pp.z), bf_hi(pp.z), bf_lo(pp.w), bf_hi(pp.w)};
                    *(u32x4*)(MIX + off + bj * 128) = pack8(p0 + acc[ai][bj][m][0] * b0, p1 + acc[ai][bj][m][1] * b1);
                } }
            asm volatile("" ::: "memory");
        }
    }
};
struct Epi3b {
    const float *xp, *xs; float* y; const float* scr; unsigned* cnt;
    __device__ __forceinline__ bool keep(const pg8::Unit&) const { return false; }
    __device__ __forceinline__ void operator()(f32x4 (&acc)[2][2][4][2], const pg8::Unit& u, int wr, int wc, int fr, int fq) const {
        const int row0 = u.pm * 256 + wr * 64 + fr, col0 = u.pn * 256 + 32 * wc + 8 * fq, lr0 = wr * 64 + fr, lc0 = 32 * wc + 8 * fq;
        wait_count(cnt, 1u);
#pragma unroll
        for (int ai = 0; ai < 2; ++ai)
#pragma unroll
            for (int m = 0; m < 4; ++m) {
                const int gr = row0 + ai * 128 + m * 16;
                const float* xr = (gr < 16384 ? xp + (size_t)gr * DM : xs + (size_t)(gr - 16384) * DM) + col0;
                float* yr = y + (size_t)gr * DM + col0;
                const bf16_t* sp = (const bf16_t*)scr + (size_t)(lr0 + ai * 128 + m * 16) * 256 + lc0;
#pragma unroll
                for (int bj = 0; bj < 2; ++bj) {
                    const u32x4 pp = *(const u32x4*)(sp + bj * 128); const f32x4 p0 = {bf_lo(pp.x), bf_hi(pp.x), bf_lo(pp.y), bf_hi(pp.y)}, p1 = {bf_lo(pp.z), bf_hi(pp.z), bf_lo(pp.w), bf_hi(pp.w)};
                    *(f32x4*)(yr + bj * 128) = *(const f32x4*)(xr + bj * 128) + p0 + acc[ai][bj][m][0]; *(f32x4*)(yr + bj * 128 + 4) = *(const f32x4*)(xr + bj * 128 + 4) + p1 + acc[ai][bj][m][1];
                }
            }
    }
};
__device__ __forceinline__ void publish_count(unsigned* cnt) {
    asm volatile("s_waitcnt vmcnt(0)" ::: "memory");
    __syncthreads();
    if (threadIdx.x == 0) { __builtin_amdgcn_fence(__ATOMIC_RELEASE, "agent"); asm volatile("s_waitcnt vmcnt(0)" ::: "memory"); xb_add(cnt, 1u); }
}

struct Epi3 {
    const float *xp, *xs; float* y;
    __device__ __forceinline__ bool keep(const pg8::Unit&) const { return false; }
    __device__ __forceinline__ void operator()(f32x4 (&acc)[2][2][4][2], const pg8::Unit& u, int wr, int wc, int fr, int fq) const {
        const int row0 = u.pm * 256 + wr * 64 + fr, col0 = u.pn * 256 + 32 * wc + 8 * fq;
#pragma unroll
        for (int ai = 0; ai < 2; ++ai) {
            f32x4 xv[4][2][2];
#pragma unroll
            for (int m = 0; m < 4; ++m) {
                const int gr = row0 + ai * 128 + m * 16;
                const float* xr = (gr < 16384 ? xp + (size_t)gr * DM : xs + (size_t)(gr - 16384) * DM) + col0;
#pragma unroll
                for (int bj = 0; bj < 2; ++bj)
#pragma unroll
                    for (int n = 0; n < 2; ++n) xv[m][bj][n] = *(const f32x4*)(xr + bj * 128 + 4 * n);
            }
#pragma unroll
            for (int m = 0; m < 4; ++m) {
                float* yr = y + (size_t)(row0 + ai * 128 + m * 16) * DM + col0;
#pragma unroll
                for (int bj = 0; bj < 2; ++bj)
#pragma unroll
                    for (int n = 0; n < 2; ++n) *(f32x4*)(yr + bj * 128 + 4 * n) = xv[m][bj][n] + acc[ai][bj][m][n];
            }
            asm volatile("" ::: "memory");
        }
    }
};

__device__ __forceinline__ float wave_sum(float v) {
#pragma unroll
    for (int o = 1; o < 64; o <<= 1) v += __shfl_xor(v, o);
    return v;
}
__device__ __forceinline__ int win_orig_col(int n) {
    const int pn = n >> 8, c = n & 255;
    if (pn < 5) { const int bj = c >> 7, wc = (c >> 5) & 3, j = c & 31; return 64 * (4 * pn + wc) + 32 * bj + j; }
    if (pn >= 10 && pn < 26) { const int t = pn - 10, bj = c >> 7, wc = (c >> 5) & 3, fq = (c >> 3) & 3, nn = (c >> 2) & 1, e = c & 3; return 2560 + 1024 * (2 * bj + nn) + 64 * t + 16 * wc + 4 * fq + e; }
    if (pn >= 26) { const int t = pn - 26, bj = c >> 7, rest = c & 127; return 6656 + 1024 * bj + 128 * t + rest; }
    return n;
}
template <bool PERMUTE>
__device__ __forceinline__ void p0_transpose_item(const float* W, int K, int N, bf16_t* WT, LAS float* scr, int item, int lane) {
    const int nblk = N / 32, kb = item / nblk, nb = item % nblk, k0 = 64 * kb, n0 = 32 * nb;
    const int ncol = PERMUTE ? win_orig_col(n0 + (lane & 31)) : n0 + (lane & 31);
    float tv[32];
#pragma unroll
    for (int i = 0; i < 32; ++i) tv[i] = __builtin_nontemporal_load(W + (size_t)(k0 + 2 * i + (lane >> 5)) * N + ncol);
#pragma unroll
    for (int i = 0; i < 32; ++i) scr[(2 * i + (lane >> 5)) * 33 + (lane & 31)] = tv[i];
    asm volatile("s_waitcnt lgkmcnt(0)" ::: "memory");
    const int c = lane & 7;
#pragma unroll
    for (int j = 0; j < 4; ++j) { const int n = (lane >> 3) + 8 * j; const LAS float* s = scr + (8 * c) * 33 + n;
        u32x4 o; o.x = cvt_pk_bf16(s[0 * 33], s[1 * 33]); o.y = cvt_pk_bf16(s[2 * 33], s[3 * 33]); o.z = cvt_pk_bf16(s[4 * 33], s[5 * 33]); o.w = cvt_pk_bf16(s[6 * 33], s[7 * 33]);
        *(u32x4*)(WT + (size_t)(n0 + n) * K + k0 + 8 * c) = o; }
    asm volatile("s_waitcnt lgkmcnt(0)" ::: "memory");
}

struct Args { const float* in[15]; float* out; unsigned char* ws; int ph_lo, ph_hi; };

__device__ __forceinline__ void p0_prologue(const Args& a, LAS unsigned char* lds, int tid, int lane, int wave, int G) {
    LAS float* scr = (LAS float*)(lds + wave * 16384);
    const int gw = blockIdx.x * 8 + wave, NGW = G * 8;
    bf16_t* WIN = (bf16_t*)(a.ws + WS_WIN); bf16_t* WA = (bf16_t*)(a.ws + WS_WA); bf16_t* WB = (bf16_t*)(a.ws + WS_WB); bf16_t* WO = (bf16_t*)(a.ws + WS_WO);
    constexpr int I_IN = 16 * (NIN / 32), I_SQ = 16 * 32, NITEMS = I_IN + 3 * I_SQ;
    for (int it = gw; it < NITEMS; it += NGW) {
        int r = it;
        if (r < I_IN) { p0_transpose_item<true>(a.in[7], DM, NIN, WIN, scr, r, lane); continue; } r -= I_IN;
        if (r < I_SQ) { p0_transpose_item<false>(a.in[12], DM, DM, WA, scr, r, lane); continue; } r -= I_SQ;
        if (r < I_SQ) { p0_transpose_item<false>(a.in[13], DM, DM, WB, scr, r, lane); continue; } r -= I_SQ;
        p0_transpose_item<false>(a.in[14], DM, DM, WO, scr, r, lane);
    }
    bf16_t* XN = (bf16_t*)(a.ws + WS_B0);
    const f32x4* nwp = (const f32x4*)a.in[6] + lane;
    f32x4 nw[4];
#pragma unroll
    for (int j = 0; j < 4; ++j) nw[j] = nwp[64 * j];
    for (int m0 = gw; m0 < MROWS; m0 += 4 * NGW) {
        const float* src[4]; f32x4 v[4][4];
#pragma unroll
        for (int q = 0; q < 4; ++q) {
            const int m = m0 + q * NGW; src[q] = nullptr;
            if (m >= R_PROMPT && m < R_SAMPLE) src[q] = a.in[0] + (size_t)(m - R_PROMPT) * DM;
            else if (m >= R_SAMPLE && m < R_END) src[q] = a.in[1] + (size_t)(m - R_SAMPLE) * DM;
            else if (m >= R_META && m < R_PROMPT) src[q] = a.in[5] + (size_t)(m - R_META) * DM;
#pragma unroll
            for (int j = 0; j < 4; ++j) v[q][j] = src[q] ? __builtin_nontemporal_load((const f32x4*)src[q] + lane + 64 * j) : (f32x4){0.f, 0.f, 0.f, 0.f};
        }
#pragma unroll
        for (int q = 0; q < 4; ++q) {
            const int m = m0 + q * NGW;
            if (m < MROWS) {
                float s2 = 0.f;
#pragma unroll
                for (int j = 0; j < 4; ++j) s2 += (v[q][j].x * v[q][j].x + v[q][j].y * v[q][j].y) + (v[q][j].z * v[q][j].z + v[q][j].w * v[q][j].w);
                const float r = 1.0f / sqrtf(wave_sum(s2) * (1.f / DM) + EPS);
                unsigned long long* o8 = (unsigned long long*)(XN + (size_t)m * DM) + lane;
#pragma unroll
                for (int j = 0; j < 4; ++j) { const f32x4 y = v[q][j] * r * nw[j]; o8[64 * j] = (unsigned long long)cvt_pk_bf16(y.x, y.y) | ((unsigned long long)cvt_pk_bf16(y.z, y.w) << 32); }
            }
        }
    }
    float* rope = (float*)(a.ws + WS_ROPE);
    for (int i = blockIdx.x * 512 + tid; i < NPOS * 32; i += G * 512) {
        const int pos = i >> 5, j = i & 31;
        double invd = 1.0; for (int q = 0; q < j; ++q) invd *= 0.74989420933245582730;
        const float inv = (float)invd; const float angf = (float)pos * inv; const double ang = (double)angf;
        const double kq = __builtin_rint(ang * 0.63661977236758134308); const int qi = (int)kq;
        double rr = __builtin_fma(-kq, 1.57079632679489655800, ang); rr = __builtin_fma(-kq, 6.12323399573676603587e-17, rr);
        const double r2 = rr * rr;
        double sn = r2 * (1.0 / 6227020800.0) - (1.0 / 39916800.0); sn = sn * r2 + (1.0 / 362880.0); sn = sn * r2 - (1.0 / 5040.0); sn = sn * r2 + (1.0 / 120.0); sn = sn * r2 - (1.0 / 6.0); sn = sn * r2 * rr + rr;
        double cs = r2 * (1.0 / 479001600.0) - (1.0 / 3628800.0); cs = cs * r2 + (1.0 / 40320.0); cs = cs * r2 - (1.0 / 720.0); cs = cs * r2 + (1.0 / 24.0); cs = cs * r2 - 0.5; cs = cs * r2 + 1.0;
        double so, co;
        switch (qi & 3) { case 0: so = sn; co = cs; break; case 1: so = cs; co = -sn; break; case 2: so = -sn; co = -cs; break; default: so = -cs; co = sn; break; }
        rope[(size_t)pos * 64 + j] = (float)co; rope[(size_t)pos * 64 + 32 + j] = (float)so;
    }
}

__device__ __forceinline__ int crow(int r, int hi) { return (r & 3) + 8 * (r >> 2) + 4 * hi; }
__device__ __forceinline__ bf16x8 packp(const f32x16& p, int s) {
    u32x4 w; w.x = cvt_pk_bf16(p[8 * s + 0], p[8 * s + 1]); w.y = cvt_pk_bf16(p[8 * s + 2], p[8 * s + 3]); w.z = cvt_pk_bf16(p[8 * s + 4], p[8 * s + 5]); w.w = cvt_pk_bf16(p[8 * s + 6], p[8 * s + 7]);
    return __builtin_bit_cast(bf16x8, w);
}
__device__ __forceinline__ float sink_softmax5(f32x16 (&S)[5], int qcmp, int hi, float sink2, int minkr) {
    const float NEG = -INFINITY;
#pragma unroll
    for (int r = 0; r < 16; ++r) { const int c = crow(r, hi); if (c < qcmp) S[0][r] = NEG; if (c > qcmp) S[4][r] = NEG; }
    if (minkr > 0) {
#pragma unroll
        for (int kb = 0; kb < 5; ++kb)
#pragma unroll
            for (int r = 0; r < 16; ++r) if (32 * kb + crow(r, hi) < minkr) S[kb][r] = NEG;
    }
    float m = sink2;
#pragma unroll
    for (int kb = 0; kb < 5; ++kb)
#pragma unroll
        for (int r = 0; r < 16; ++r) m = fmaxf(m, S[kb][r]);
    m = fmaxf(m, __shfl_xor(m, 32));
    float l = 0.f;
#pragma unroll
    for (int kb = 0; kb < 5; ++kb)
#pragma unroll
        for (int r = 0; r < 16; ++r) { const float p = __builtin_amdgcn_exp2f(S[kb][r] - m); S[kb][r] = p; l += p; }
    l += __shfl_xor(l, 32);
    l += __builtin_amdgcn_exp2f(sink2 - m);
    return 1.0f / l;
}
__device__ __forceinline__ void attn_store(const f32x16 (&O)[2], float inv_l, int row, int head, int hi, const bf16_t* SZA, bf16_t* QA) {
#pragma unroll
    for (int blk = 0; blk < 2; ++blk)
#pragma unroll
        for (int rr = 0; rr < 4; ++rr) {
            const size_t off = (size_t)row * DM + 64 * head + 32 * blk + 8 * rr + 4 * hi;
            const u32x2 z = *(const u32x2*)(SZA + off);
            u32x2 w; w.x = cvt_pk_bf16(O[blk][4 * rr] * inv_l * bf_lo(z.x), O[blk][4 * rr + 1] * inv_l * bf_hi(z.x)); w.y = cvt_pk_bf16(O[blk][4 * rr + 2] * inv_l * bf_lo(z.y), O[blk][4 * rr + 3] * inv_l * bf_hi(z.y));
            *(u32x2*)(QA + off) = w;
        }
}

__device__ __forceinline__ void attn_prompt_all(LAS unsigned char* lds, int tid, int id0, int G, int idEnd, const bf16_t* Kb, const bf16_t* Vt, bf16_t* QA, const bf16_t* SZA, const float* sinks) {
    const int lane = tid & 63, wid = __builtin_amdgcn_readfirstlane(tid >> 6), ql = lane & 31, hi = lane >> 5;
    LAS unsigned char* Ks = lds; LAS unsigned char* Vs = lds + 27648;
    const int i0 = 32 * (wid & 1);
    u32x4 kst[3], vst[3];
#define ATT_FETCH(id_) do { const int n_ = 1 + ((id_) >> 3), g_ = ((id_) >> 1) & 3, kbase_ = 128 * (n_ - 1) + 64 * ((id_) & 1); \
        _Pragma("unroll") for (int i = 0; i < 3; ++i) { const int ch = tid + 512 * i; \
            { const int row = ch >> 3, c = ch & 7; kst[i] = *(const u32x4*)(Kb + (size_t)(kbase_ + row) * 256 + g_ * 64 + c * 8); } \
            { const int d = ch / 24, c = ch - d * 24; vst[i] = *(const u32x4*)(Vt + (size_t)(g_ * 64 + d) * MROWS + kbase_ + c * 8); } } \
        } while (0)
    int id = id0;
    if (id < idEnd) ATT_FETCH(id);
    for (; id < idEnd; id += G) {
        const int n = 1 + (id >> 3), g = (id >> 1) & 3, half = id & 1;
        const int kbase = 128 * (n - 1) + 64 * half;
#pragma unroll
        for (int i = 0; i < 3; ++i) {
            const int ch = tid + 512 * i;
            { const int row = ch >> 3, c = ch & 7; *(LAS u32x4*)(Ks + row * 144 + c * 16) = kst[i]; }
            { const int d = ch / 24, c = ch - d * 24; LAS u32x2* p = (LAS u32x2*)(Vs + d * 392 + c * 16); p[0] = (u32x2){vst[i].x, vst[i].y}; p[1] = (u32x2){vst[i].z, vst[i].w}; }
        }
        const int hq = 4 * g + (wid >> 1);
        const int qrow = kbase + 128 + i0 + ql;
        bf16x8 qr[4];
#pragma unroll
        for (int d0 = 0; d0 < 4; ++d0) qr[d0] = *(const bf16x8*)(QA + (size_t)qrow * DM + 64 * hq + 16 * d0 + 8 * hi);
        const float sink2 = sinks[hq] * LOG2E;
        __syncthreads();
        u32x2 zz[2][4];
#pragma unroll
        for (int blk = 0; blk < 2; ++blk)
#pragma unroll
            for (int rr = 0; rr < 4; ++rr) zz[blk][rr] = *(const u32x2*)(SZA + (size_t)qrow * DM + 64 * hq + 32 * blk + 8 * rr + 4 * hi);
        if (id + G < idEnd) ATT_FETCH(id + G);
        const int minkr = R_META - (kbase + i0);
        float mrun = sink2, lrun = hi ? 0.f : 1.f;
        f32x16 O[2]; O[0] = (f32x16){}; O[1] = (f32x16){};
#pragma unroll
        for (int kb = 0; kb < 5; ++kb) {
            f32x16 S = (f32x16){};
#pragma unroll
            for (int d0 = 0; d0 < 4; ++d0) { const bf16x8 a = *(const LAS bf16x8*)(Ks + (i0 + 32 * kb + ql) * 144 + (16 * d0 + 8 * hi) * 2); S = __builtin_amdgcn_mfma_f32_32x32x16_bf16(a, qr[d0], S, 0, 0, 0); }
            if (kb == 0) {
#pragma unroll
                for (int r = 0; r < 16; ++r) if (crow(r, hi) < ql) S[r] = -INFINITY;
            }
            if (kb == 4) {
#pragma unroll
                for (int r = 0; r < 16; ++r) if (crow(r, hi) > ql) S[r] = -INFINITY;
            }
            if (minkr > 32 * kb) {
#pragma unroll
                for (int r = 0; r < 16; ++r) if (32 * kb + crow(r, hi) < minkr) S[r] = -INFINITY;
            }
            float mb = S[0];
#pragma unroll
            for (int r = 1; r < 16; ++r) mb = fmaxf(mb, S[r]);
            mb = fmaxf(mb, __shfl_xor(mb, 32));
            const float mn = fmaxf(mrun, mb), alpha = __builtin_amdgcn_exp2f(mrun - mn); mrun = mn;
            float ps = 0.f;
#pragma unroll
            for (int r = 0; r < 16; ++r) { const float p = __builtin_amdgcn_exp2f(S[r] - mn); S[r] = p; ps += p; }
            lrun = lrun * alpha + ps;
            O[0] = O[0] * alpha; O[1] = O[1] * alpha;
#pragma unroll
            for (int s = 0; s < 2; ++s) {
                const bf16x8 pb = packp(S, s);
#pragma unroll
                for (int blk = 0; blk < 2; ++blk) {
                    const LAS unsigned char* vp = Vs + (32 * blk + ql) * 392 + (i0 + 32 * kb + 16 * s + 4 * hi) * 2;
                    const u32x2 lo = *(const LAS u32x2*)vp, hh = *(const LAS u32x2*)(vp + 16);
                    const u32x4 av = {lo.x, lo.y, hh.x, hh.y};
                    O[blk] = __builtin_amdgcn_mfma_f32_32x32x16_bf16(__builtin_bit_cast(bf16x8, av), pb, O[blk], 0, 0, 0);
                }
            }
        }
        lrun += __shfl_xor(lrun, 32);
        const float inv_l = 1.0f / lrun;
#pragma unroll
        for (int blk = 0; blk < 2; ++blk)
#pragma unroll
            for (int rr = 0; rr < 4; ++rr) {
                const size_t off = (size_t)qrow * DM + 64 * hq + 32 * blk + 8 * rr + 4 * hi; const u32x2 z = zz[blk][rr];
                u32x2 w; w.x = cvt_pk_bf16(O[blk][4 * rr] * inv_l * bf_lo(z.x), O[blk][4 * rr + 1] * inv_l * bf_hi(z.x)); w.y = cvt_pk_bf16(O[blk][4 * rr + 2] * inv_l * bf_lo(z.y), O[blk][4 * rr + 3] * inv_l * bf_hi(z.y));
                *(u32x2*)(QA + off) = w;
            }
        __syncthreads();
    }
#undef ATT_FETCH
}

__device__ __forceinline__ bf16x8 cvt8(const f32x4 a, const f32x4 b) { return __builtin_bit_cast(bf16x8, pack8(a, b)); }

__device__ __forceinline__ void attn_sample_unit(int b, int g, int hh, int lane, const float* ck, const float* cv, const bf16_t* Kb, const bf16_t* Vt, bf16_t* QA, const bf16_t* SZA, const float* sinks, float* out) {
    const int ql = lane & 31, hi = lane >> 5, t = ql & 7; const bool cp = (hh == 0);
    const int row = R_SAMPLE + 8 * b + t, head = 4 * g + hh;
    bf16x8 qr[4];
#pragma unroll
    for (int d0 = 0; d0 < 4; ++d0) qr[d0] = *(const bf16x8*)(QA + (size_t)row * DM + 64 * head + 16 * d0 + 8 * hi);
    const float sink2 = sinks[head] * LOG2E;
    const float* ckb = ck + (size_t)b * 128 * 256 + g * 64; const float* cvb = cv + (size_t)b * 128 * 256 + g * 64;
    float* oks = out + O_NKS + (size_t)b * 128 * 256 + g * 64; float* ovs = out + O_NVS + (size_t)b * 128 * 256 + g * 64;
    float m = sink2, l = hi ? 0.f : 1.f;
    f32x16 O[2]; O[0] = (f32x16){}; O[1] = (f32x16){};
    const float NEG = -INFINITY;
#pragma unroll 1
    for (int kb = 0; kb < 5; ++kb) {
        f32x16 S = (f32x16){};
        if (kb < 4) {
            const int s = 32 * kb + ql;
#pragma unroll
            for (int d0 = 0; d0 < 4; ++d0) {
                const float* p = ckb + (size_t)s * 256 + 16 * d0 + 8 * hi; const f32x4 x0 = *(const f32x4*)p, x1 = *(const f32x4*)(p + 4);
                if (cp && s >= 8) { float* o = oks + (size_t)(s - 8) * 256 + 16 * d0 + 8 * hi; *(f32x4*)o = x0; *(f32x4*)(o + 4) = x1; }
                S = __builtin_amdgcn_mfma_f32_32x32x16_bf16(cvt8(x0, x1), qr[d0], S, 0, 0, 0);
            }
        } else {
#pragma unroll
            for (int d0 = 0; d0 < 4; ++d0) {
                u32x4 kv = {0u, 0u, 0u, 0u};
                if (ql < 8) kv = *(const u32x4*)(Kb + (size_t)(R_SAMPLE + 8 * b + ql) * 256 + g * 64 + 16 * d0 + 8 * hi);
                S = __builtin_amdgcn_mfma_f32_32x32x16_bf16(__builtin_bit_cast(bf16x8, kv), qr[d0], S, 0, 0, 0);
            }
        }
        if (kb == 0) {
#pragma unroll
            for (int r = 0; r < 16; ++r) if (crow(r, hi) < t) S[r] = NEG;
        }
        if (kb == 4) {
#pragma unroll
            for (int r = 0; r < 16; ++r) if (crow(r, hi) > t) S[r] = NEG;
        }
        float mb = S[0];
#pragma unroll
        for (int r = 1; r < 16; ++r) mb = fmaxf(mb, S[r]);
        mb = fmaxf(mb, __shfl_xor(mb, 32));
        const float mn = fmaxf(m, mb), alpha = __builtin_amdgcn_exp2f(m - mn); m = mn;
        float ps = 0.f;
#pragma unroll
        for (int r = 0; r < 16; ++r) { const float p = __builtin_amdgcn_exp2f(S[r] - mn); S[r] = p; ps += p; }
        l = l * alpha + ps;
        O[0] = O[0] * alpha; O[1] = O[1] * alpha;
        if (kb < 4) {
#pragma unroll
            for (int s2 = 0; s2 < 2; ++s2) {
                const bf16x8 pb = packp(S, s2);
#pragma unroll
                for (int blk = 0; blk < 2; ++blk) {
                    const int d = 32 * blk + ql;
                    f32x4 v0, v1;
                    const int kk = 32 * kb + 16 * s2 + 4 * hi;
                    const float* vsrc = cvb + (size_t)kk * 256 + d; float* vdst = ovs + (size_t)kk * 256 + d - 8 * 256;
                    v0.x = vsrc[0]; v0.y = vsrc[256]; v0.z = vsrc[512]; v0.w = vsrc[768]; v1.x = vsrc[2048]; v1.y = vsrc[2304]; v1.z = vsrc[2560]; v1.w = vsrc[2816];
                    if (cp && kk >= 8) { vdst[0] = v0.x; vdst[256] = v0.y; vdst[512] = v0.z; vdst[768] = v0.w; }
                    if (cp) { vdst[2048] = v1.x; vdst[2304] = v1.y; vdst[2560] = v1.z; vdst[2816] = v1.w; }
                    O[blk] = __builtin_amdgcn_mfma_f32_32x32x16_bf16(cvt8(v0, v1), pb, O[blk], 0, 0, 0);
                }
            }
        } else {
            const bf16x8 pb = packp(S, 0);
#pragma unroll
            for (int blk = 0; blk < 2; ++blk) {
                const int d = 32 * blk + ql;
                const u32x2 lo = *(const u32x2*)(Vt + (size_t)(g * 64 + d) * MROWS + R_SAMPLE + 8 * b + 4 * hi);
                const u32x4 av = {lo.x, lo.y, 0u, 0u};
                O[blk] = __builtin_amdgcn_mfma_f32_32x32x16_bf16(__builtin_bit_cast(bf16x8, av), pb, O[blk], 0, 0, 0);
            }
        }
    }
    l += __shfl_xor(l, 32);
    if (ql < 8) attn_store(O, 1.0f / l, row, head, hi, SZA, QA);
}

__device__ __forceinline__ void attn_sample_wg(LAS unsigned char* lds, int tid, int id, const float* ck, const float* cv, const bf16_t* Kb, const bf16_t* Vt, bf16_t* QA, const bf16_t* SZA, const float* sinks, float* out) {
    const int lane = tid & 63, wid = __builtin_amdgcn_readfirstlane(tid >> 6), ql = lane & 31, hi = lane >> 5, t = ql & 7;
    const int b = id >> 1, gp = id & 1;
    constexpr int KSG = 160 * 144, VSG = 64 * 328;
    LAS unsigned char* Ks = lds; LAS unsigned char* Vs = lds + 2 * KSG;
    const float* ckb = ck + (size_t)b * 128 * 256 + gp * 128; const float* cvb = cv + (size_t)b * 128 * 256 + gp * 128;
    float* oks = out + O_NKS + (size_t)b * 128 * 256 + gp * 128; float* ovs = out + O_NVS + (size_t)b * 128 * 256 + gp * 128;
#pragma unroll
    for (int i = 0; i < 8; ++i) {
        const int idx = tid + 512 * i, srow = idx >> 5, c4 = idx & 31, gl = c4 >> 4, d = (c4 & 15) * 4;
        const f32x4 k4 = *(const f32x4*)(ckb + (size_t)srow * 256 + c4 * 4), v4 = *(const f32x4*)(cvb + (size_t)srow * 256 + c4 * 4);
        if (srow >= 8) { *(f32x4*)(oks + (size_t)(srow - 8) * 256 + c4 * 4) = k4; *(f32x4*)(ovs + (size_t)(srow - 8) * 256 + c4 * 4) = v4; }
        u32x2 kw; kw.x = cvt_pk_bf16(k4.x, k4.y); kw.y = cvt_pk_bf16(k4.z, k4.w);
        *(LAS u32x2*)(Ks + gl * KSG + srow * 144 + d * 2) = kw;
        const unsigned v01 = cvt_pk_bf16(v4.x, v4.y), v23 = cvt_pk_bf16(v4.z, v4.w);
        LAS bf16_t* vp = (LAS bf16_t*)(Vs + gl * VSG + d * 328 + srow * 2);
        vp[0] = (bf16_t)(v01 & 0xffffu); vp[164] = (bf16_t)(v01 >> 16); vp[328] = (bf16_t)(v23 & 0xffffu); vp[492] = (bf16_t)(v23 >> 16);
    }
    if (tid < 128) {
        const int j = tid >> 4, c8 = tid & 15, gl = c8 >> 3, d = (c8 & 7) * 8;
        *(LAS u32x4*)(Ks + gl * KSG + (128 + j) * 144 + d * 2) = *(const u32x4*)(Kb + (size_t)(R_SAMPLE + 8 * b + j) * 256 + (2 * gp + gl) * 64 + d);
    } else if (tid < 256) {
        const int gl = (tid - 128) >> 6, d = (tid - 128) & 63;
        const u32x4 v = *(const u32x4*)(Vt + (size_t)((2 * gp + gl) * 64 + d) * MROWS + R_SAMPLE + 8 * b);
        LAS u32x2* p = (LAS u32x2*)(Vs + gl * VSG + d * 328 + 256); p[0] = (u32x2){v.x, v.y}; p[1] = (u32x2){v.z, v.w};
    } else if (tid < 384) {
        const int gl = (tid - 256) >> 6, d = (tid - 256) & 63;
        LAS u32x2* p = (LAS u32x2*)(Vs + gl * VSG + d * 328 + 272);
#pragma unroll
        for (int q = 0; q < 6; ++q) p[q] = (u32x2){0u, 0u};
    }
    const int gl = wid >> 2, hh = wid & 3, head = 4 * (2 * gp + gl) + hh, row = R_SAMPLE + 8 * b + t;
    bf16x8 qr[4];
#pragma unroll
    for (int d0 = 0; d0 < 4; ++d0) qr[d0] = *(const bf16x8*)(QA + (size_t)row * DM + 64 * head + 16 * d0 + 8 * hi);
    const float sink2 = sinks[head] * LOG2E;
    __syncthreads();
    const LAS unsigned char* Kg = Ks + gl * KSG; const LAS unsigned char* Vg = Vs + gl * VSG;
    f32x16 S[5];
#pragma unroll
    for (int kb = 0; kb < 5; ++kb) {
        S[kb] = (f32x16){};
#pragma unroll
        for (int d0 = 0; d0 < 4; ++d0) { const bf16x8 a = *(const LAS bf16x8*)(Kg + (32 * kb + ql) * 144 + (16 * d0 + 8 * hi) * 2); S[kb] = __builtin_amdgcn_mfma_f32_32x32x16_bf16(a, qr[d0], S[kb], 0, 0, 0); }
    }
    const float inv_l = sink_softmax5(S, t, hi, sink2, 0);
    f32x16 O[2]; O[0] = (f32x16){}; O[1] = (f32x16){};
#pragma unroll
    for (int kb = 0; kb < 5; ++kb)
#pragma unroll
        for (int s2 = 0; s2 < 2; ++s2) {
            const bf16x8 pb = packp(S[kb], s2);
#pragma unroll
            for (int blk = 0; blk < 2; ++blk) {
                const LAS unsigned char* vp = Vg + (32 * blk + ql) * 328 + (32 * kb + 16 * s2 + 4 * hi) * 2;
                const u32x2 lo = *(const LAS u32x2*)vp, h2 = *(const LAS u32x2*)(vp + 16);
                const u32x4 av = {lo.x, lo.y, h2.x, h2.y};
                O[blk] = __builtin_amdgcn_mfma_f32_32x32x16_bf16(__builtin_bit_cast(bf16x8, av), pb, O[blk], 0, 0, 0);
            }
        }
    if (ql < 8) attn_store(O, inv_l, row, head, hi, SZA, QA);
    __syncthreads();
}

__device__ __forceinline__ void conv_pass(int gtid, int nthr, int item_lo, int item_hi, const bf16_t* U, bf16_t* BZ, const float* cw, const float* state) {
    const int ch = (gtid & 127) * 8;
    float w0[8], w1[8], w2[8];
#pragma unroll
    for (int e = 0; e < 8; ++e) { w0[e] = cw[ch + e]; w1[e] = cw[DM + ch + e]; w2[e] = cw[2 * DM + ch + e]; }
    for (int item = item_lo + (gtid >> 7); item < item_hi; item += nthr >> 7) {
        const int r0 = R_PROMPT + 8 * item;
        float um2[8], um1[8];
        if (r0 < R_SAMPLE) {
            const u32x4 a = *(const u32x4*)(U + (size_t)(r0 - 2) * DM + ch), b = *(const u32x4*)(U + (size_t)(r0 - 1) * DM + ch);
            um2[0] = bf_lo(a.x); um2[1] = bf_hi(a.x); um2[2] = bf_lo(a.y); um2[3] = bf_hi(a.y); um2[4] = bf_lo(a.z); um2[5] = bf_hi(a.z); um2[6] = bf_lo(a.w); um2[7] = bf_hi(a.w);
            um1[0] = bf_lo(b.x); um1[1] = bf_hi(b.x); um1[2] = bf_lo(b.y); um1[3] = bf_hi(b.y); um1[4] = bf_lo(b.z); um1[5] = bf_hi(b.z); um1[6] = bf_lo(b.w); um1[7] = bf_hi(b.w);
        } else {
            const float* st = state + (size_t)((r0 - R_SAMPLE) >> 3) * 2 * DM + ch;
#pragma unroll
            for (int e = 0; e < 8; ++e) { um2[e] = st[e]; um1[e] = st[DM + e]; }
        }
#pragma unroll
        for (int i = 0; i < 8; ++i) {
            const size_t off = (size_t)(r0 + i) * DM + ch;
            const u32x4 a = *(const u32x4*)(U + off), z = *(const u32x4*)(BZ + off);
            float uc[8], bz[8], o[8];
            uc[0] = bf_lo(a.x); uc[1] = bf_hi(a.x); uc[2] = bf_lo(a.y); uc[3] = bf_hi(a.y); uc[4] = bf_lo(a.z); uc[5] = bf_hi(a.z); uc[6] = bf_lo(a.w); uc[7] = bf_hi(a.w);
            bz[0] = bf_lo(z.x); bz[1] = bf_hi(z.x); bz[2] = bf_lo(z.y); bz[3] = bf_hi(z.y); bz[4] = bf_lo(z.z); bz[5] = bf_hi(z.z); bz[6] = bf_lo(z.w); bz[7] = bf_hi(z.w);
#pragma unroll
            for (int e = 0; e < 8; ++e) { o[e] = bz[e] * (w0[e] * um2[e] + w1[e] * um1[e] + w2[e] * uc[e]); um2[e] = um1[e]; um1[e] = uc[e]; }
            u32x4 w; w.x = cvt_pk_bf16(o[0], o[1]); w.y = cvt_pk_bf16(o[2], o[3]); w.z = cvt_pk_bf16(o[4], o[5]); w.w = cvt_pk_bf16(o[6], o[7]);
            *(u32x4*)(BZ + off) = w;
        }
    }
}


#define XB_TMO      128
#define XB_XCNT(j)  (256  + 64 * (j))
#define XB_XSUB(j)  (1280 + 64 * (j))
#define XB_XGEN(j)  (2304 + 64 * (j))
#define XB_TOP      3328
#define XB_TOPGEN   3392
#define XCD_BAR_WORDS 3456
#define XB_SPIN_CAP (1u << 18)
__device__ __forceinline__ unsigned xb_xcc_id() { return (unsigned)__builtin_amdgcn_s_getreg((3 << 11) | 20) & 0xFu; }
#define XB_SPIN(cond, bar) do { unsigned _sp = 0; while (cond) { __builtin_amdgcn_s_sleep(1); \
    if ((++_sp & 255u) == 0u) { if (xb_ld(&(bar)[XB_TMO])) break; if (_sp > XB_SPIN_CAP) { atomicAdd(&(bar)[XB_TMO], 1u); break; } } } } while (0)
struct XcdBarrier { unsigned* bar; unsigned x; volatile LAS unsigned* st; };
__device__ __forceinline__ XcdBarrier xcd_barrier_post(unsigned* bar, volatile LAS unsigned* st) {
    XcdBarrier b; b.bar = bar; b.x = xb_xcc_id(); b.st = st;
    if (threadIdx.x == 0) (void)xb_add(&bar[XB_XCNT(b.x)], 1u);
    return b;
}
__device__ __forceinline__ void xcd_barrier_complete(unsigned* bar, unsigned x, unsigned& nloc, unsigned& nx) {
    const unsigned G = gridDim.x * gridDim.y * gridDim.z;
    unsigned sum, cnt, mine, sp = 0u;
    for (;;) {
        sum = 0u; cnt = 0u; mine = 0u;
#pragma unroll
        for (unsigned j = 0; j < 16; ++j) { const unsigned c = xb_ld(&bar[XB_XCNT(j)]); sum += c; cnt += (c > 0u) ? 1u : 0u; mine = (j == x) ? c : mine; }
        if (sum == G) break;
        __builtin_amdgcn_s_sleep(1);
        if ((++sp & 255u) == 0u) { if (xb_ld(&bar[XB_TMO])) break; if (sp > XB_SPIN_CAP) { atomicAdd(&bar[XB_TMO], 1u); break; } }
    }
    nloc = mine > 0u ? mine : 1u; nx = cnt > 0u ? cnt : 1u;
}
__device__ __forceinline__ void xcd_barrier(const XcdBarrier& b) {
    asm volatile("s_waitcnt vmcnt(0)" ::: "memory");
    __syncthreads();
    if (threadIdx.x == 0) {
        unsigned* bar = b.bar;
        __builtin_amdgcn_s_waitcnt(0);
        unsigned nloc = b.st[0], nx = b.st[1];
        if (nloc == 0u) { xcd_barrier_complete(bar, b.x, nloc, nx); b.st[0] = nloc; b.st[1] = nx; }
        const unsigned old = xb_add(&bar[XB_XSUB(b.x)], 1u);
        const unsigned gen = old / nloc;
        if (old + 1u == (gen + 1u) * nloc) {
            __builtin_amdgcn_fence(__ATOMIC_RELEASE, "agent");
            asm volatile("s_waitcnt vmcnt(0)" ::: "memory");
            const unsigned og = xb_add(&bar[XB_TOP], 1u);
            const unsigned tg = og / nx;
            if (og + 1u == (tg + 1u) * nx) xb_add(&bar[XB_TOPGEN], 1u);
            else XB_SPIN(xb_ld(&bar[XB_TOPGEN]) == tg, bar);
            __builtin_amdgcn_fence(__ATOMIC_ACQUIRE, "agent");
            xb_add(&bar[XB_XGEN(b.x)], 1u);
            asm volatile("s_waitcnt vmcnt(0)" ::: "memory");
        } else {
            XB_SPIN(xb_ld(&bar[XB_XGEN(b.x)]) == gen, bar);
            __builtin_amdgcn_fence(__ATOMIC_ACQUIRE, "agent");
            asm volatile("s_waitcnt vmcnt(0)" ::: "memory");
        }
    }
    __syncthreads();
}

__device__ __forceinline__ void sub_barrier(unsigned* word, unsigned nwg) {
    asm volatile("s_waitcnt vmcnt(0)" ::: "memory");
    __syncthreads();
    if (threadIdx.x == 0) {
        __builtin_amdgcn_s_waitcnt(0);
        __builtin_amdgcn_fence(__ATOMIC_RELEASE, "agent");
        asm volatile("s_waitcnt vmcnt(0)" ::: "memory");
        xb_add(word, 1u);
        unsigned sp = 0; while (xb_ld(word) < nwg) { __builtin_amdgcn_s_sleep(1); if (++sp > (1u << 22)) break; }
        __builtin_amdgcn_fence(__ATOMIC_ACQUIRE, "agent");
        asm volatile("s_waitcnt vmcnt(0)" ::: "memory");
    }
    __syncthreads();
}

typedef const __attribute__((address_space(4))) Args* CArgs;
__device__ __forceinline__ CArgs fresh_args() { CArgs p = (CArgs)__builtin_amdgcn_kernarg_segment_ptr(); asm volatile("" : "+s"(p)); return p; }
#define PTRS() CArgs A = fresh_args(); unsigned char* ws = A->ws; \
    bf16_t* XN = (bf16_t*)(ws + WS_B0); bf16_t* QA = (bf16_t*)(ws + WS_QA); bf16_t* BZ = (bf16_t*)(ws + WS_BZ); bf16_t* SZA = (bf16_t*)(ws + WS_SZA); \
    bf16_t* Ub = (bf16_t*)(ws + WS_U); bf16_t* SGB = (bf16_t*)(ws + WS_SGB); bf16_t* Kb = (bf16_t*)(ws + WS_K); bf16_t* Vt = (bf16_t*)(ws + WS_VT); \
    bf16_t* SGA = (bf16_t*)A->out; float* rope = (float*)(ws + WS_ROPE); \
    (void)XN; (void)QA; (void)BZ; (void)SZA; (void)Ub; (void)SGB; (void)Kb; (void)Vt; (void)SGA; (void)rope
#define G2_DECL() const pg8::Gemm g2{QA + (size_t)R_PROMPT * DM, (const bf16_t*)(ws + WS_WA), M23, DM, DM, BUFB, 2097152}; const Epi2 E2{SGA + (size_t)R_PROMPT * DM, SGB + (size_t)R_PROMPT * DM, XN}
#define G3_DECL() const pg8::Gemm g3{XN, (const bf16_t*)(ws + WS_WO), M23, DM, DM, 0, 0}; const Epi3 E3{A->in[0], A->in[1], A->out + O_Y}
__global__ void __launch_bounds__(512, 2) hybrid_fwd(Args a_unused) {
    extern __shared__ __attribute__((aligned(16))) unsigned char lds_raw[];
    LAS unsigned char* lds = (LAS unsigned char*)lds_raw;
    const int G = gridDim.x;
#define TIDS() int tid = threadIdx.x; asm volatile("" : "+v"(tid)); const int lane = tid & 63, wave = __builtin_amdgcn_readfirstlane(tid >> 6); (void)lane; (void)wave
#define GSYNC() xcd_barrier(xbar)
    volatile LAS unsigned* MISC = (volatile LAS unsigned*)(lds + 131072);
    if (threadIdx.x < 4) MISC[threadIdx.x] = 0u;
    __syncthreads();
    XcdBarrier xbar;
    { CArgs A = fresh_args(); xbar = xcd_barrier_post((unsigned*)(A->ws + WS_CTL), MISC);
      if (A->ph_lo > 1000) cg::this_grid().sync(); }
    unsigned long long pt0 = 0, pt1 = 0; (void)pt0; (void)pt1;
#define PSTAMP0(k) do { if (PROBE_PH == (k)) pt0 = __builtin_amdgcn_s_memrealtime(); } while (0)
#define PSTAMP1(k) do { if (PROBE_PH == (k)) pt1 = __builtin_amdgcn_s_memrealtime(); } while (0)
    const bool split = (G == 256);
    constexpr int NSPL = 16;
    PSTAMP0(0);
    { TIDS(); CArgs A = fresh_args(); Args pa; pa.in[0] = A->in[0]; pa.in[1] = A->in[1]; pa.in[5] = A->in[5]; pa.in[6] = A->in[6]; pa.in[7] = A->in[7]; pa.in[12] = A->in[12]; pa.in[13] = A->in[13]; pa.in[14] = A->in[14]; pa.ws = A->ws; p0_prologue(pa, lds, tid, lane, wave, G); }
    GSYNC();
    PSTAMP1(0); PSTAMP0(1);
    {
        PTRS();
        pg8::Gemm g{XN, (const bf16_t*)(ws + WS_WIN), MROWS, NIN, DM, 0, 0}; pg8::StaticOrder S; S.init(MROWS, NIN, G, (int)blockIdx.x, 1); S.special = split ? 1 : 0;
        Epi1 E{QA, Kb, Vt, SZA, BZ, Ub, SGA, SGB, rope, A->in[8], A->in[9], A->out};
        pg8::gemm_phase<Epi1>(lds, g, S, E);
    }
    GSYNC();
    PSTAMP1(1); PSTAMP0(2);
    {
        TIDS(); PTRS();
        for (int id = blockIdx.x; id < 256; id += G) attn_sample_wg(lds, tid, id, A->in[2], A->in[3], Kb, Vt, QA, SZA, A->in[10], A->out);
        conv_pass(blockIdx.x * 512 + tid, G * 512, 2048, M23 / 8, Ub, BZ, A->in[11], A->in[4]);
    }
    GSYNC();
    PSTAMP1(2); PSTAMP0(3); if (PROBE_PH == 6) pt0 = __builtin_amdgcn_s_memrealtime();
    if (split && blockIdx.x < 2 * NSPL) {
        const int c = (int)blockIdx.x, tj = c & (NSPL - 1);
#define SPL_PTRS() PTRS(); float* scr1 = (float*)(ws + WS_B0) + (size_t)tj * 65536; float* scr2 = (float*)(ws + WS_B0) + (size_t)(NSPL + tj) * 65536; \
        unsigned* cnt1 = (unsigned*)(ws + WS_CTL) + 9216 + 64 * tj; unsigned* cnt2 = (unsigned*)(ws + WS_CTL) + 10240 + 64 * tj; unsigned* bar32 = (unsigned*)(ws + WS_CTL) + 8192; \
        (void)scr1; (void)scr2; (void)cnt1; (void)cnt2; (void)bar32
        if (c < NSPL) {
            { SPL_PTRS(); const pg8::Gemm ga{QA + (size_t)R_PROMPT * DM, (const bf16_t*)(ws + WS_WA), M23, DM, DM, 0, 0, 0};
              const EpiPart<true> Ea{SGA + (size_t)R_PROMPT * DM, scr1, SGB + (size_t)R_PROMPT * DM};
              pg8::StaticOrder S; S.init(M23, DM, G, c, 1, 256 + tj); pg8::gemm_phase<EpiPart<true>>(lds, ga, S, Ea); publish_count(cnt1); }
            { SPL_PTRS(); sub_barrier(bar32, 2 * NSPL); }
            { SPL_PTRS(); const pg8::Gemm g3a{XN, (const bf16_t*)(ws + WS_WO), M23, DM, 512, 0, 0, DM};
              const EpiPart<false> Ea{nullptr, scr2, nullptr};
              pg8::StaticOrder S; S.init(M23, DM, G, c, 1, 256 + tj); pg8::gemm_phase<EpiPart<false>>(lds, g3a, S, Ea); publish_count(cnt2); }
        } else {
            { SPL_PTRS(); const pg8::Gemm gb{BZ + (size_t)R_PROMPT * DM, (const bf16_t*)(ws + WS_WB), M23, DM, DM, 0, 0, 0};
              const Epi2b Eb{SGB + (size_t)R_PROMPT * DM, scr1, XN, cnt1};
              pg8::StaticOrder S; S.init(M23, DM, G, c, 1, 256 + tj); pg8::gemm_phase<Epi2b>(lds, gb, S, Eb); }
            { SPL_PTRS(); sub_barrier(bar32, 2 * NSPL); }
            { SPL_PTRS(); const pg8::Gemm g3b{XN + 512, (const bf16_t*)(ws + WS_WO) + 512, M23, DM, 512, 0, 0, DM};
              const Epi3b Eb{A->in[0], A->in[1], A->out + O_Y, scr2, cnt2};
              pg8::StaticOrder S; S.init(M23, DM, G, c, 1, 256 + tj); pg8::gemm_phase<Epi3b>(lds, g3b, S, Eb); }
        }
#undef SPL_PTRS
    } else {
        TIDS(); PTRS();
        const int vc = split ? (int)blockIdx.x - 2 * NSPL : (int)blockIdx.x, VG = split ? G - 2 * NSPL : G;
        if (split) {
            const int nd = vc < 150 ? 1 : 2, j0 = vc < 150 ? vc : 150 + 2 * (vc - 150);
            for (int k = 0; k < nd; ++k) {
                const int j = j0 + k, q = j - 2, dpm = j < 2 ? 26 : 27 + (q >> 3), dpn = j < 2 ? 32 + j : 26 + (q & 7);
                pg8::Gemm g{XN, (const bf16_t*)(ws + WS_WIN), MROWS, NIN, DM, 0, 0}; pg8::StaticOrder S; S.init(MROWS, NIN, G, (int)blockIdx.x, 1, dpm * 34 + dpn);
                Epi1 E{QA, Kb, Vt, SZA, BZ, Ub, SGA, SGB, rope, A->in[8], A->in[9], A->out};
                pg8::gemm_phase<Epi1>(lds, g, S, E);
            }
        }
        {
            const int a0 = !split ? vc : (vc < 150 ? 5 * vc : (vc < 172 ? 750 + 3 * (vc - 150) : 816 + 4 * (vc - 172))), na = vc < 150 ? 5 : (vc < 172 ? 3 : 4);
            attn_prompt_all(lds, tid, a0, split ? 1 : VG, split ? a0 + na : 1024, Kb, Vt, QA, SZA, A->in[10]);
        }
        { int tid2 = threadIdx.x; asm volatile("" : "+v"(tid2)); conv_pass(vc * 512 + tid2, VG * 512, 0, 2048, Ub, BZ, A->in[11], A->in[4]); }
    }
    if (PROBE_PH == 6) pt1 = __builtin_amdgcn_s_memrealtime();
    GSYNC();
    PSTAMP1(3); PSTAMP0(4);
    { PTRS(); G2_DECL(); pg8::StaticOrder S; S.init(split ? 16384 : M23, DM, G, (int)blockIdx.x, 2); pg8::gemm_phase<Epi2>(lds, g2, S, E2); }
    GSYNC();
#if REP_MASK & 8
    { PTRS(); G2_DECL(); pg8::StaticOrder S; S.init(split ? 16384 : M23, DM, G, (int)blockIdx.x, 2); pg8::gemm_phase<Epi2>(lds, g2, S, E2); }
    GSYNC();
#endif
    PSTAMP1(4); PSTAMP0(5);
    { PTRS(); G3_DECL(); pg8::StaticOrder S; S.init(split ? 16384 : M23, DM, G, (int)blockIdx.x, 1); pg8::gemm_phase<Epi3>(lds, g3, S, E3); }
#if REP_MASK & 16
    GSYNC();
    { PTRS(); G3_DECL(); pg8::StaticOrder S; S.init(split ? 16384 : M23, DM, G, (int)blockIdx.x, 1); pg8::gemm_phase<Epi3>(lds, g3, S, E3); }
#endif
    PSTAMP1(5);
    if (PROBE_PH >= 0 && blockIdx.x == PROBE_BLK) { const unsigned long long te = __builtin_amdgcn_s_memrealtime(); while (__builtin_amdgcn_s_memrealtime() - te < pt1 - pt0) __builtin_amdgcn_s_sleep(8); }
#undef GSYNC
}

#ifndef DBG_DUMP
#define DBG_DUMP 0
#endif
__global__ void dbg_dump(const bf16_t* src, float* dst, size_t n) {
    for (size_t i = (size_t)blockIdx.x * blockDim.x + threadIdx.x; i < n; i += (size_t)gridDim.x * blockDim.x) dst[i] = __uint_as_float((unsigned)src[i] << 16);
}
extern "C" void kernel_launch(void* const* d_in, const int* in_sizes, int n_in, void* d_out, int out_size, void* d_ws, size_t ws_size, hipStream_t stream) {
    static int grid = 0;
    if (grid == 0) {
        int dev = 0, cus = 0, per_cu = 0;
        if (n_in != 15 || ws_size < WS_END) { fprintf(stderr, "kernel_launch: unexpected inputs (n_in %d, ws %zu)\n", n_in, ws_size); grid = -1; return; }
        if (hipGetDevice(&dev) != hipSuccess || hipDeviceGetAttribute(&cus, hipDeviceAttributeMultiprocessorCount, dev) != hipSuccess) { grid = -1; return; }
        if (hipFuncSetAttribute((const void*)hybrid_fwd, hipFuncAttributeMaxDynamicSharedMemorySize, LDS_BYTES) != hipSuccess) { fprintf(stderr, "kernel_launch: hipFuncSetAttribute failed\n"); grid = -1; return; }
        if (hipOccupancyMaxActiveBlocksPerMultiprocessor(&per_cu, (const void*)hybrid_fwd, 512, LDS_BYTES) != hipSuccess || per_cu < 1) { fprintf(stderr, "kernel_launch: occupancy query gives %d\n", per_cu); per_cu = 1; }
        (void)hipGetLastError();
        grid = cus * 1;
    }
    if (grid < 0) return;
    Args a{};
    for (int i = 0; i < 15; ++i) a.in[i] = (const float*)d_in[i];
    a.out = (float*)d_out; a.ws = (unsigned char*)d_ws;
    if (hipMemsetAsync((char*)d_ws + WS_CTL, 0, CTL_BYTES, stream) != hipSuccess) { fprintf(stderr, "kernel_launch: memset of the barrier words failed\n"); return; }
    a.ph_lo = 0; a.ph_hi = 5;
    void* args[] = {&a};
    hipError_t e = hipLaunchCooperativeKernel((const void*)hybrid_fwd, dim3(grid), dim3(512), args, LDS_BYTES, stream);
    if (e != hipSuccess) fprintf(stderr, "cooperative launch failed: %s (grid %d)\n", hipGetErrorString(e), grid);
}
```

```cpp
#include <hip/hip_runtime.h>
#include <hip/hip_cooperative_groups.h>
#include <cstdio>
#include <cstdint>
namespace cg = cooperative_groups;

#ifndef CHAIN_LATE
#define CHAIN_LATE 0
#endif
#ifndef PROBE_BLK
#define PROBE_BLK 32
#endif
#ifndef PROBE_PH
#define PROBE_PH -1
#endif
#ifndef REP_MASK
#define REP_MASK 0
#endif
#ifndef DBG_NPH
#define DBG_NPH 5
#define DBG_DUMP 0
#endif
#ifndef MK_N_LAUNCHES
#define MK_N_LAUNCHES 1
#endif

#define LAS __attribute__((address_space(3)))
typedef unsigned short bf16_t;
typedef short bf16x8 __attribute__((ext_vector_type(8)));
typedef float f32x4 __attribute__((ext_vector_type(4)));
typedef float f32x16 __attribute__((ext_vector_type(16)));
typedef unsigned u32x4 __attribute__((ext_vector_type(4)));
typedef unsigned u32x2 __attribute__((ext_vector_type(2)));

constexpr int DM = 1024, NIN = 8704;
constexpr int R_META = 112, R_PROMPT = 128, R_SAMPLE = 16512, R_END = 17536, MROWS = 17664;
constexpr int M23 = 17408;
constexpr int NPOS = 16400;
constexpr float EPS = 1e-6f;
constexpr float LOG2E = 1.4426950408889634f;
constexpr float C2 = 0.125f * LOG2E;
constexpr size_t O_Y = 0, O_NKP = 17825792, O_NVP = 17858560, O_NCP = 17891328, O_NKS = 17893376, O_NVS = 22087680, O_NCS = 26281984;
constexpr size_t BUFB = (size_t)MROWS * DM * 2;
constexpr size_t WS_WIN = 0, WS_WA = (size_t)NIN * DM * 2, WS_WB = WS_WA + 2097152, WS_WO = WS_WB + 2097152;
constexpr size_t WS_B0 = 25165824;
constexpr size_t WS_QA = WS_B0 + BUFB, WS_BZ = WS_QA + BUFB, WS_SZA = WS_BZ + BUFB, WS_U = WS_SZA + BUFB, WS_SGB = WS_U + BUFB;
constexpr size_t WS_K = WS_SGB + BUFB, WS_VT = WS_K + (size_t)MROWS * 256 * 2, WS_ROPE = WS_VT + (size_t)MROWS * 256 * 2, WS_END = WS_ROPE + (size_t)NPOS * 64 * 4;
constexpr size_t WS_CTL = 265289728, CTL_BYTES = 65536;
static_assert(WS_END <= WS_CTL && WS_CTL + CTL_BYTES <= 268435456, "d_ws map");

constexpr int LDS_BYTES = 147456;

namespace pg8 {
constexpr int BM = 256, BK = 64, HALF = 128, HTB = HALF * BK * 2, STAGE_BYTES = 8 * HTB, NXCD = 8, WGM = 8;
__host__ __device__ __forceinline__ int lds_byte(int r, int c) { const int st = (r >> 4) * 2 + (c >> 5), rr = r & 15, cc = c & 31, ob = rr * 64 + cc * 2; return st * 1024 + (ob ^ (((ob >> 9) & 1) << 5)); }
__host__ __device__ __forceinline__ void stage_rc(int b, int& R, int& C) { const int st = b / 1024, sb = b % 1024, swz = sb ^ (((sb >> 9) & 1) << 5); R = (st >> 1) * 16 + swz / 64; C = (st & 1) * 32 + (swz % 64) / 2; }
__host__ __device__ __forceinline__ int perm32(int rho) { const int n = rho >> 4, i = rho & 15; return 8 * (i >> 2) + 4 * n + (i & 3); }

struct Unit { int pm, pn, part; };
struct Gemm { const bf16_t* A; const bf16_t* Bt; int M, N, K; size_t partA, partB; int ld; };

struct StaticOrder {
    int nM, nN, nwg, G, c, np, direct, special;
    __host__ __device__ void init(int M, int N, int G_, int c_, int np_, int direct_ = -1) { nM = M / BM; nN = N / BM; nwg = nM * nN; G = G_; c = c_; np = np_; direct = direct_; special = 0; }
    __host__ __device__ static void swz(int wgid, int nM_, int nN_, int& pm, int& pn) {
        const int nwg_ = nM_ * nN_;
        { const int q = nwg_ / NXCD, r = nwg_ % NXCD, xcd = wgid % NXCD, off = wgid / NXCD; wgid = (xcd < r ? xcd * (q + 1) : r * (q + 1) + (xcd - r) * q) + off; }
        const int nig = WGM * nN_, gid = wgid / nig, fm = gid * WGM, gsz = (nM_ - fm) < WGM ? (nM_ - fm) : WGM;
        pm = fm + ((wgid % nig) % gsz); pn = (wgid % nig) / gsz;
    }
    __host__ __device__ bool next(int i, Unit& u) const {
        const int it = (np == 2) ? (i >> 1) : i; u.part = (np == 2) ? (i & 1) : 0;
        if (direct >= 0) { if (it > 0) return false; u.pm = direct / nN; u.pn = direct % nN; return true; }
        const long L = (long)it * G + c;
        if (special) {
            if (L >= 2048) return false;
            int l = (int)L;
            if (l < 884) { swz(l, 26, 34, u.pm, u.pn); return true; } l -= 884;
            if (l < 1118) { swz(l, 43, 26, u.pm, u.pn); u.pm += 26; return true; } l -= 1118;
            if (l < 40) { u.pm = 64 + (l >> 3); u.pn = 26 + (l & 7); return true; } l -= 40;
            u.pm = 26; u.pn = 26 + l; return true;
        }
        if (L >= nwg) return false;
        swz((int)L, nM, nN, u.pm, u.pn); return true;
    }
};

typedef float f32x2_t __attribute__((ext_vector_type(2))); typedef __bf16 bf16x2_t __attribute__((ext_vector_type(2)));
__device__ __forceinline__ unsigned cvt_pk_bf16(float lo, float hi) { const f32x2_t v = {lo, hi}; const bf16x2_t b = __builtin_convertvector(v, bf16x2_t); return __builtin_bit_cast(unsigned, b); }

template <class Epi>
__device__ __forceinline__ void gemm_phase(LAS unsigned char* lds, const Gemm g, const StaticOrder& S, const Epi& E) {
    int tid_ = threadIdx.x; asm volatile("" : "+v"(tid_));
    const int tid = tid_, wid = __builtin_amdgcn_readfirstlane(tid >> 6), lane = tid & 63, wr = wid >> 2, wc = wid & 3, fr = lane & 15, fq = lane >> 4;
    const int K = g.ld ? g.ld : g.K, nt = g.K / BK;
    unsigned voffA[2], voffB[2];
#pragma unroll
    for (int i = 0; i < 2; ++i) { int R, C; stage_rc(tid * 16 + i * 8192, R, C); const int Rb = ((R & ~31) + perm32(R & 31));
        voffA[i] = (unsigned)(R * K + C) * 2u; voffB[i] = (unsigned)(Rb * K + C) * 2u; }
    const size_t kstep = (size_t)(BK * 2);
    const size_t hstep = (size_t)HALF * K * 2;
    const size_t tstep = 2 * hstep;
    const unsigned ldsw = (unsigned)wid * 1024u;
    const int aoff = lds_byte(wr * 64 + fr, fq * 8), boff = lds_byte(wc * 32 + fr, fq * 8);
#define PG8_SA(b, h) (((b) * 2 + (h)) * HTB)
#define PG8_SB(b, h) ((4 + (b) * 2 + (h)) * HTB)
#define PG8_STAGE(bufoff, gbase, voff) do { _Pragma("unroll") for (int _i = 0; _i < 2; ++_i) \
        __builtin_amdgcn_global_load_lds((const unsigned*)((const char*)(gbase) + (voff)[_i]), (LAS unsigned*)(lds + (bufoff) + ldsw + _i * 8192), 16, 0, 0); } while (0)
#define PG8_LDA(dst, b, h) do { _Pragma("unroll") for (int m = 0; m < 4; ++m) _Pragma("unroll") for (int k = 0; k < 2; ++k) dst[m][k] = *(const LAS bf16x8*)(lds + PG8_SA(b, h) + aoff + m * 2048 + k * 1024); } while (0)
#define PG8_LDB(dst, b, h) do { _Pragma("unroll") for (int n = 0; n < 2; ++n) _Pragma("unroll") for (int k = 0; k < 2; ++k) dst[n][k] = *(const LAS bf16x8*)(lds + PG8_SB(b, h) + boff + n * 2048 + k * 1024); } while (0)
#define PG8_MMA(ai, bj, At, Bt) do { __builtin_amdgcn_s_setprio(1); _Pragma("unroll") for (int m = 0; m < 4; ++m) _Pragma("unroll") for (int n = 0; n < 2; ++n) _Pragma("unroll") for (int k = 0; k < 2; ++k) \
        acc[ai][bj][m][n] = __builtin_amdgcn_mfma_f32_16x16x32_bf16(Bt[n][k], At[m][k], acc[ai][bj][m][n], 0, 0, 0); __builtin_amdgcn_s_setprio(0); } while (0)
#define PG8_WAIT_V(n) asm volatile("s_waitcnt vmcnt(" #n ")" ::: "memory")
#define PG8_WAIT_L(n) asm volatile("s_waitcnt lgkmcnt(" #n ")" ::: "memory")
#define PG8_BAR __builtin_amdgcn_s_barrier()
#define PG8_SCHED __builtin_amdgcn_sched_barrier(0)
    Unit cur, nxt; int ui = 0;
    if (!S.next(0, cur)) return;
    f32x4 acc[2][2][4][2];
#pragma unroll
    for (int a = 0; a < 2; ++a)
#pragma unroll
        for (int b = 0; b < 2; ++b)
#pragma unroll
            for (int m = 0; m < 4; ++m)
#pragma unroll
                for (int n = 0; n < 2; ++n) acc[a][b][m][n] = (f32x4){0.f, 0.f, 0.f, 0.f};
    bf16x8 At[4][2], B0[2][2], B1[2][2];
    const char* cA = (const char*)g.A + (size_t)cur.pm * tstep + (size_t)cur.part * g.partA; const char* cB = (const char*)g.Bt + (size_t)cur.pn * tstep + (size_t)cur.part * g.partB;
    PG8_STAGE(PG8_SB(0, 0), cB, voffB); PG8_STAGE(PG8_SB(0, 1), cB + hstep, voffB); PG8_STAGE(PG8_SA(0, 0), cA, voffA); PG8_STAGE(PG8_SA(0, 1), cA + hstep, voffA);
    if (wr == 1) PG8_BAR;
    PG8_WAIT_V(2); PG8_BAR;
    PG8_STAGE(PG8_SB(1, 0), cB + kstep, voffB); PG8_STAGE(PG8_SA(1, 0), cA + kstep, voffA); PG8_STAGE(PG8_SB(1, 1), cB + hstep + kstep, voffB);
    PG8_WAIT_V(6); PG8_BAR;
    for (;;) {
        const bool has_next = S.next(ui + 1, nxt);
        const char* nA = has_next ? (const char*)g.A + (size_t)nxt.pm * tstep + (size_t)nxt.part * g.partA : cA; const char* nB = has_next ? (const char*)g.Bt + (size_t)nxt.pn * tstep + (size_t)nxt.part * g.partB : cB;
        for (int t = 0; t < nt; t += 2) {
            const bool last = (t == nt - 2);
            const char* a1 = cA + (size_t)(t + 1) * kstep;
            const char* a2 = last ? nA : cA + (size_t)(t + 2) * kstep; const char* b2 = last ? nB : cB + (size_t)(t + 2) * kstep;
            const char* a3 = a2 + kstep; const char* b3 = b2 + kstep;
            PG8_LDB(B0, 0, 0); PG8_LDB(B1, 0, 1); PG8_SCHED; PG8_LDA(At, 0, 0); PG8_STAGE(PG8_SA(1, 1), a1 + hstep, voffA);
            PG8_WAIT_V(8); PG8_WAIT_L(0); PG8_BAR; PG8_MMA(0, 0, At, B0); PG8_MMA(0, 1, At, B1); PG8_BAR; PG8_SCHED;
            PG8_LDA(At, 0, 1); PG8_STAGE(PG8_SB(0, 0), b2, voffB); PG8_STAGE(PG8_SB(0, 1), b2 + hstep, voffB); PG8_STAGE(PG8_SA(0, 0), a2, voffA);
            PG8_WAIT_V(8); PG8_WAIT_L(0); PG8_BAR; PG8_MMA(1, 0, At, B0); PG8_MMA(1, 1, At, B1); PG8_BAR; PG8_SCHED;
            PG8_LDB(B0, 1, 0); PG8_LDB(B1, 1, 1); PG8_SCHED; PG8_LDA(At, 1, 0); PG8_STAGE(PG8_SA(0, 1), a2 + hstep, voffA);
            PG8_WAIT_V(8); PG8_WAIT_L(0); PG8_BAR; PG8_MMA(0, 0, At, B0); PG8_MMA(0, 1, At, B1); PG8_BAR; PG8_SCHED;
            PG8_LDA(At, 1, 1); PG8_STAGE(PG8_SB(1, 0), b3, voffB); PG8_STAGE(PG8_SB(1, 1), b3 + hstep, voffB); PG8_STAGE(PG8_SA(1, 0), a3, voffA);
            PG8_WAIT_V(8); PG8_WAIT_L(0); PG8_BAR; PG8_MMA(1, 0, At, B0); PG8_MMA(1, 1, At, B1); PG8_BAR; PG8_SCHED;
        }
        if (wr == 0) PG8_BAR;
        { Unit eu = cur; int ewr = wr, ewc = wc, efr = fr, efq = fq;
          asm volatile("" : "+s"(eu.pm), "+s"(eu.pn), "+s"(eu.part), "+s"(ewr), "+s"(ewc), "+v"(efr), "+v"(efq));
          E(acc, eu, ewr, ewc, efr, efq); }
        if (!has_next) break;
        if (!E.keep(cur)) {
#pragma unroll
        for (int a = 0; a < 2; ++a)
#pragma unroll
            for (int b = 0; b < 2; ++b)
#pragma unroll
                for (int m = 0; m < 4; ++m)
#pragma unroll
                    for (int n = 0; n < 2; ++n) acc[a][b][m][n] = (f32x4){0.f, 0.f, 0.f, 0.f};
        }
        cur = nxt; cA = nA; cB = nB; ++ui;
        if (wr == 1) PG8_BAR;
    }
    PG8_WAIT_V(0);
    PG8_BAR;
#undef PG8_SA
#undef PG8_SB
#undef PG8_STAGE
#undef PG8_LDA
#undef PG8_LDB
#undef PG8_MMA
#undef PG8_WAIT_V
#undef PG8_WAIT_L
#undef PG8_BAR
#undef PG8_SCHED
}
}
using pg8::cvt_pk_bf16;

__device__ __forceinline__ unsigned xb_ld(unsigned* p)              { return __hip_atomic_load(p, __ATOMIC_RELAXED, __HIP_MEMORY_SCOPE_AGENT); }
__device__ __forceinline__ unsigned xb_add(unsigned* p, unsigned v) { return __hip_atomic_fetch_add(p, v, __ATOMIC_RELAXED, __HIP_MEMORY_SCOPE_AGENT); }
__device__ __forceinline__ float bf_lo(unsigned u) { return __uint_as_float(u << 16); }
__device__ __forceinline__ float bf_hi(unsigned u) { return __uint_as_float(u & 0xffff0000u); }
__device__ __forceinline__ float sigm_f(float x) { return __builtin_amdgcn_rcpf(1.f + __builtin_amdgcn_exp2f(-LOG2E * x)); }
__device__ __forceinline__ float silu_f(float x) { return x * sigm_f(x); }
__device__ __forceinline__ f32x4 sigm4(const f32x4 v) { f32x4 r; r.x = sigm_f(v.x); r.y = sigm_f(v.y); r.z = sigm_f(v.z); r.w = sigm_f(v.w); return r; }
__device__ __forceinline__ f32x4 onepexp4(const f32x4 v) { f32x4 r; r.x = 1.f + __builtin_amdgcn_exp2f(-LOG2E * v.x); r.y = 1.f + __builtin_amdgcn_exp2f(-LOG2E * v.y); r.z = 1.f + __builtin_amdgcn_exp2f(-LOG2E * v.z); r.w = 1.f + __builtin_amdgcn_exp2f(-LOG2E * v.w); return r; }
__device__ __forceinline__ f32x4 rcp4(const f32x4 v) { f32x4 r; r.x = __builtin_amdgcn_rcpf(v.x); r.y = __builtin_amdgcn_rcpf(v.y); r.z = __builtin_amdgcn_rcpf(v.z); r.w = __builtin_amdgcn_rcpf(v.w); return r; }
__device__ __forceinline__ void gate4(const f32x4 ga, const f32x4 gb, f32x4& r, f32x4& sb) { const f32x4 ea = onepexp4(ga), eb = onepexp4(gb); sb = rcp4(eb); r = rcp4(ea) * eb; }
__device__ __forceinline__ int rowpos(int row) { return row < R_SAMPLE ? (row > R_META ? row - R_META : 0) : (row < R_END ? 16384 + ((row - R_SAMPLE) & 7) : 0); }
__device__ __forceinline__ u32x4 pack8(const f32x4 a, const f32x4 b) { u32x4 w; w.x = cvt_pk_bf16(a[0], a[1]); w.y = cvt_pk_bf16(a[2], a[3]); w.z = cvt_pk_bf16(b[0], b[1]); w.w = cvt_pk_bf16(b[2], b[3]); return w; }

struct Epi1 {
    bf16_t *Q, *Kb, *Vt, *SZA, *BZ, *U, *SGA, *SGB; const float *rope, *qnw, *knw; float* out;
    __device__ __forceinline__ bool keep(const pg8::Unit&) const { return false; }
    __device__ __forceinline__ void operator()(f32x4 (&acc)[2][2][4][2], const pg8::Unit& u, int wr, int wc, int fr, int fq) const {
        const int pn = u.pn, row0 = u.pm * 256 + wr * 64 + fr;
        if (pn < 5) {
            const bool isq = pn < 4; const float* nw = isq ? qnw : knw;
            f32x4 w[2][2];
#pragma unroll
            for (int bj = 0; bj < 2; ++bj)
#pragma unroll
                for (int n = 0; n < 2; ++n) w[bj][n] = *(const f32x4*)(nw + 32 * bj + 8 * fq + 4 * n);
            const float sc = isq ? C2 : 1.f;
#pragma unroll
            for (int ai = 0; ai < 2; ++ai)
#pragma unroll
                for (int m = 0; m < 4; ++m) {
                    const int row = row0 + ai * 128 + m * 16;
                    float ss = 0.f;
#pragma unroll
                    for (int bj = 0; bj < 2; ++bj)
#pragma unroll
                        for (int n = 0; n < 2; ++n) { const f32x4 x = acc[ai][bj][m][n]; ss += (x[0] * x[0] + x[1] * x[1]) + (x[2] * x[2] + x[3] * x[3]); }
                    ss += __shfl_xor(ss, 16); ss += __shfl_xor(ss, 32);
                    const float rinv = 1.0f / sqrtf(ss * (1.f / 64.f) + EPS);
                    const float* rp = rope + (size_t)rowpos(row) * 64 + 8 * fq;
                    f32x4 o1[2], o2[2];
#pragma unroll
                    for (int n = 0; n < 2; ++n) {
                        const f32x4 cs = *(const f32x4*)(rp + 4 * n), sn = *(const f32x4*)(rp + 32 + 4 * n);
                        const f32x4 x1 = acc[ai][0][m][n] * rinv * w[0][n], x2 = acc[ai][1][m][n] * rinv * w[1][n];
                        o1[n] = (x1 * cs - x2 * sn) * sc; o2[n] = (x2 * cs + x1 * sn) * sc;
                    }
                    if (isq) {
                        bf16_t* p = Q + (size_t)row * DM + 64 * (4 * pn + wc) + 8 * fq;
                        *(u32x4*)p = pack8(o1[0], o1[1]); *(u32x4*)(p + 32) = pack8(o2[0], o2[1]);
                    } else {
                        bf16_t* p = Kb + (size_t)row * 256 + 64 * wc + 8 * fq;
                        *(u32x4*)p = pack8(o1[0], o1[1]); *(u32x4*)(p + 32) = pack8(o2[0], o2[1]);
                        if (u.pm >= 64) {
                            float* d = nullptr;
                            if (row >= 16384 && row < R_SAMPLE) d = out + O_NKP + (size_t)(row - 16384) * 256;
                            else if (row >= R_SAMPLE && row < R_END) { const int sr = row - R_SAMPLE; d = out + O_NKS + ((size_t)(sr >> 3) * 128 + 120 + (sr & 7)) * 256; }
                            if (d) { d += 64 * wc + 8 * fq; *(f32x4*)d = o1[0]; *(f32x4*)(d + 4) = o1[1]; *(f32x4*)(d + 32) = o2[0]; *(f32x4*)(d + 36) = o2[1]; }
                        }
                    }
                }
        } else if (pn == 5) {
#pragma unroll
            for (int ai = 0; ai < 2; ++ai)
#pragma unroll
                for (int m = 0; m < 4; ++m) {
                    const int row = row0 + ai * 128 + m * 16;
                    float* d = nullptr;
                    if (u.pm >= 64) {
                        if (row >= 16384 && row < R_SAMPLE) d = out + O_NVP + (size_t)(row - 16384) * 256;
                        else if (row >= R_SAMPLE && row < R_END) { const int sr = row - R_SAMPLE; d = out + O_NVS + ((size_t)(sr >> 3) * 128 + 120 + (sr & 7)) * 256; }
                    }
#pragma unroll
                    for (int bj = 0; bj < 2; ++bj)
#pragma unroll
                        for (int n = 0; n < 2; ++n) {
                            const int c = 128 * bj + 32 * wc + 8 * fq + 4 * n; const f32x4 x = acc[ai][bj][m][n];
                            const unsigned p0 = cvt_pk_bf16(x[0], x[1]), p1 = cvt_pk_bf16(x[2], x[3]);
                            bf16_t* vp = Vt + (size_t)c * MROWS + row;
                            vp[0] = (bf16_t)(p0 & 0xffffu); vp[MROWS] = (bf16_t)(p0 >> 16); vp[2 * (size_t)MROWS] = (bf16_t)(p1 & 0xffffu); vp[3 * (size_t)MROWS] = (bf16_t)(p1 >> 16);
                            if (d) *(f32x4*)(d + c) = x;
                        }
                }
        } else if (pn >= 10 && pn < 26) {
            const int ch = 64 * (pn - 10) + 16 * wc + 4 * fq;
#pragma unroll
            for (int ai = 0; ai < 2; ++ai)
#pragma unroll
                for (int m = 0; m < 4; ++m) {
                    const int row = row0 + ai * 128 + m * 16;
                    const f32x4 b = acc[ai][0][m][0], c = acc[ai][0][m][1], hc = acc[ai][1][m][0], zb = acc[ai][1][m][1];
                    const f32x4 uu = c * hc, bz = b * zb * sigm4(zb);
                    u32x2 wu, wb; wu.x = cvt_pk_bf16(uu[0], uu[1]); wu.y = cvt_pk_bf16(uu[2], uu[3]); wb.x = cvt_pk_bf16(bz[0], bz[1]); wb.y = cvt_pk_bf16(bz[2], bz[3]);
                    *(u32x2*)(U + (size_t)row * DM + ch) = wu; *(u32x2*)(BZ + (size_t)row * DM + ch) = wb;
                    if (u.pm >= 64) {
                        if (row == 16510 || row == 16511) *(f32x4*)(out + O_NCP + (size_t)(row - 16510) * DM + ch) = uu;
                        else if (row >= R_SAMPLE && row < R_END && ((row - R_SAMPLE) & 7) >= 6) { const int sr = row - R_SAMPLE; *(f32x4*)(out + O_NCS + ((size_t)(sr >> 3) * 2 + ((sr & 7) - 6)) * DM + ch) = uu; }
                    }
                }
        } else if (pn < 10) {
            const int col0 = (pn - 6) * 256 + 32 * wc + 8 * fq;
#pragma unroll
            for (int ai = 0; ai < 2; ++ai)
#pragma unroll
                for (int m = 0; m < 4; ++m) {
                    bf16_t* rowp = SZA + (size_t)(row0 + ai * 128 + m * 16) * DM + col0;
#pragma unroll
                    for (int bj = 0; bj < 2; ++bj) {
                        const f32x4 v0 = acc[ai][bj][m][0], v1 = acc[ai][bj][m][1];
                        *(u32x4*)(rowp + bj * 128) = pack8(sigm4(v0) * v0, sigm4(v1) * v1);
                    }
                }
        } else {
            const int col0 = (pn - 26) * 128 + 32 * wc + 8 * fq;
#pragma unroll
            for (int ai = 0; ai < 2; ++ai)
#pragma unroll
                for (int m = 0; m < 4; ++m) {
                    const size_t off = (size_t)(row0 + ai * 128 + m * 16) * DM + col0;
#pragma unroll
                    for (int n = 0; n < 2; ++n) {
                        f32x4 r0, s0; gate4(acc[ai][0][m][n], acc[ai][1][m][n], r0, s0);
                        u32x2 wr_, ws_; wr_.x = cvt_pk_bf16(r0.x, r0.y); wr_.y = cvt_pk_bf16(r0.z, r0.w); ws_.x = cvt_pk_bf16(s0.x, s0.y); ws_.y = cvt_pk_bf16(s0.z, s0.w);
                        *(u32x2*)(SGA + off + 4 * n) = wr_; *(u32x2*)(SGB + off + 4 * n) = ws_;
                        __builtin_amdgcn_sched_barrier(0);
                    }
                }
        }
    }
};

struct Epi2 {
    const bf16_t *SGA, *SGB; bf16_t* MIX;
    __device__ __forceinline__ bool keep(const pg8::Unit& u) const { return u.part == 0; }
    __device__ __forceinline__ void operator()(f32x4 (&acc)[2][2][4][2], const pg8::Unit& u, int wr, int wc, int fr, int fq) const {
        const int row0 = u.pm * 256 + wr * 64 + fr, col0 = u.pn * 256 + 32 * wc + 8 * fq;
        const bf16_t* p0 = SGA; const bf16_t* p1 = SGB; asm volatile("" : "+s"(p0), "+s"(p1));
        const bf16_t* G = u.part == 0 ? p0 : p1;
        u32x4 gv[2][4][2];
#pragma unroll
        for (int ai = 0; ai < 2; ++ai)
#pragma unroll
            for (int m = 0; m < 4; ++m)
#pragma unroll
                for (int bj = 0; bj < 2; ++bj) gv[ai][m][bj] = *(const u32x4*)(G + (size_t)(row0 + ai * 128 + m * 16) * DM + col0 + bj * 128);
#pragma unroll
        for (int ai = 0; ai < 2; ++ai)
#pragma unroll
            for (int m = 0; m < 4; ++m) {
                const size_t off = (size_t)(row0 + ai * 128 + m * 16) * DM + col0;
#pragma unroll
                for (int bj = 0; bj < 2; ++bj) {
                    const u32x4 gb = gv[ai][m][bj];
                    const f32x4 b0 = {bf_lo(gb.x), bf_hi(gb.x), bf_lo(gb.y), bf_hi(gb.y)}, b1 = {bf_lo(gb.z), bf_hi(gb.z), bf_lo(gb.w), bf_hi(gb.w)};
                    if (u.part == 0) { acc[ai][bj][m][0] = acc[ai][bj][m][0] * b0; acc[ai][bj][m][1] = acc[ai][bj][m][1] * b1; }
                    else *(u32x4*)(MIX + off + bj * 128) = pack8(acc[ai][bj][m][0] * b0, acc[ai][bj][m][1] * b1);
                }
            }
    }
};

template <bool GATE> struct EpiPart {
    const bf16_t* SGA; float* scr; const bf16_t* SGB;
    __device__ __forceinline__ bool keep(const pg8::Unit&) const { return false; }
    __device__ __forceinline__ void operator()(f32x4 (&acc)[2][2][4][2], const pg8::Unit& u, int wr, int wc, int fr, int fq) const {
        const int row0 = u.pm * 256 + wr * 64 + fr, col0 = u.pn * 256 + 32 * wc + 8 * fq, lr0 = wr * 64 + fr, lc0 = 32 * wc + 8 * fq;
#pragma unroll
        for (int ai = 0; ai < 2; ++ai)
#pragma unroll
            for (int m = 0; m < 4; ++m) {
                const size_t off = (size_t)(row0 + ai * 128 + m * 16) * DM + col0;
                bf16_t* sp = (bf16_t*)scr + (size_t)(lr0 + ai * 128 + m * 16) * 256 + lc0;
#pragma unroll
                for (int bj = 0; bj < 2; ++bj) {
                    f32x4 a0 = {1.f, 1.f, 1.f, 1.f}, a1 = a0;
                    if (GATE) { const u32x4 ga = *(const u32x4*)(SGA + off + bj * 128), gb = *(const u32x4*)(SGB + off + bj * 128);
                        a0 = (f32x4){bf_lo(ga.x) * bf_lo(gb.x), bf_hi(ga.x) * bf_hi(gb.x), bf_lo(ga.y) * bf_lo(gb.y), bf_hi(ga.y) * bf_hi(gb.y)};
                        a1 = (f32x4){bf_lo(ga.z) * bf_lo(gb.z), bf_hi(ga.z) * bf_hi(gb.z), bf_lo(ga.w) * bf_lo(gb.w), bf_hi(ga.w) * bf_hi(gb.w)}; }
                    *(u32x4*)(sp + bj * 128) = pack8(acc[ai][bj][m][0] * a0, acc[ai][bj][m][1] * a1);
                }
            }
    }
};
__device__ __forceinline__ void wait_count(unsigned* cnt, unsigned want) {
    unsigned sp = 0; while (xb_ld(cnt) < want) { __builtin_amdgcn_s_sleep(1); if (++sp > (1u << 22)) break; }
    __builtin_amdgcn_fence(__ATOMIC_ACQUIRE, "agent");
    asm volatile("s_waitcnt vmcnt(0)" ::: "memory");
}
struct Epi2b {
    const bf16_t* SGB; const float* scr; bf16_t* MIX; unsigned* cnt;
    __device__ __forceinline__ bool keep(const pg8::Unit&) const { return false; }
    __device__ __forceinline__ void operator()(f32x4 (&acc)[2][2][4][2], const pg8::Unit& u, int wr, int wc, int fr, int fq) const {
        const int row0 = u.pm * 256 + wr * 64 + fr, col0 = u.pn * 256 + 32 * wc + 8 * fq, lr0 = wr * 64 + fr, lc0 = 32 * wc + 8 * fq;
        u32x4 gbv[4][2];
#pragma unroll
        for (int m = 0; m < 4; ++m)
#pragma unroll
            for (int bj = 0; bj < 2; ++bj) gbv[m][bj] = *(const u32x4*)(SGB + (size_t)(row0 + m * 16) * DM + col0 + bj * 128);
        wait_count(cnt, 1u);
#pragma unroll
        for (int ai = 0; ai < 2; ++ai) {
            u32x4 ppv[4][2];
#pragma unroll
            for (int m = 0; m < 4; ++m) { const bf16_t* sp = (const bf16_t*)scr + (size_t)(lr0 + ai * 128 + m * 16) * 256 + lc0;
#pragma unroll
                for (int bj = 0; bj < 2; ++bj) { ppv[m][bj] = *(const u32x4*)(sp + bj * 128); if (ai == 1) gbv[m][bj] = *(const u32x4*)(SGB + (size_t)(row0 + 128 + m * 16) * DM + col0 + bj * 128); } }
#pragma unroll
            for (int m = 0; m < 4; ++m) { const size_t off = (size_t)(row0 + ai * 128 + m * 16) * DM + col0;
#pragma unroll
                for (int bj = 0; bj < 2; ++bj) {
                    const u32x4 gb = gbv[m][bj], pp = ppv[m][bj];
                    const f32x4 b0 = {bf_lo(gb.x), bf_hi(gb.x), bf_lo(gb.y), bf_hi(gb.y)}, b1 = {bf_lo(gb.z), bf_hi(gb.z), bf_lo(gb.w), bf_hi(gb.w)};
                    const f32x4 p0 = {bf_lo(pp.x), bf_hi(pp.x), bf_lo(pp.y), bf_hi(pp.y)}, p1 = {bf_lo(pp.z), bf_hi(pp.z), bf_lo(pp.w), bf_hi(pp.w)};
                    *(u32x4*)(MIX + off + bj * 128) = pack8(p0 + acc[ai][bj][m][0] * b0, p1 + acc[ai][bj][m][1] * b1);
                } }
            asm volatile("" ::: "memory");
        }
    }
};
struct Epi3b {
    const float *xp, *xs; float* y; const float* scr; unsigned* cnt;
    __device__ __forceinline__ bool keep(const pg8::Unit&) const { return false; }
    __device__ __forceinline__ void operator()(f32x4 (&acc)[2][2][4][2], const pg8::Unit& u, int wr, int wc, int fr, int fq) const {
        const int row0 = u.pm * 256 + wr * 64 + fr, col0 = u.pn * 256 + 32 * wc + 8 * fq, lr0 = wr * 64 + fr, lc0 = 32 * wc + 8 * fq;
        wait_count(cnt, 1u);
#pragma unroll
        for (int ai = 0; ai < 2; ++ai)
#pragma unroll
            for (int m = 0; m < 4; ++m) {
                const int gr = row0 + ai * 128 + m * 16;
                const float* xr = (gr < 16384 ? xp + (size_t)gr * DM : xs + (size_t)(gr - 16384) * DM) + col0;
                float* yr = y + (size_t)gr * DM + col0;
                const bf16_t* sp = (const bf16_t*)scr + (size_t)(lr0 + ai * 128 + m * 16) * 256 + lc0;
#pragma unroll
                for (int bj = 0; bj < 2; ++bj) {
                    const u32x4 pp = *(const u32x4*)(sp + bj * 128); const f32x4 p0 = {bf_lo(pp.x), bf_hi(pp.x), bf_lo(pp.y), bf_hi(pp.y)}, p1 = {bf_lo(pp.z), bf_hi(pp.z), bf_lo(pp.w), bf_hi(pp.w)};
                    *(f32x4*)(yr + bj * 128) = *(const f32x4*)(xr + bj * 128) + p0 + acc[ai][bj][m][0]; *(f32x4*)(yr + bj * 128 + 4) = *(const f32x4*)(xr + bj * 128 + 4) + p1 + acc[ai][bj][m][1];
                }
            }
    }
};
__device__ __forceinline__ void publish_count(unsigned* cnt) {
    asm volatile("s_waitcnt vmcnt(0)" ::: "memory");
    __syncthreads();
    if (threadIdx.x == 0) { __builtin_amdgcn_fence(__ATOMIC_RELEASE, "agent"); asm volatile("s_waitcnt vmcnt(0)" ::: "memory"); xb_add(cnt, 1u); }
}

struct Epi3 {
    const float *xp, *xs; float* y;
    __device__ __forceinline__ bool keep(const pg8::Unit&) const { return false; }
    __device__ __forceinline__ void operator()(f32x4 (&acc)[2][2][4][2], const pg8::Unit& u, int wr, int wc, int fr, int fq) const {
        const int row0 = u.pm * 256 + wr * 64 + fr, col0 = u.pn * 256 + 32 * wc + 8 * fq;
#pragma unroll
        for (int ai = 0; ai < 2; ++ai) {
            f32x4 xv[4][2][2];
#pragma unroll
            for (int m = 0; m < 4; ++m) {
                const int gr = row0 + ai * 128 + m * 16;
                const float* xr = (gr < 16384 ? xp + (size_t)gr * DM : xs + (size_t)(gr - 16384) * DM) + col0;
#pragma unroll
                for (int bj = 0; bj < 2; ++bj)
#pragma unroll
                    for (int n = 0; n < 2; ++n) xv[m][bj][n] = *(const f32x4*)(xr + bj * 128 + 4 * n);
            }
#pragma unroll
            for (int m = 0; m < 4; ++m) {
                float* yr = y + (size_t)(row0 + ai * 128 + m * 16) * DM + col0;
#pragma unroll
                for (int bj = 0; bj < 2; ++bj)
#pragma unroll
                    for (int n = 0; n < 2; ++n) *(f32x4*)(yr + bj * 128 + 4 * n) = xv[m][bj][n] + acc[ai][bj][m][n];
            }
            asm volatile("" ::: "memory");
        }
    }
};

__device__ __forceinline__ float wave_sum(float v) {
#pragma unroll
    for (int o = 1; o < 64; o <<= 1) v += __shfl_xor(v, o);
    return v;
}
__device__ __forceinline__ int win_orig_col(int n) {
    const int pn = n >> 8, c = n & 255;
    if (pn < 5) { const int bj = c >> 7, wc = (c >> 5) & 3, j = c & 31; return 64 * (4 * pn + wc) + 32 * bj + j; }
    if (pn >= 10 && pn < 26) { const int t = pn - 10, bj = c >> 7, wc = (c >> 5) & 3, fq = (c >> 3) & 3, nn = (c >> 2) & 1, e = c & 3; return 2560 + 1024 * (2 * bj + nn) + 64 * t + 16 * wc + 4 * fq + e; }
    if (pn >= 26) { const int t = pn - 26, bj = c >> 7, rest = c & 127; return 6656 + 1024 * bj + 128 * t + rest; }
    return n;
}
template <bool PERMUTE>
__device__ __forceinline__ void p0_transpose_item(const float* W, int K, int N, bf16_t* WT, LAS float* scr, int item, int lane) {
    const int nblk = N / 32, kb = item / nblk, nb = item % nblk, k0 = 64 * kb, n0 = 32 * nb;
    const int ncol = PERMUTE ? win_orig_col(n0 + (lane & 31)) : n0 + (lane & 31);
    float tv[32];
#pragma unroll
    for (int i = 0; i < 32; ++i) tv[i] = __builtin_nontemporal_load(W + (size_t)(k0 + 2 * i + (lane >> 5)) * N + ncol);
#pragma unroll
    for (int i = 0; i < 32; ++i) scr[(2 * i + (lane >> 5)) * 33 + (lane & 31)] = tv[i];
    asm volatile("s_waitcnt lgkmcnt(0)" ::: "memory");
    const int c = lane & 7;
#pragma unroll
    for (int j = 0; j < 4; ++j) { const int n = (lane >> 3) + 8 * j; const LAS float* s = scr + (8 * c) * 33 + n;
        u32x4 o; o.x = cvt_pk_bf16(s[0 * 33], s[1 * 33]); o.y = cvt_pk_bf16(s[2 * 33], s[3 * 33]); o.z = cvt_pk_bf16(s[4 * 33], s[5 * 33]); o.w = cvt_pk_bf16(s[6 * 33], s[7 * 33]);
        *(u32x4*)(WT + (size_t)(n0 + n) * K + k0 + 8 * c) = o; }
    asm volatile("s_waitcnt lgkmcnt(0)" ::: "memory");
}

struct Args { const float* in[15]; float* out; unsigned char* ws; int ph_lo, ph_hi; };

__device__ __forceinline__ void p0_prologue(const Args& a, LAS unsigned char* lds, int tid, int lane, int wave, int G) {
    LAS float* scr = (LAS float*)(lds + wave * 16384);
    const int gw = blockIdx.x * 8 + wave, NGW = G * 8;
    bf16_t* WIN = (bf16_t*)(a.ws + WS_WIN); bf16_t* WA = (bf16_t*)(a.ws + WS_WA); bf16_t* WB = (bf16_t*)(a.ws + WS_WB); bf16_t* WO = (bf16_t*)(a.ws + WS_WO);
    constexpr int I_IN = 16 * (NIN / 32), I_SQ = 16 * 32, NITEMS = I_IN + 3 * I_SQ;
    for (int it = gw; it < NITEMS; it += NGW) {
        int r = it;
        if (r < I_IN) { p0_transpose_item<true>(a.in[7], DM, NIN, WIN, scr, r, lane); continue; } r -= I_IN;
        if (r < I_SQ) { p0_transpose_item<false>(a.in[12], DM, DM, WA, scr, r, lane); continue; } r -= I_SQ;
        if (r < I_SQ) { p0_transpose_item<false>(a.in[13], DM, DM, WB, scr, r, lane); continue; } r -= I_SQ;
        p0_transpose_item<false>(a.in[14], DM, DM, WO, scr, r, lane);
    }
    bf16_t* XN = (bf16_t*)(a.ws + WS_B0);
    const f32x4* nwp = (const f32x4*)a.in[6] + lane;
    f32x4 nw[4];
#pragma unroll
    for (int j = 0; j < 4; ++j) nw[j] = nwp[64 * j];
    for (int m0 = gw; m0 < MROWS; m0 += 4 * NGW) {
        const float* src[4]; f32x4 v[4][4];
#pragma unroll
        for (int q = 0; q < 4; ++q) {
            const int m = m0 + q * NGW; src[q] = nullptr;
            if (m >= R_PROMPT && m < R_SAMPLE) src[q] = a.in[0] + (size_t)(m - R_PROMPT) * DM;
            else if (m >= R_SAMPLE && m < R_END) src[q] = a.in[1] + (size_t)(m - R_SAMPLE) * DM;
            else if (m >= R_META && m < R_PROMPT) src[q] = a.in[5] + (size_t)(m - R_META) * DM;
#pragma unroll
            for (int j = 0; j < 4; ++j) v[q][j] = src[q] ? __builtin_nontemporal_load((const f32x4*)src[q] + lane + 64 * j) : (f32x4){0.f, 0.f, 0.f, 0.f};
        }
#pragma unroll
        for (int q = 0; q < 4; ++q) {
            const int m = m0 + q * NGW;
            if (m < MROWS) {
                float s2 = 0.f;
#pragma unroll
                for (int j = 0; j < 4; ++j) s2 += (v[q][j].x * v[q][j].x + v[q][j].y * v[q][j].y) + (v[q][j].z * v[q][j].z + v[q][j].w * v[q][j].w);
                const float r = 1.0f / sqrtf(wave_sum(s2) * (1.f / DM) + EPS);
                unsigned long long* o8 = (unsigned long long*)(XN + (size_t)m * DM) + lane;
#pragma unroll
                for (int j = 0; j < 4; ++j) { const f32x4 y = v[q][j] * r * nw[j]; o8[64 * j] = (unsigned long long)cvt_pk_bf16(y.x, y.y) | ((unsigned long long)cvt_pk_bf16(y.z, y.w) << 32); }
            }
        }
    }
    float* rope = (float*)(a.ws + WS_ROPE);
    for (int i = blockIdx.x * 512 + tid; i < NPOS * 32; i += G * 512) {
        const int pos = i >> 5, j = i & 31;
        double invd = 1.0; for (int q = 0; q < j; ++q) invd *= 0.74989420933245582730;
        const float inv = (float)invd; const float angf = (float)pos * inv; const double ang = (double)angf;
        const double kq = __builtin_rint(ang * 0.63661977236758134308); const int qi = (int)kq;
        double rr = __builtin_fma(-kq, 1.57079632679489655800, ang); rr = __builtin_fma(-kq, 6.12323399573676603587e-17, rr);
        const double r2 = rr * rr;
        double sn = r2 * (1.0 / 6227020800.0) - (1.0 / 39916800.0); sn = sn * r2 + (1.0 / 362880.0); sn = sn * r2 - (1.0 / 5040.0); sn = sn * r2 + (1.0 / 120.0); sn = sn * r2 - (1.0 / 6.0); sn = sn * r2 * rr + rr;
        double cs = r2 * (1.0 / 479001600.0) - (1.0 / 3628800.0); cs = cs * r2 + (1.0 / 40320.0); cs = cs * r2 - (1.0 / 720.0); cs = cs * r2 + (1.0 / 24.0); cs = cs * r2 - 0.5; cs = cs * r2 + 1.0;
        double so, co;
        switch (qi & 3) { case 0: so = sn; co = cs; break; case 1: so = cs; co = -sn; break; case 2: so = -sn; co = -cs; break; default: so = -cs; co = sn; break; }
        rope[(size_t)pos * 64 + j] = (float)co; rope[(size_t)pos * 64 + 32 + j] = (float)so;
    }
}

__device__ __forceinline__ int crow(int r, int hi) { return (r & 3) + 8 * (r >> 2) + 4 * hi; }
__device__ __forceinline__ bf16x8 packp(const f32x16& p, int s) {
    u32x4 w; w.x = cvt_pk_bf16(p[8 * s + 0], p[8 * s + 1]); w.y = cvt_pk_bf16(p[8 * s + 2], p[8 * s + 3]); w.z = cvt_pk_bf16(p[8 * s + 4], p[8 * s + 5]); w.w = cvt_pk_bf16(p[8 * s + 6], p[8 * s + 7]);
    return __builtin_bit_cast(bf16x8, w);
}
__device__ __forceinline__ float sink_softmax5(f32x16 (&S)[5], int qcmp, int hi, float sink2, int minkr) {
    const float NEG = -INFINITY;
#pragma unroll
    for (int r = 0; r < 16; ++r) { const int c = crow(r, hi); if (c < qcmp) S[0][r] = NEG; if (c > qcmp) S[4][r] = NEG; }
    if (minkr > 0) {
#pragma unroll
        for (int kb = 0; kb < 5; ++kb)
#pragma unroll
            for (int r = 0; r < 16; ++r) if (32 * kb + crow(r, hi) < minkr) S[kb][r] = NEG;
    }
    float m = sink2;
#pragma unroll
    for (int kb = 0; kb < 5; ++kb)
#pragma unroll
        for (int r = 0; r < 16; ++r) m = fmaxf(m, S[kb][r]);
    m = fmaxf(m, __shfl_xor(m, 32));
    float l = 0.f;
#pragma unroll
    for (int kb = 0; kb < 5; ++kb)
#pragma unroll
        for (int r = 0; r < 16; ++r) { const float p = __builtin_amdgcn_exp2f(S[kb][r] - m); S[kb][r] = p; l += p; }
    l += __shfl_xor(l, 32);
    l += __builtin_amdgcn_exp2f(sink2 - m);
    return 1.0f / l;
}
__device__ __forceinline__ void attn_store(const f32x16 (&O)[2], float inv_l, int row, int head, int hi, const bf16_t* SZA, bf16_t* QA) {
#pragma unroll
    for (int blk = 0; blk < 2; ++blk)
#pragma unroll
        for (int rr = 0; rr < 4; ++rr) {
            const size_t off = (size_t)row * DM + 64 * head + 32 * blk + 8 * rr + 4 * hi;
            const u32x2 z = *(const u32x2*)(SZA + off);
            u32x2 w; w.x = cvt_pk_bf16(O[blk][4 * rr] * inv_l * bf_lo(z.x), O[blk][4 * rr + 1] * inv_l * bf_hi(z.x)); w.y = cvt_pk_bf16(O[blk][4 * rr + 2] * inv_l * bf_lo(z.y), O[blk][4 * rr + 3] * inv_l * bf_hi(z.y));
            *(u32x2*)(QA + off) = w;
        }
}

__device__ __forceinline__ void attn_prompt_all(LAS unsigned char* lds, int tid, int id0, int G, int idEnd, const bf16_t* Kb, const bf16_t* Vt, bf16_t* QA, const bf16_t* SZA, const float* sinks) {
    const int lane = tid & 63, wid = __builtin_amdgcn_readfirstlane(tid >> 6), ql = lane & 31, hi = lane >> 5;
    LAS unsigned char* Ks = lds; LAS unsigned char* Vs = lds + 27648;
    const int i0 = 32 * (wid & 1);
    u32x4 kst[3], vst[3];
#define ATT_FETCH(id_) do { const int n_ = 1 + ((id_) >> 3), g_ = ((id_) >> 1) & 3, kbase_ = 128 * (n_ - 1) + 64 * ((id_) & 1); \
        _Pragma("unroll") for (int i = 0; i < 3; ++i) { const int ch = tid + 512 * i; \
            { const int row = ch >> 3, c = ch & 7; kst[i] = *(const u32x4*)(Kb + (size_t)(kbase_ + row) * 256 + g_ * 64 + c * 8); } \
            { const int d = ch / 24, c = ch - d * 24; vst[i] = *(const u32x4*)(Vt + (size_t)(g_ * 64 + d) * MROWS + kbase_ + c * 8); } } \
        } while (0)
    int id = id0;
    if (id < idEnd) ATT_FETCH(id);
    for (; id < idEnd; id += G) {
        const int n = 1 + (id >> 3), g = (id >> 1) & 3, half = id & 1;
        const int kbase = 128 * (n - 1) + 64 * half;
#pragma unroll
        for (int i = 0; i < 3; ++i) {
            const int ch = tid + 512 * i;
            { const int row = ch >> 3, c = ch & 7; *(LAS u32x4*)(Ks + row * 144 + c * 16) = kst[i]; }
            { const int d = ch / 24, c = ch - d * 24; LAS u32x2* p = (LAS u32x2*)(Vs + d * 392 + c * 16); p[0] = (u32x2){vst[i].x, vst[i].y}; p[1] = (u32x2){vst[i].z, vst[i].w}; }
        }
        const int hq = 4 * g + (wid >> 1);
        const int qrow = kbase + 128 + i0 + ql;
        bf16x8 qr[4];
#pragma unroll
        for (int d0 = 0; d0 < 4; ++d0) qr[d0] = *(const bf16x8*)(QA + (size_t)qrow * DM + 64 * hq + 16 * d0 + 8 * hi);
        const float sink2 = sinks[hq] * LOG2E;
        __syncthreads();
        u32x2 zz[2][4];
#pragma unroll
        for (int blk = 0; blk < 2; ++blk)
#pragma unroll
            for (int rr = 0; rr < 4; ++rr) zz[blk][rr] = *(const u32x2*)(SZA + (size_t)qrow * DM + 64 * hq + 32 * blk + 8 * rr + 4 * hi);
        if (id + G < idEnd) ATT_FETCH(id + G);
        const int minkr = R_META - (kbase + i0);
        float mrun = sink2, lrun = hi ? 0.f : 1.f;
        f32x16 O[2]; O[0] = (f32x16){}; O[1] = (f32x16){};
#pragma unroll
        for (int kb = 0; kb < 5; ++kb) {
            f32x16 S = (f32x16){};
#pragma unroll
            for (int d0 = 0; d0 < 4; ++d0) { const bf16x8 a = *(const LAS bf16x8*)(Ks + (i0 + 32 * kb + ql) * 144 + (16 * d0 + 8 * hi) * 2); S = __builtin_amdgcn_mfma_f32_32x32x16_bf16(a, qr[d0], S, 0, 0, 0); }
            if (kb == 0) {
#pragma unroll
                for (int r = 0; r < 16; ++r) if (crow(r, hi) < ql) S[r] = -INFINITY;
            }
            if (kb == 4) {
#pragma unroll
                for (int r = 0; r < 16; ++r) if (crow(r, hi) > ql) S[r] = -INFINITY;
            }
            if (minkr > 32 * kb) {
#pragma unroll
                for (int r = 0; r < 16; ++r) if (32 * kb + crow(r, hi) < minkr) S[r] = -INFINITY;
            }
            float mb = S[0];
#pragma unroll
            for (int r = 1; r < 16; ++r) mb = fmaxf(mb, S[r]);
            mb = fmaxf(mb, __shfl_xor(mb, 32));
            const float mn = fmaxf(mrun, mb), alpha = __builtin_amdgcn_exp2f(mrun - mn); mrun = mn;
            float ps = 0.f;
#pragma unroll
            for (int r = 0; r < 16; ++r) { const float p = __builtin_amdgcn_exp2f(S[r] - mn); S[r] = p; ps += p; }
            lrun = lrun * alpha + ps;
            O[0] = O[0] * alpha; O[1] = O[1] * alpha;
#pragma unroll
            for (int s = 0; s < 2; ++s) {
                const bf16x8 pb = packp(S, s);
#pragma unroll
                for (int blk = 0; blk < 2; ++blk) {
                    const LAS unsigned char* vp = Vs + (32 * blk + ql) * 392 + (i0 + 32 * kb + 16 * s + 4 * hi) * 2;
                    const u32x2 lo = *(const LAS u32x2*)vp, hh = *(const LAS u32x2*)(vp + 16);
                    const u32x4 av = {lo.x, lo.y, hh.x, hh.y};
                    O[blk] = __builtin_amdgcn_mfma_f32_32x32x16_bf16(__builtin_bit_cast(bf16x8, av), pb, O[blk], 0, 0, 0);
                }
            }
        }
        lrun += __shfl_xor(lrun, 32);
        const float inv_l = 1.0f / lrun;
#pragma unroll
        for (int blk = 0; blk < 2; ++blk)
#pragma unroll
            for (int rr = 0; rr < 4; ++rr) {
                const size_t off = (size_t)qrow * DM + 64 * hq + 32 * blk + 8 * rr + 4 * hi; const u32x2 z = zz[blk][rr];
                u32x2 w; w.x = cvt_pk_bf16(O[blk][4 * rr] * inv_l * bf_lo(z.x), O[blk][4 * rr + 1] * inv_l * bf_hi(z.x)); w.y = cvt_pk_bf16(O[blk][4 * rr + 2] * inv_l * bf_lo(z.y), O[blk][4 * rr + 3] * inv_l * bf_hi(z.y));
                *(u32x2*)(QA + off) = w;
            }
        __syncthreads();
    }
#undef ATT_FETCH
}

__device__ __forceinline__ bf16x8 cvt8(const f32x4 a, const f32x4 b) { return __builtin_bit_cast(bf16x8, pack8(a, b)); }

__device__ __forceinline__ void attn_sample_unit(int b, int g, int hh, int lane, const float* ck, const float* cv, const bf16_t* Kb, const bf16_t* Vt, bf16_t* QA, const bf16_t* SZA, const float* sinks, float* out) {
    const int ql = lane & 31, hi = lane >> 5, t = ql & 7; const bool cp = (hh == 0);
    const int row = R_SAMPLE + 8 * b + t, head = 4 * g + hh;
    bf16x8 qr[4];
#pragma unroll
    for (int d0 = 0; d0 < 4; ++d0) qr[d0] = *(const bf16x8*)(QA + (size_t)row * DM + 64 * head + 16 * d0 + 8 * hi);
    const float sink2 = sinks[head] * LOG2E;
    const float* ckb = ck + (size_t)b * 128 * 256 + g * 64; const float* cvb = cv + (size_t)b * 128 * 256 + g * 64;
    float* oks = out + O_NKS + (size_t)b * 128 * 256 + g * 64; float* ovs = out + O_NVS + (size_t)b * 128 * 256 + g * 64;
    float m = sink2, l = hi ? 0.f : 1.f;
    f32x16 O[2]; O[0] = (f32x16){}; O[1] = (f32x16){};
    const float NEG = -INFINITY;
#pragma unroll 1
    for (int kb = 0; kb < 5; ++kb) {
        f32x16 S = (f32x16){};
        if (kb < 4) {
            const int s = 32 * kb + ql;
#pragma unroll
            for (int d0 = 0; d0 < 4; ++d0) {
                const float* p = ckb + (size_t)s * 256 + 16 * d0 + 8 * hi; const f32x4 x0 = *(const f32x4*)p, x1 = *(const f32x4*)(p + 4);
                if (cp && s >= 8) { float* o = oks + (size_t)(s - 8) * 256 + 16 * d0 + 8 * hi; *(f32x4*)o = x0; *(f32x4*)(o + 4) = x1; }
                S = __builtin_amdgcn_mfma_f32_32x32x16_bf16(cvt8(x0, x1), qr[d0], S, 0, 0, 0);
            }
        } else {
#pragma unroll
            for (int d0 = 0; d0 < 4; ++d0) {
                u32x4 kv = {0u, 0u, 0u, 0u};
                if (ql < 8) kv = *(const u32x4*)(Kb + (size_t)(R_SAMPLE + 8 * b + ql) * 256 + g * 64 + 16 * d0 + 8 * hi);
                S = __builtin_amdgcn_mfma_f32_32x32x16_bf16(__builtin_bit_cast(bf16x8, kv), qr[d0], S, 0, 0, 0);
            }
        }
        if (kb == 0) {
#pragma unroll
            for (int r = 0; r < 16; ++r) if (crow(r, hi) < t) S[r] = NEG;
        }
        if (kb == 4) {
#pragma unroll
            for (int r = 0; r < 16; ++r) if (crow(r, hi) > t) S[r] = NEG;
        }
        float mb = S[0];
#pragma unroll
        for (int r = 1; r < 16; ++r) mb = fmaxf(mb, S[r]);
        mb = fmaxf(mb, __shfl_xor(mb, 32));
        const float mn = fmaxf(m, mb), alpha = __builtin_amdgcn_exp2f(m - mn); m = mn;
        float ps = 0.f;
#pragma unroll
        for (int r = 0; r < 16; ++r) { const float p = __builtin_amdgcn_exp2f(S[r] - mn); S[r] = p; ps += p; }
        l = l * alpha + ps;
        O[0] = O[0] * alpha; O[1] = O[1] * alpha;
        if (kb < 4) {
#pragma unroll
            for (int s2 = 0; s2 < 2; ++s2) {
                const bf16x8 pb = packp(S, s2);
#pragma unroll
                for (int blk = 0; blk < 2; ++blk) {
                    const int d = 32 * blk + ql;
                    f32x4 v0, v1;
                    const int kk = 32 * kb + 16 * s2 + 4 * hi;
                    const float* vsrc = cvb + (size_t)kk * 256 + d; float* vdst = ovs + (size_t)kk * 256 + d - 8 * 256;
                    v0.x = vsrc[0]; v0.y = vsrc[256]; v0.z = vsrc[512]; v0.w = vsrc[768]; v1.x = vsrc[2048]; v1.y = vsrc[2304]; v1.z = vsrc[2560]; v1.w = vsrc[2816];
                    if (cp && kk >= 8) { vdst[0] = v0.x; vdst[256] = v0.y; vdst[512] = v0.z; vdst[768] = v0.w; }
                    if (cp) { vdst[2048] = v1.x; vdst[2304] = v1.y; vdst[2560] = v1.z; vdst[2816] = v1.w; }
                    O[blk] = __builtin_amdgcn_mfma_f32_32x32x16_bf16(cvt8(v0, v1), pb, O[blk], 0, 0, 0);
                }
            }
        } else {
            const bf16x8 pb = packp(S, 0);
#pragma unroll
            for (int blk = 0; blk < 2; ++blk) {
                const int d = 32 * blk + ql;
                const u32x2 lo = *(const u32x2*)(Vt + (size_t)(g * 64 + d) * MROWS + R_SAMPLE + 8 * b + 4 * hi);
                const u32x4 av = {lo.x, lo.y, 0u, 0u};
                O[blk] = __builtin_amdgcn_mfma_f32_32x32x16_bf16(__builtin_bit_cast(bf16x8, av), pb, O[blk], 0, 0, 0);
            }
        }
    }
    l += __shfl_xor(l, 32);
    if (ql < 8) attn_store(O, 1.0f / l, row, head, hi, SZA, QA);
}

__device__ __forceinline__ void attn_sample_wg(LAS unsigned char* lds, int tid, int id, const float* ck, const float* cv, const bf16_t* Kb, const bf16_t* Vt, bf16_t* QA, const bf16_t* SZA, const float* sinks, float* out) {
    const int lane = tid & 63, wid = __builtin_amdgcn_readfirstlane(tid >> 6), ql = lane & 31, hi = lane >> 5, t = ql & 7;
    const int b = id >> 1, gp = id & 1;
    constexpr int KSG = 160 * 144, VSG = 64 * 328;
    LAS unsigned char* Ks = lds; LAS unsigned char* Vs = lds + 2 * KSG;
    const float* ckb = ck + (size_t)b * 128 * 256 + gp * 128; const float* cvb = cv + (size_t)b * 128 * 256 + gp * 128;
    float* oks = out + O_NKS + (size_t)b * 128 * 256 + gp * 128; float* ovs = out + O_NVS + (size_t)b * 128 * 256 + gp * 128;
#pragma unroll
    for (int i = 0; i < 8; ++i) {
        const int idx = tid + 512 * i, srow = idx >> 5, c4 = idx & 31, gl = c4 >> 4, d = (c4 & 15) * 4;
        const f32x4 k4 = *(const f32x4*)(ckb + (size_t)srow * 256 + c4 * 4), v4 = *(const f32x4*)(cvb + (size_t)srow * 256 + c4 * 4);
        if (srow >= 8) { __builtin_nontemporal_store(k4, (f32x4*)(oks + (size_t)(srow - 8) * 256 + c4 * 4)); __builtin_nontemporal_store(v4, (f32x4*)(ovs + (size_t)(srow - 8) * 256 + c4 * 4)); }
        u32x2 kw; kw.x = cvt_pk_bf16(k4.x, k4.y); kw.y = cvt_pk_bf16(k4.z, k4.w);
        *(LAS u32x2*)(Ks + gl * KSG + srow * 144 + d * 2) = kw;
        const unsigned v01 = cvt_pk_bf16(v4.x, v4.y), v23 = cvt_pk_bf16(v4.z, v4.w);
        LAS bf16_t* vp = (LAS bf16_t*)(Vs + gl * VSG + d * 328 + srow * 2);
        vp[0] = (bf16_t)(v01 & 0xffffu); vp[164] = (bf16_t)(v01 >> 16); vp[328] = (bf16_t)(v23 & 0xffffu); vp[492] = (bf16_t)(v23 >> 16);
    }
    if (tid < 128) {
        const int j = tid >> 4, c8 = tid & 15, gl = c8 >> 3, d = (c8 & 7) * 8;
        *(LAS u32x4*)(Ks + gl * KSG + (128 + j) * 144 + d * 2) = *(const u32x4*)(Kb + (size_t)(R_SAMPLE + 8 * b + j) * 256 + (2 * gp + gl) * 64 + d);
    } else if (tid < 256) {
        const int gl = (tid - 128) >> 6, d = (tid - 128) & 63;
        const u32x4 v = *(const u32x4*)(Vt + (size_t)((2 * gp + gl) * 64 + d) * MROWS + R_SAMPLE + 8 * b);
        LAS u32x2* p = (LAS u32x2*)(Vs + gl * VSG + d * 328 + 256); p[0] = (u32x2){v.x, v.y}; p[1] = (u32x2){v.z, v.w};
    } else if (tid < 384) {
        const int gl = (tid - 256) >> 6, d = (tid - 256) & 63;
        LAS u32x2* p = (LAS u32x2*)(Vs + gl * VSG + d * 328 + 272);
#pragma unroll
        for (int q = 0; q < 6; ++q) p[q] = (u32x2){0u, 0u};
    }
    const int gl = wid >> 2, hh = wid & 3, head = 4 * (2 * gp + gl) + hh, row = R_SAMPLE + 8 * b + t;
    bf16x8 qr[4];
#pragma unroll
    for (int d0 = 0; d0 < 4; ++d0) qr[d0] = *(const bf16x8*)(QA + (size_t)row * DM + 64 * head + 16 * d0 + 8 * hi);
    const float sink2 = sinks[head] * LOG2E;
    __syncthreads();
    const LAS unsigned char* Kg = Ks + gl * KSG; const LAS unsigned char* Vg = Vs + gl * VSG;
    f32x16 S[5];
#pragma unroll
    for (int kb = 0; kb < 5; ++kb) {
        S[kb] = (f32x16){};
#pragma unroll
        for (int d0 = 0; d0 < 4; ++d0) { const bf16x8 a = *(const LAS bf16x8*)(Kg + (32 * kb + ql) * 144 + (16 * d0 + 8 * hi) * 2); S[kb] = __builtin_amdgcn_mfma_f32_32x32x16_bf16(a, qr[d0], S[kb], 0, 0, 0); }
    }
    const float inv_l = sink_softmax5(S, t, hi, sink2, 0);
    f32x16 O[2]; O[0] = (f32x16){}; O[1] = (f32x16){};
#pragma unroll
    for (int kb = 0; kb < 5; ++kb)
#pragma unroll
        for (int s2 = 0; s2 < 2; ++s2) {
            const bf16x8 pb = packp(S[kb], s2);
#pragma unroll
            for (int blk = 0; blk < 2; ++blk) {
                const LAS unsigned char* vp = Vg + (32 * blk + ql) * 328 + (32 * kb + 16 * s2 + 4 * hi) * 2;
                const u32x2 lo = *(const LAS u32x2*)vp, h2 = *(const LAS u32x2*)(vp + 16);
                const u32x4 av = {lo.x, lo.y, h2.x, h2.y};
                O[blk] = __builtin_amdgcn_mfma_f32_32x32x16_bf16(__builtin_bit_cast(bf16x8, av), pb, O[blk], 0, 0, 0);
            }
        }
    if (ql < 8) attn_store(O, inv_l, row, head, hi, SZA, QA);
    __syncthreads();
}

__device__ __forceinline__ void conv_pass(int gtid, int nthr, int item_lo, int item_hi, const bf16_t* U, bf16_t* BZ, const float* cw, const float* state) {
    const int ch = (gtid & 127) * 8;
    float w0[8], w1[8], w2[8];
#pragma unroll
    for (int e = 0; e < 8; ++e) { w0[e] = cw[ch + e]; w1[e] = cw[DM + ch + e]; w2[e] = cw[2 * DM + ch + e]; }
    for (int item = item_lo + (gtid >> 7); item < item_hi; item += nthr >> 7) {
        const int r0 = R_PROMPT + 8 * item;
        float um2[8], um1[8];
        if (r0 < R_SAMPLE) {
            const u32x4 a = *(const u32x4*)(U + (size_t)(r0 - 2) * DM + ch), b = *(const u32x4*)(U + (size_t)(r0 - 1) * DM + ch);
            um2[0] = bf_lo(a.x); um2[1] = bf_hi(a.x); um2[2] = bf_lo(a.y); um2[3] = bf_hi(a.y); um2[4] = bf_lo(a.z); um2[5] = bf_hi(a.z); um2[6] = bf_lo(a.w); um2[7] = bf_hi(a.w);
            um1[0] = bf_lo(b.x); um1[1] = bf_hi(b.x); um1[2] = bf_lo(b.y); um1[3] = bf_hi(b.y); um1[4] = bf_lo(b.z); um1[5] = bf_hi(b.z); um1[6] = bf_lo(b.w); um1[7] = bf_hi(b.w);
        } else {
            const float* st = state + (size_t)((r0 - R_SAMPLE) >> 3) * 2 * DM + ch;
#pragma unroll
            for (int e = 0; e < 8; ++e) { um2[e] = st[e]; um1[e] = st[DM + e]; }
        }
#pragma unroll
        for (int i = 0; i < 8; ++i) {
            const size_t off = (size_t)(r0 + i) * DM + ch;
            const u32x4 a = *(const u32x4*)(U + off), z = *(const u32x4*)(BZ + off);
            float uc[8], bz[8], o[8];
            uc[0] = bf_lo(a.x); uc[1] = bf_hi(a.x); uc[2] = bf_lo(a.y); uc[3] = bf_hi(a.y); uc[4] = bf_lo(a.z); uc[5] = bf_hi(a.z); uc[6] = bf_lo(a.w); uc[7] = bf_hi(a.w);
            bz[0] = bf_lo(z.x); bz[1] = bf_hi(z.x); bz[2] = bf_lo(z.y); bz[3] = bf_hi(z.y); bz[4] = bf_lo(z.z); bz[5] = bf_hi(z.z); bz[6] = bf_lo(z.w); bz[7] = bf_hi(z.w);
#pragma unroll
            for (int e = 0; e < 8; ++e) { o[e] = bz[e] * (w0[e] * um2[e] + w1[e] * um1[e] + w2[e] * uc[e]); um2[e] = um1[e]; um1[e] = uc[e]; }
            u32x4 w; w.x = cvt_pk_bf16(o[0], o[1]); w.y = cvt_pk_bf16(o[2], o[3]); w.z = cvt_pk_bf16(o[4], o[5]); w.w = cvt_pk_bf16(o[6], o[7]);
            *(u32x4*)(BZ + off) = w;
        }
    }
}


#define XB_TMO      128
#define XB_XCNT(j)  (256  + 64 * (j))
#define XB_XSUB(j)  (1280 + 64 * (j))
#define XB_XGEN(j)  (2304 + 64 * (j))
#define XB_TOP      3328
#define XB_TOPGEN   3392
#define XCD_BAR_WORDS 3456
#define XB_SPIN_CAP (1u << 18)
__device__ __forceinline__ unsigned xb_xcc_id() { return (unsigned)__builtin_amdgcn_s_getreg((3 << 11) | 20) & 0xFu; }
#define XB_SPIN(cond, bar) do { unsigned _sp = 0; while (cond) { __builtin_amdgcn_s_sleep(1); \
    if ((++_sp & 255u) == 0u) { if (xb_ld(&(bar)[XB_TMO])) break; if (_sp > XB_SPIN_CAP) { atomicAdd(&(bar)[XB_TMO], 1u); break; } } } } while (0)
struct XcdBarrier { unsigned* bar; unsigned x; volatile LAS unsigned* st; };
__device__ __forceinline__ XcdBarrier xcd_barrier_post(unsigned* bar, volatile LAS unsigned* st) {
    XcdBarrier b; b.bar = bar; b.x = xb_xcc_id(); b.st = st;
    if (threadIdx.x == 0) (void)xb_add(&bar[XB_XCNT(b.x)], 1u);
    return b;
}
__device__ __forceinline__ void xcd_barrier_complete(unsigned* bar, unsigned x, unsigned& nloc, unsigned& nx) {
    const unsigned G = gridDim.x * gridDim.y * gridDim.z;
    unsigned sum, cnt, mine, sp = 0u;
    for (;;) {
        sum = 0u; cnt = 0u; mine = 0u;
#pragma unroll
        for (unsigned j = 0; j < 16; ++j) { const unsigned c = xb_ld(&bar[XB_XCNT(j)]); sum += c; cnt += (c > 0u) ? 1u : 0u; mine = (j == x) ? c : mine; }
        if (sum == G) break;
        __builtin_amdgcn_s_sleep(1);
        if ((++sp & 255u) == 0u) { if (xb_ld(&bar[XB_TMO])) break; if (sp > XB_SPIN_CAP) { atomicAdd(&bar[XB_TMO], 1u); break; } }
    }
    nloc = mine > 0u ? mine : 1u; nx = cnt > 0u ? cnt : 1u;
}
__device__ __forceinline__ void xcd_barrier(const XcdBarrier& b) {
    asm volatile("s_waitcnt vmcnt(0)" ::: "memory");
    __syncthreads();
    if (threadIdx.x == 0) {
        unsigned* bar = b.bar;
        __builtin_amdgcn_s_waitcnt(0);
        unsigned nloc = b.st[0], nx = b.st[1];
        if (nloc == 0u) { xcd_barrier_complete(bar, b.x, nloc, nx); b.st[0] = nloc; b.st[1] = nx; }
        const unsigned old = xb_add(&bar[XB_XSUB(b.x)], 1u);
        const unsigned gen = old / nloc;
        if (old + 1u == (gen + 1u) * nloc) {
            __builtin_amdgcn_fence(__ATOMIC_RELEASE, "agent");
            asm volatile("s_waitcnt vmcnt(0)" ::: "memory");
            const unsigned og = xb_add(&bar[XB_TOP], 1u);
            const unsigned tg = og / nx;
            if (og + 1u == (tg + 1u) * nx) xb_add(&bar[XB_TOPGEN], 1u);
            else XB_SPIN(xb_ld(&bar[XB_TOPGEN]) == tg, bar);
            __builtin_amdgcn_fence(__ATOMIC_ACQUIRE, "agent");
            xb_add(&bar[XB_XGEN(b.x)], 1u);
            asm volatile("s_waitcnt vmcnt(0)" ::: "memory");
        } else {
            XB_SPIN(xb_ld(&bar[XB_XGEN(b.x)]) == gen, bar);
            __builtin_amdgcn_fence(__ATOMIC_ACQUIRE, "agent");
            asm volatile("s_waitcnt vmcnt(0)" ::: "memory");
        }
    }
    __syncthreads();
}

__device__ __forceinline__ void sub_barrier(unsigned* word, unsigned nwg) {
    asm volatile("s_waitcnt vmcnt(0)" ::: "memory");
    __syncthreads();
    if (threadIdx.x == 0) {
        __builtin_amdgcn_s_waitcnt(0);
        __builtin_amdgcn_fence(__ATOMIC_RELEASE, "agent");
        asm volatile("s_waitcnt vmcnt(0)" ::: "memory");
        xb_add(word, 1u);
        unsigned sp = 0; while (xb_ld(word) < nwg) { __builtin_amdgcn_s_sleep(1); if (++sp > (1u << 22)) break; }
        __builtin_amdgcn_fence(__ATOMIC_ACQUIRE, "agent");
        asm volatile("s_waitcnt vmcnt(0)" ::: "memory");
    }
    __syncthreads();
}

typedef const __attribute__((address_space(4))) Args* CArgs;
__device__ __forceinline__ CArgs fresh_args() { CArgs p = (CArgs)__builtin_amdgcn_kernarg_segment_ptr(); asm volatile("" : "+s"(p)); return p; }
#define PTRS() CArgs A = fresh_args(); unsigned char* ws = A->ws; \
    bf16_t* XN = (bf16_t*)(ws + WS_B0); bf16_t* QA = (bf16_t*)(ws + WS_QA); bf16_t* BZ = (bf16_t*)(ws + WS_BZ); bf16_t* SZA = (bf16_t*)(ws + WS_SZA); \
    bf16_t* Ub = (bf16_t*)(ws + WS_U); bf16_t* SGB = (bf16_t*)(ws + WS_SGB); bf16_t* Kb = (bf16_t*)(ws + WS_K); bf16_t* Vt = (bf16_t*)(ws + WS_VT); \
    bf16_t* SGA = (bf16_t*)A->out; float* rope = (float*)(ws + WS_ROPE); \
    (void)XN; (void)QA; (void)BZ; (void)SZA; (void)Ub; (void)SGB; (void)Kb; (void)Vt; (void)SGA; (void)rope
#define G2_DECL() const pg8::Gemm g2{QA + (size_t)R_PROMPT * DM, (const bf16_t*)(ws + WS_WA), M23, DM, DM, BUFB, 2097152}; const Epi2 E2{SGA + (size_t)R_PROMPT * DM, SGB + (size_t)R_PROMPT * DM, XN}
#define G3_DECL() const pg8::Gemm g3{XN, (const bf16_t*)(ws + WS_WO), M23, DM, DM, 0, 0}; const Epi3 E3{A->in[0], A->in[1], A->out + O_Y}
__global__ void __launch_bounds__(512, 2) hybrid_fwd(Args a_unused) {
    extern __shared__ __attribute__((aligned(16))) unsigned char lds_raw[];
    LAS unsigned char* lds = (LAS unsigned char*)lds_raw;
    const int G = gridDim.x;
#define TIDS() int tid = threadIdx.x; asm volatile("" : "+v"(tid)); const int lane = tid & 63, wave = __builtin_amdgcn_readfirstlane(tid >> 6); (void)lane; (void)wave
#define GSYNC() xcd_barrier(xbar)
    volatile LAS unsigned* MISC = (volatile LAS unsigned*)(lds + 131072);
    if (threadIdx.x < 4) MISC[threadIdx.x] = 0u;
    __syncthreads();
    XcdBarrier xbar;
    { CArgs A = fresh_args(); xbar = xcd_barrier_post((unsigned*)(A->ws + WS_CTL), MISC);
      if (A->ph_lo > 1000) cg::this_grid().sync(); }
    unsigned long long pt0 = 0, pt1 = 0; (void)pt0; (void)pt1;
#define PSTAMP0(k) do { if (PROBE_PH == (k)) pt0 = __builtin_amdgcn_s_memrealtime(); } while (0)
#define PSTAMP1(k) do { if (PROBE_PH == (k)) pt1 = __builtin_amdgcn_s_memrealtime(); } while (0)
    const bool split = (G == 256);
    constexpr int NSPL = 16;
    PSTAMP0(0);
    { TIDS(); CArgs A = fresh_args(); Args pa; pa.in[0] = A->in[0]; pa.in[1] = A->in[1]; pa.in[5] = A->in[5]; pa.in[6] = A->in[6]; pa.in[7] = A->in[7]; pa.in[12] = A->in[12]; pa.in[13] = A->in[13]; pa.in[14] = A->in[14]; pa.ws = A->ws; p0_prologue(pa, lds, tid, lane, wave, G); }
    GSYNC();
    PSTAMP1(0); PSTAMP0(1);
    {
        PTRS();
        pg8::Gemm g{XN, (const bf16_t*)(ws + WS_WIN), MROWS, NIN, DM, 0, 0}; pg8::StaticOrder S; S.init(MROWS, NIN, G, (int)blockIdx.x, 1); S.special = split ? 1 : 0;
        Epi1 E{QA, Kb, Vt, SZA, BZ, Ub, SGA, SGB, rope, A->in[8], A->in[9], A->out};
        pg8::gemm_phase<Epi1>(lds, g, S, E);
    }
    GSYNC();
    PSTAMP1(1); PSTAMP0(2);
    {
        TIDS(); PTRS();
        for (int id = blockIdx.x; id < 256; id += G) attn_sample_wg(lds, tid, id, A->in[2], A->in[3], Kb, Vt, QA, SZA, A->in[10], A->out);
        conv_pass(blockIdx.x * 512 + tid, G * 512, 2048, M23 / 8, Ub, BZ, A->in[11], A->in[4]);
    }
    GSYNC();
    PSTAMP1(2); PSTAMP0(3); if (PROBE_PH == 6) pt0 = __builtin_amdgcn_s_memrealtime();
    if (split && blockIdx.x < 2 * NSPL) {
        const int c = (int)blockIdx.x, tj = c & (NSPL - 1);
#define SPL_PTRS() PTRS(); float* scr1 = (float*)(ws + WS_B0) + (size_t)tj * 65536; float* scr2 = (float*)(ws + WS_B0) + (size_t)(NSPL + tj) * 65536; \
        unsigned* cnt1 = (unsigned*)(ws + WS_CTL) + 9216 + 64 * tj; unsigned* cnt2 = (unsigned*)(ws + WS_CTL) + 10240 + 64 * tj; unsigned* bar32 = (unsigned*)(ws + WS_CTL) + 8192; \
        (void)scr1; (void)scr2; (void)cnt1; (void)cnt2; (void)bar32
        if (c < NSPL) {
            { SPL_PTRS(); const pg8::Gemm ga{QA + (size_t)R_PROMPT * DM, (const bf16_t*)(ws + WS_WA), M23, DM, DM, 0, 0, 0};
              const EpiPart<true> Ea{SGA + (size_t)R_PROMPT * DM, scr1, SGB + (size_t)R_PROMPT * DM};
              pg8::StaticOrder S; S.init(M23, DM, G, c, 1, 256 + tj); pg8::gemm_phase<EpiPart<true>>(lds, ga, S, Ea); publish_count(cnt1); }
            { SPL_PTRS(); sub_barrier(bar32, 2 * NSPL); }
            { SPL_PTRS(); const pg8::Gemm g3a{XN, (const bf16_t*)(ws + WS_WO), M23, DM, 512, 0, 0, DM};
              const EpiPart<false> Ea{nullptr, scr2, nullptr};
              pg8::StaticOrder S; S.init(M23, DM, G, c, 1, 256 + tj); pg8::gemm_phase<EpiPart<false>>(lds, g3a, S, Ea); publish_count(cnt2); }
        } else {
            { SPL_PTRS(); const pg8::Gemm gb{BZ + (size_t)R_PROMPT * DM, (const bf16_t*)(ws + WS_WB), M23, DM, DM, 0, 0, 0};
              const Epi2b Eb{SGB + (size_t)R_PROMPT * DM, scr1, XN, cnt1};
              pg8::StaticOrder S; S.init(M23, DM, G, c, 1, 256 + tj); pg8::gemm_phase<Epi2b>(lds, gb, S, Eb); }
            { SPL_PTRS(); sub_barrier(bar32, 2 * NSPL); }
            { SPL_PTRS(); const pg8::Gemm g3b{XN + 512, (const bf16_t*)(ws + WS_WO) + 512, M23, DM, 512, 0, 0, DM};
              const Epi3b Eb{A->in[0], A->in[1], A->out + O_Y, scr2, cnt2};
              pg8::StaticOrder S; S.init(M23, DM, G, c, 1, 256 + tj); pg8::gemm_phase<Epi3b>(lds, g3b, S, Eb); }
        }
#undef SPL_PTRS
    } else {
        TIDS(); PTRS();
        const int vc = split ? (int)blockIdx.x - 2 * NSPL : (int)blockIdx.x, VG = split ? G - 2 * NSPL : G;
        if (split) {
            const int nd = vc < 150 ? 1 : 2, j0 = vc < 150 ? vc : 150 + 2 * (vc - 150);
            for (int k = 0; k < nd; ++k) {
                const int j = j0 + k, q = j - 2, dpm = j < 2 ? 26 : 27 + (q >> 3), dpn = j < 2 ? 32 + j : 26 + (q & 7);
                pg8::Gemm g{XN, (const bf16_t*)(ws + WS_WIN), MROWS, NIN, DM, 0, 0}; pg8::StaticOrder S; S.init(MROWS, NIN, G, (int)blockIdx.x, 1, dpm * 34 + dpn);
                Epi1 E{QA, Kb, Vt, SZA, BZ, Ub, SGA, SGB, rope, A->in[8], A->in[9], A->out};
                pg8::gemm_phase<Epi1>(lds, g, S, E);
            }
        }
        {
            const int a0 = !split ? vc : (vc < 150 ? 5 * vc : (vc < 172 ? 750 + 3 * (vc - 150) : 816 + 4 * (vc - 172))), na = vc < 150 ? 5 : (vc < 172 ? 3 : 4);
            attn_prompt_all(lds, tid, a0, split ? 1 : VG, split ? a0 + na : 1024, Kb, Vt, QA, SZA, A->in[10]);
        }
        { int tid2 = threadIdx.x; asm volatile("" : "+v"(tid2)); conv_pass(vc * 512 + tid2, VG * 512, 0, 2048, Ub, BZ, A->in[11], A->in[4]); }
    }
    if (PROBE_PH == 6) pt1 = __builtin_amdgcn_s_memrealtime();
    GSYNC();
    PSTAMP1(3); PSTAMP0(4);
    { PTRS(); G2_DECL(); pg8::StaticOrder S; S.init(split ? 16384 : M23, DM, G, (int)blockIdx.x, 2); pg8::gemm_phase<Epi2>(lds, g2, S, E2); }
    GSYNC();
#if REP_MASK & 8
    { PTRS(); G2_DECL(); pg8::StaticOrder S; S.init(split ? 16384 : M23, DM, G, (int)blockIdx.x, 2); pg8::gemm_phase<Epi2>(lds, g2, S, E2); }
    GSYNC();
#endif
    PSTAMP1(4); PSTAMP0(5);
    { PTRS(); G3_DECL(); pg8::StaticOrder S; S.init(split ? 16384 : M23, DM, G, (int)blockIdx.x, 1); pg8::gemm_phase<Epi3>(lds, g3, S, E3); }
#if REP_MASK & 16
    GSYNC();
    { PTRS(); G3_DECL(); pg8::StaticOrder S; S.init(split ? 16384 : M23, DM, G, (int)blockIdx.x, 1); pg8::gemm_phase<Epi3>(lds, g3, S, E3); }
#endif
    PSTAMP1(5);
    if (PROBE_PH >= 0 && blockIdx.x == PROBE_BLK) { const unsigned long long te = __builtin_amdgcn_s_memrealtime(); while (__builtin_amdgcn_s_memrealtime() - te < pt1 - pt0) __builtin_amdgcn_s_sleep(8); }
#undef GSYNC
}

#ifndef DBG_DUMP
#define DBG_DUMP 0
#endif
__global__ void dbg_dump(const bf16_t* src, float* dst, size_t n) {
    for (size_t i = (size_t)blockIdx.x * blockDim.x + threadIdx.x; i < n; i += (size_t)gridDim.x * blockDim.x) dst[i] = __uint_as_float((unsigned)src[i] << 16);
}
extern "C" void kernel_launch(void* const* d_in, const int* in_sizes, int n_in, void* d_out, int out_size, void* d_ws, size_t ws_size, hipStream_t stream) {
    static int grid = 0;
    if (grid == 0) {
        int dev = 0, cus = 0, per_cu = 0;
        if (n_in != 15 || ws_size < WS_END) { fprintf(stderr, "kernel_launch: unexpected inputs (n_in %d, ws %zu)\n", n_in, ws_size); grid = -1; return; }
        if (hipGetDevice(&dev) != hipSuccess || hipDeviceGetAttribute(&cus, hipDeviceAttributeMultiprocessorCount, dev) != hipSuccess) { grid = -1; return; }
        if (hipFuncSetAttribute((const void*)hybrid_fwd, hipFuncAttributeMaxDynamicSharedMemorySize, LDS_BYTES) != hipSuccess) { fprintf(stderr, "kernel_launch: hipFuncSetAttribute failed\n"); grid = -1; return; }
        if (hipOccupancyMaxActiveBlocksPerMultiprocessor(&per_cu, (const void*)hybrid_fwd, 512, LDS_BYTES) != hipSuccess || per_cu < 1) { fprintf(stderr, "kernel_launch: occupancy query gives %d\n", per_cu); per_cu = 1; }
        (void)hipGetLastError();
        grid = cus * 1;
    }
    if (grid < 0) return;
    Args a{};
    for (int i = 0; i < 15; ++i) a.in[i] = (const float*)d_in[i];
    a.out = (float*)d_out; a.ws = (unsigned char*)d_ws;
    if (hipMemsetAsync((char*)d_ws + WS_CTL, 0, CTL_BYTES, stream) != hipSuccess) { fprintf(stderr, "kernel_launch: memset of the barrier words failed\n"); return; }
    a.ph_lo = 0; a.ph_hi = 5;
    void* args[] = {&a};
    hipError_t e = hipLaunchCooperativeKernel((const void*)hybrid_fwd, dim3(grid), dim3(512), args, LDS_BYTES, stream);
    if (e != hipSuccess) fprintf(stderr, "cooperative launch failed: %s (grid %d)\n", hipGetErrorString(e), grid);
}
```

```cpp
#include <hip/hip_runtime.h>
#include <hip/hip_cooperative_groups.h>
#include <cstdio>
#include <cstdint>
namespace cg = cooperative_groups;

#ifndef CHAIN_LATE
#define CHAIN_LATE 0
#endif
#ifndef PROBE_BLK
#define PROBE_BLK 32
#endif
#ifndef PROBE_PH
#define PROBE_PH -1
#endif
#ifndef REP_MASK
#define REP_MASK 0
#endif
#ifndef DBG_NPH
#define DBG_NPH 5
#define DBG_DUMP 0
#endif
#ifndef MK_N_LAUNCHES
#define MK_N_LAUNCHES 1
#endif

#define LAS __attribute__((address_space(3)))
typedef unsigned short bf16_t;
typedef short bf16x8 __attribute__((ext_vector_type(8)));
typedef float f32x4 __attribute__((ext_vector_type(4)));
typedef float f32x16 __attribute__((ext_vector_type(16)));
typedef unsigned u32x4 __attribute__((ext_vector_type(4)));
typedef unsigned u32x2 __attribute__((ext_vector_type(2)));

constexpr int DM = 1024, NIN = 8704;
constexpr int R_META = 112, R_PROMPT = 128, R_SAMPLE = 16512, R_END = 17536, MROWS = 17664;
constexpr int M23 = 17408;
constexpr int NPOS = 16400;
constexpr float EPS = 1e-6f;
constexpr float LOG2E = 1.4426950408889634f;
constexpr float C2 = 0.125f * LOG2E;
constexpr size_t O_Y = 0, O_NKP = 17825792, O_NVP = 17858560, O_NCP = 17891328, O_NKS = 17893376, O_NVS = 22087680, O_NCS = 26281984;
constexpr size_t BUFB = (size_t)MROWS * DM * 2;
constexpr size_t WS_WIN = 0, WS_WA = (size_t)NIN * DM * 2, WS_WB = WS_WA + 2097152, WS_WO = WS_WB + 2097152;
constexpr size_t WS_B0 = 25165824;
constexpr size_t WS_QA = WS_B0 + BUFB, WS_BZ = WS_QA + BUFB, WS_SZA = WS_BZ + BUFB, WS_U = WS_SZA + BUFB, WS_SGB = WS_U + BUFB;
constexpr size_t WS_K = WS_SGB + BUFB, WS_VT = WS_K + (size_t)MROWS * 256 * 2, WS_ROPE = WS_VT + (size_t)MROWS * 256 * 2, WS_END = WS_ROPE + (size_t)NPOS * 64 * 4;
constexpr size_t WS_CTL = 265289728, CTL_BYTES = 65536;
static_assert(WS_END <= WS_CTL && WS_CTL + CTL_BYTES <= 268435456, "d_ws map");

constexpr int LDS_BYTES = 147456;

namespace pg8 {
constexpr int BM = 256, BK = 64, HALF = 128, HTB = HALF * BK * 2, STAGE_BYTES = 8 * HTB, NXCD = 8, WGM = 8;
__host__ __device__ __forceinline__ int lds_byte(int r, int c) { const int st = (r >> 4) * 2 + (c >> 5), rr = r & 15, cc = c & 31, ob = rr * 64 + cc * 2; return st * 1024 + (ob ^ (((ob >> 9) & 1) << 5)); }
__host__ __device__ __forceinline__ void stage_rc(int b, int& R, int& C) { const int st = b / 1024, sb = b % 1024, swz = sb ^ (((sb >> 9) & 1) << 5); R = (st >> 1) * 16 + swz / 64; C = (st & 1) * 32 + (swz % 64) / 2; }
__host__ __device__ __forceinline__ int perm32(int rho) { const int n = rho >> 4, i = rho & 15; return 8 * (i >> 2) + 4 * n + (i & 3); }

struct Unit { int pm, pn, part; };
struct Gemm { const bf16_t* A; const bf16_t* Bt; int M, N, K; size_t partA, partB; int ld; };

struct StaticOrder {
    int nM, nN, nwg, G, c, np, direct, special;
    __host__ __device__ void init(int M, int N, int G_, int c_, int np_, int direct_ = -1) { nM = M / BM; nN = N / BM; nwg = nM * nN; G = G_; c = c_; np = np_; direct = direct_; special = 0; }
    __host__ __device__ static void swz(int wgid, int nM_, int nN_, int& pm, int& pn) {
        const int nwg_ = nM_ * nN_;
        { const int q = nwg_ / NXCD, r = nwg_ % NXCD, xcd = wgid % NXCD, off = wgid / NXCD; wgid = (xcd < r ? xcd * (q + 1) : r * (q + 1) + (xcd - r) * q) + off; }
        const int nig = WGM * nN_, gid = wgid / nig, fm = gid * WGM, gsz = (nM_ - fm) < WGM ? (nM_ - fm) : WGM;
        pm = fm + ((wgid % nig) % gsz); pn = (wgid % nig) / gsz;
    }
    __host__ __device__ bool next(int i, Unit& u) const {
        const int it = (np == 2) ? (i >> 1) : i; u.part = (np == 2) ? (i & 1) : 0;
        if (direct >= 0) { if (it > 0) return false; u.pm = direct / nN; u.pn = direct % nN; return true; }
        const long L = (long)it * G + c;
        if (special) {
            if (L >= 2048) return false;
            int l = (int)L;
            if (l < 884) { swz(l, 26, 34, u.pm, u.pn); return true; } l -= 884;
            if (l < 1118) { swz(l, 43, 26, u.pm, u.pn); u.pm += 26; return true; } l -= 1118;
            if (l < 40) { u.pm = 64 + (l >> 3); u.pn = 26 + (l & 7); return true; } l -= 40;
            u.pm = 26; u.pn = 26 + l; return true;
        }
        if (L >= nwg) return false;
        swz((int)L, nM, nN, u.pm, u.pn); return true;
    }
};

typedef float f32x2_t __attribute__((ext_vector_type(2))); typedef __bf16 bf16x2_t __attribute__((ext_vector_type(2)));
__device__ __forceinline__ unsigned cvt_pk_bf16(float lo, float hi) { const f32x2_t v = {lo, hi}; const bf16x2_t b = __builtin_convertvector(v, bf16x2_t); return __builtin_bit_cast(unsigned, b); }

template <class Epi>
__device__ __forceinline__ void gemm_phase(LAS unsigned char* lds, const Gemm g, const StaticOrder& S, const Epi& E) {
    int tid_ = threadIdx.x; asm volatile("" : "+v"(tid_));
    const int tid = tid_, wid = __builtin_amdgcn_readfirstlane(tid >> 6), lane = tid & 63, wr = wid >> 2, wc = wid & 3, fr = lane & 15, fq = lane >> 4;
    const int K = g.ld ? g.ld : g.K, nt = g.K / BK;
    unsigned voffA[2], voffB[2];
#pragma unroll
    for (int i = 0; i < 2; ++i) { int R, C; stage_rc(tid * 16 + i * 8192, R, C); const int Rb = ((R & ~31) + perm32(R & 31));
        voffA[i] = (unsigned)(R * K + C) * 2u; voffB[i] = (unsigned)(Rb * K + C) * 2u; }
    const size_t kstep = (size_t)(BK * 2);
    const size_t hstep = (size_t)HALF * K * 2;
    const size_t tstep = 2 * hstep;
    const unsigned ldsw = (unsigned)wid * 1024u;
    const int aoff = lds_byte(wr * 64 + fr, fq * 8), boff = lds_byte(wc * 32 + fr, fq * 8);
#define PG8_SA(b, h) (((b) * 2 + (h)) * HTB)
#define PG8_SB(b, h) ((4 + (b) * 2 + (h)) * HTB)
#define PG8_STAGE(bufoff, gbase, voff) do { _Pragma("unroll") for (int _i = 0; _i < 2; ++_i) \
        __builtin_amdgcn_global_load_lds((const unsigned*)((const char*)(gbase) + (voff)[_i]), (LAS unsigned*)(lds + (bufoff) + ldsw + _i * 8192), 16, 0, 0); } while (0)
#define PG8_LDA(dst, b, h) do { _Pragma("unroll") for (int m = 0; m < 4; ++m) _Pragma("unroll") for (int k = 0; k < 2; ++k) dst[m][k] = *(const LAS bf16x8*)(lds + PG8_SA(b, h) + aoff + m * 2048 + k * 1024); } while (0)
#define PG8_LDB(dst, b, h) do { _Pragma("unroll") for (int n = 0; n < 2; ++n) _Pragma("unroll") for (int k = 0; k < 2; ++k) dst[n][k] = *(const LAS bf16x8*)(lds + PG8_SB(b, h) + boff + n * 2048 + k * 1024); } while (0)
#define PG8_MMA(ai, bj, At, Bt) do { __builtin_amdgcn_s_setprio(1); _Pragma("unroll") for (int m = 0; m < 4; ++m) _Pragma("unroll") for (int n = 0; n < 2; ++n) _Pragma("unroll") for (int k = 0; k < 2; ++k) \
        acc[ai][bj][m][n] = __builtin_amdgcn_mfma_f32_16x16x32_bf16(Bt[n][k], At[m][k], acc[ai][bj][m][n], 0, 0, 0); __builtin_amdgcn_s_setprio(0); } while (0)
#define PG8_WAIT_V(n) asm volatile("s_waitcnt vmcnt(" #n ")" ::: "memory")
#define PG8_WAIT_L(n) asm volatile("s_waitcnt lgkmcnt(" #n ")" ::: "memory")
#define PG8_BAR __builtin_amdgcn_s_barrier()
#define PG8_SCHED __builtin_amdgcn_sched_barrier(0)
    Unit cur, nxt; int ui = 0;
    if (!S.next(0, cur)) return;
    f32x4 acc[2][2][4][2];
#pragma unroll
    for (int a = 0; a < 2; ++a)
#pragma unroll
        for (int b = 0; b < 2; ++b)
#pragma unroll
            for (int m = 0; m < 4; ++m)
#pragma unroll
                for (int n = 0; n < 2; ++n) acc[a][b][m][n] = (f32x4){0.f, 0.f, 0.f, 0.f};
    bf16x8 At[4][2], B0[2][2], B1[2][2];
    const char* cA = (const char*)g.A + (size_t)cur.pm * tstep + (size_t)cur.part * g.partA; const char* cB = (const char*)g.Bt + (size_t)cur.pn * tstep + (size_t)cur.part * g.partB;
    PG8_STAGE(PG8_SB(0, 0), cB, voffB); PG8_STAGE(PG8_SB(0, 1), cB + hstep, voffB); PG8_STAGE(PG8_SA(0, 0), cA, voffA); PG8_STAGE(PG8_SA(0, 1), cA + hstep, voffA);
    if (wr == 1) PG8_BAR;
    PG8_WAIT_V(2); PG8_BAR;
    PG8_STAGE(PG8_SB(1, 0), cB + kstep, voffB); PG8_STAGE(PG8_SA(1, 0), cA + kstep, voffA); PG8_STAGE(PG8_SB(1, 1), cB + hstep + kstep, voffB);
    PG8_WAIT_V(6); PG8_BAR;
    for (;;) {
        const bool has_next = S.next(ui + 1, nxt);
        const char* nA = has_next ? (const char*)g.A + (size_t)nxt.pm * tstep + (size_t)nxt.part * g.partA : cA; const char* nB = has_next ? (const char*)g.Bt + (size_t)nxt.pn * tstep + (size_t)nxt.part * g.partB : cB;
        for (int t = 0; t < nt; t += 2) {
            const bool last = (t == nt - 2);
            const char* a1 = cA + (size_t)(t + 1) * kstep;
            const char* a2 = last ? nA : cA + (size_t)(t + 2) * kstep; const char* b2 = last ? nB : cB + (size_t)(t + 2) * kstep;
            const char* a3 = a2 + kstep; const char* b3 = b2 + kstep;
            PG8_LDB(B0, 0, 0); PG8_LDB(B1, 0, 1); PG8_SCHED; PG8_LDA(At, 0, 0); PG8_STAGE(PG8_SA(1, 1), a1 + hstep, voffA);
            PG8_WAIT_V(8); PG8_WAIT_L(0); PG8_BAR; PG8_MMA(0, 0, At, B0); PG8_MMA(0, 1, At, B1); PG8_BAR; PG8_SCHED;
            PG8_LDA(At, 0, 1); PG8_STAGE(PG8_SB(0, 0), b2, voffB); PG8_STAGE(PG8_SB(0, 1), b2 + hstep, voffB); PG8_STAGE(PG8_SA(0, 0), a2, voffA);
            PG8_WAIT_V(8); PG8_WAIT_L(0); PG8_BAR; PG8_MMA(1, 0, At, B0); PG8_MMA(1, 1, At, B1); PG8_BAR; PG8_SCHED;
            PG8_LDB(B0, 1, 0); PG8_LDB(B1, 1, 1); PG8_SCHED; PG8_LDA(At, 1, 0); PG8_STAGE(PG8_SA(0, 1), a2 + hstep, voffA);
            PG8_WAIT_V(8); PG8_WAIT_L(0); PG8_BAR; PG8_MMA(0, 0, At, B0); PG8_MMA(0, 1, At, B1); PG8_BAR; PG8_SCHED;
            PG8_LDA(At, 1, 1); PG8_STAGE(PG8_SB(1, 0), b3, voffB); PG8_STAGE(PG8_SB(1, 1), b3 + hstep, voffB); PG8_STAGE(PG8_SA(1, 0), a3, voffA);
            PG8_WAIT_V(8); PG8_WAIT_L(0); PG8_BAR; PG8_MMA(1, 0, At, B0); PG8_MMA(1, 1, At, B1); PG8_BAR; PG8_SCHED;
        }
        if (wr == 0) PG8_BAR;
        { Unit eu = cur; int ewr = wr, ewc = wc, efr = fr, efq = fq;
          asm volatile("" : "+s"(eu.pm), "+s"(eu.pn), "+s"(eu.part), "+s"(ewr), "+s"(ewc), "+v"(efr), "+v"(efq));
          E(acc, eu, ewr, ewc, efr, efq); }
        if (!has_next) break;
        if (!E.keep(cur)) {
#pragma unroll
        for (int a = 0; a < 2; ++a)
#pragma unroll
            for (int b = 0; b < 2; ++b)
#pragma unroll
                for (int m = 0; m < 4; ++m)
#pragma unroll
                    for (int n = 0; n < 2; ++n) acc[a][b][m][n] = (f32x4){0.f, 0.f, 0.f, 0.f};
        }
        cur = nxt; cA = nA; cB = nB; ++ui;
        if (wr == 1) PG8_BAR;
    }
    PG8_WAIT_V(0);
    PG8_BAR;
#undef PG8_SA
#undef PG8_SB
#undef PG8_STAGE
#undef PG8_LDA
#undef PG8_LDB
#undef PG8_MMA
#undef PG8_WAIT_V
#undef PG8_WAIT_L
#undef PG8_BAR
#undef PG8_SCHED
}
}
using pg8::cvt_pk_bf16;

__device__ __forceinline__ unsigned xb_ld(unsigned* p)              { return __hip_atomic_load(p, __ATOMIC_RELAXED, __HIP_MEMORY_SCOPE_AGENT); }
__device__ __forceinline__ unsigned xb_add(unsigned* p, unsigned v) { return __hip_atomic_fetch_add(p, v, __ATOMIC_RELAXED, __HIP_MEMORY_SCOPE_AGENT); }
__device__ __forceinline__ float bf_lo(unsigned u) { return __uint_as_float(u << 16); }
__device__ __forceinline__ float bf_hi(unsigned u) { return __uint_as_float(u & 0xffff0000u); }
__device__ __forceinline__ float sigm_f(float x) { return __builtin_amdgcn_rcpf(1.f + __builtin_amdgcn_exp2f(-LOG2E * x)); }
__device__ __forceinline__ float silu_f(float x) { return x * sigm_f(x); }
__device__ __forceinline__ f32x4 sigm4(const f32x4 v) { f32x4 r; r.x = sigm_f(v.x); r.y = sigm_f(v.y); r.z = sigm_f(v.z); r.w = sigm_f(v.w); return r; }
__device__ __forceinline__ f32x4 onepexp4(const f32x4 v) { f32x4 r; r.x = 1.f + __builtin_amdgcn_exp2f(-LOG2E * v.x); r.y = 1.f + __builtin_amdgcn_exp2f(-LOG2E * v.y); r.z = 1.f + __builtin_amdgcn_exp2f(-LOG2E * v.z); r.w = 1.f + __builtin_amdgcn_exp2f(-LOG2E * v.w); return r; }
__device__ __forceinline__ f32x4 rcp4(const f32x4 v) { f32x4 r; r.x = __builtin_amdgcn_rcpf(v.x); r.y = __builtin_amdgcn_rcpf(v.y); r.z = __builtin_amdgcn_rcpf(v.z); r.w = __builtin_amdgcn_rcpf(v.w); return r; }
__device__ __forceinline__ void gate4(const f32x4 ga, const f32x4 gb, f32x4& r, f32x4& sb) { const f32x4 ea = onepexp4(ga), eb = onepexp4(gb); sb = rcp4(eb); r = rcp4(ea) * eb; }
__device__ __forceinline__ int rowpos(int row) { return row < R_SAMPLE ? (row > R_META ? row - R_META : 0) : (row < R_END ? 16384 + ((row - R_SAMPLE) & 7) : 0); }
__device__ __forceinline__ u32x4 pack8(const f32x4 a, const f32x4 b) { u32x4 w; w.x = cvt_pk_bf16(a[0], a[1]); w.y = cvt_pk_bf16(a[2], a[3]); w.z = cvt_pk_bf16(b[0], b[1]); w.w = cvt_pk_bf16(b[2], b[3]); return w; }

struct Epi1 {
    bf16_t *Q, *Kb, *Vt, *SZA, *BZ, *U, *SGA, *SGB; const float *rope, *qnw, *knw; float* out;
    __device__ __forceinline__ bool keep(const pg8::Unit&) const { return false; }
    __device__ __forceinline__ void operator()(f32x4 (&acc)[2][2][4][2], const pg8::Unit& u, int wr, int wc, int fr, int fq) const {
        const int pn = u.pn, row0 = u.pm * 256 + wr * 64 + fr;
        if (pn < 5) {
            const bool isq = pn < 4; const float* nw = isq ? qnw : knw;
            f32x4 w[2][2];
#pragma unroll
            for (int bj = 0; bj < 2; ++bj)
#pragma unroll
                for (int n = 0; n < 2; ++n) w[bj][n] = *(const f32x4*)(nw + 32 * bj + 8 * fq + 4 * n);
            const float sc = isq ? C2 : 1.f;
#pragma unroll
            for (int ai = 0; ai < 2; ++ai)
#pragma unroll
                for (int m = 0; m < 4; ++m) {
                    const int row = row0 + ai * 128 + m * 16;
                    float ss = 0.f;
#pragma unroll
                    for (int bj = 0; bj < 2; ++bj)
#pragma unroll
                        for (int n = 0; n < 2; ++n) { const f32x4 x = acc[ai][bj][m][n]; ss += (x[0] * x[0] + x[1] * x[1]) + (x[2] * x[2] + x[3] * x[3]); }
                    ss += __shfl_xor(ss, 16); ss += __shfl_xor(ss, 32);
                    const float rinv = 1.0f / sqrtf(ss * (1.f / 64.f) + EPS);
                    const float* rp = rope + (size_t)rowpos(row) * 64 + 8 * fq;
                    f32x4 o1[2], o2[2];
#pragma unroll
                    for (int n = 0; n < 2; ++n) {
                        const f32x4 cs = *(const f32x4*)(rp + 4 * n), sn = *(const f32x4*)(rp + 32 + 4 * n);
                        const f32x4 x1 = acc[ai][0][m][n] * rinv * w[0][n], x2 = acc[ai][1][m][n] * rinv * w[1][n];
                        o1[n] = (x1 * cs - x2 * sn) * sc; o2[n] = (x2 * cs + x1 * sn) * sc;
                    }
                    if (isq) {
                        bf16_t* p = Q + (size_t)row * DM + 64 * (4 * pn + wc) + 8 * fq;
                        *(u32x4*)p = pack8(o1[0], o1[1]); *(u32x4*)(p + 32) = pack8(o2[0], o2[1]);
                    } else {
                        bf16_t* p = Kb + (size_t)row * 256 + 64 * wc + 8 * fq;
                        *(u32x4*)p = pack8(o1[0], o1[1]); *(u32x4*)(p + 32) = pack8(o2[0], o2[1]);
                        if (u.pm >= 64) {
                            float* d = nullptr;
                            if (row >= 16384 && row < R_SAMPLE) d = out + O_NKP + (size_t)(row - 16384) * 256;
                            else if (row >= R_SAMPLE && row < R_END) { const int sr = row - R_SAMPLE; d = out + O_NKS + ((size_t)(sr >> 3) * 128 + 120 + (sr & 7)) * 256; }
                            if (d) { d += 64 * wc + 8 * fq; *(f32x4*)d = o1[0]; *(f32x4*)(d + 4) = o1[1]; *(f32x4*)(d + 32) = o2[0]; *(f32x4*)(d + 36) = o2[1]; }
                        }
                    }
                }
        } else if (pn == 5) {
#pragma unroll
            for (int ai = 0; ai < 2; ++ai)
#pragma unroll
                for (int m = 0; m < 4; ++m) {
                    const int row = row0 + ai * 128 + m * 16;
                    float* d = nullptr;
                    if (u.pm >= 64) {
                        if (row >= 16384 && row < R_SAMPLE) d = out + O_NVP + (size_t)(row - 16384) * 256;
                        else if (row >= R_SAMPLE && row < R_END) { const int sr = row - R_SAMPLE; d = out + O_NVS + ((size_t)(sr >> 3) * 128 + 120 + (sr & 7)) * 256; }
                    }
#pragma unroll
                    for (int bj = 0; bj < 2; ++bj)
#pragma unroll
                        for (int n = 0; n < 2; ++n) {
                            const int c = 128 * bj + 32 * wc + 8 * fq + 4 * n; const f32x4 x = acc[ai][bj][m][n];
                            const unsigned p0 = cvt_pk_bf16(x[0], x[1]), p1 = cvt_pk_bf16(x[2], x[3]);
                            bf16_t* vp = Vt + (size_t)c * MROWS + row;
                            vp[0] = (bf16_t)(p0 & 0xffffu); vp[MROWS] = (bf16_t)(p0 >> 16); vp[2 * (size_t)MROWS] = (bf16_t)(p1 & 0xffffu); vp[3 * (size_t)MROWS] = (bf16_t)(p1 >> 16);
                            if (d) *(f32x4*)(d + c) = x;
                        }
                }
        } else if (pn >= 10 && pn < 26) {
            const int ch = 64 * (pn - 10) + 16 * wc + 4 * fq;
#pragma unroll
            for (int ai = 0; ai < 2; ++ai)
#pragma unroll
                for (int m = 0; m < 4; ++m) {
                    const int row = row0 + ai * 128 + m * 16;
                    const f32x4 b = acc[ai][0][m][0], c = acc[ai][0][m][1], hc = acc[ai][1][m][0], zb = acc[ai][1][m][1];
                    const f32x4 uu = c * hc, bz = b * zb * sigm4(zb);
                    u32x2 wu, wb; wu.x = cvt_pk_bf16(uu[0], uu[1]); wu.y = cvt_pk_bf16(uu[2], uu[3]); wb.x = cvt_pk_bf16(bz[0], bz[1]); wb.y = cvt_pk_bf16(bz[2], bz[3]);
                    *(u32x2*)(U + (size_t)row * DM + ch) = wu; *(u32x2*)(BZ + (size_t)row * DM + ch) = wb;
                    if (u.pm >= 64) {
                        if (row == 16510 || row == 16511) *(f32x4*)(out + O_NCP + (size_t)(row - 16510) * DM + ch) = uu;
                        else if (row >= R_SAMPLE && row < R_END && ((row - R_SAMPLE) & 7) >= 6) { const int sr = row - R_SAMPLE; *(f32x4*)(out + O_NCS + ((size_t)(sr >> 3) * 2 + ((sr & 7) - 6)) * DM + ch) = uu; }
                    }
                }
        } else if (pn < 10) {
            const int col0 = (pn - 6) * 256 + 32 * wc + 8 * fq;
#pragma unroll
            for (int ai = 0; ai < 2; ++ai)
#pragma unroll
                for (int m = 0; m < 4; ++m) {
                    bf16_t* rowp = SZA + (size_t)(row0 + ai * 128 + m * 16) * DM + col0;
#pragma unroll
                    for (int bj = 0; bj < 2; ++bj) {
                        const f32x4 v0 = acc[ai][bj][m][0], v1 = acc[ai][bj][m][1];
                        *(u32x4*)(rowp + bj * 128) = pack8(sigm4(v0) * v0, sigm4(v1) * v1);
                    }
                }
        } else {
            const int col0 = (pn - 26) * 128 + 32 * wc + 8 * fq;
#pragma unroll
            for (int ai = 0; ai < 2; ++ai)
#pragma unroll
                for (int m = 0; m < 4; ++m) {
                    const size_t off = (size_t)(row0 + ai * 128 + m * 16) * DM + col0;
#pragma unroll
                    for (int n = 0; n < 2; ++n) {
                        f32x4 r0, s0; gate4(acc[ai][0][m][n], acc[ai][1][m][n], r0, s0);
                        u32x2 wr_, ws_; wr_.x = cvt_pk_bf16(r0.x, r0.y); wr_.y = cvt_pk_bf16(r0.z, r0.w); ws_.x = cvt_pk_bf16(s0.x, s0.y); ws_.y = cvt_pk_bf16(s0.z, s0.w);
                        *(u32x2*)(SGA + off + 4 * n) = wr_; *(u32x2*)(SGB + off + 4 * n) = ws_;
                        __builtin_amdgcn_sched_barrier(0);
                    }
                }
        }
    }
};

struct Epi2 {
    const bf16_t *SGA, *SGB; bf16_t* MIX;
    __device__ __forceinline__ bool keep(const pg8::Unit& u) const { return u.part == 0; }
    __device__ __forceinline__ void operator()(f32x4 (&acc)[2][2][4][2], const pg8::Unit& u, int wr, int wc, int fr, int fq) const {
        const int row0 = u.pm * 256 + wr * 64 + fr, col0 = u.pn * 256 + 32 * wc + 8 * fq;
        const bf16_t* p0 = SGA; const bf16_t* p1 = SGB; asm volatile("" : "+s"(p0), "+s"(p1));
        const bf16_t* G = u.part == 0 ? p0 : p1;
        u32x4 gv[2][4][2];
#pragma unroll
        for (int ai = 0; ai < 2; ++ai)
#pragma unroll
            for (int m = 0; m < 4; ++m)
#pragma unroll
                for (int bj = 0; bj < 2; ++bj) gv[ai][m][bj] = *(const u32x4*)(G + (size_t)(row0 + ai * 128 + m * 16) * DM + col0 + bj * 128);
#pragma unroll
        for (int ai = 0; ai < 2; ++ai)
#pragma unroll
            for (int m = 0; m < 4; ++m) {
                const size_t off = (size_t)(row0 + ai * 128 + m * 16) * DM + col0;
#pragma unroll
                for (int bj = 0; bj < 2; ++bj) {
                    const u32x4 gb = gv[ai][m][bj];
                    const f32x4 b0 = {bf_lo(gb.x), bf_hi(gb.x), bf_lo(gb.y), bf_hi(gb.y)}, b1 = {bf_lo(gb.z), bf_hi(gb.z), bf_lo(gb.w), bf_hi(gb.w)};
                    if (u.part == 0) { acc[ai][bj][m][0] = acc[ai][bj][m][0] * b0; acc[ai][bj][m][1] = acc[ai][bj][m][1] * b1; }
                    else *(u32x4*)(MIX + off + bj * 128) = pack8(acc[ai][bj][m][0] * b0, acc[ai][bj][m][1] * b1);
                }
            }
    }
};

template <bool GATE> struct EpiPart {
    const bf16_t* SGA; float* scr; const bf16_t* SGB;
    __device__ __forceinline__ bool keep(const pg8::Unit&) const { return false; }
    __device__ __forceinline__ void operator()(f32x4 (&acc)[2][2][4][2], const pg8::Unit& u, int wr, int wc, int fr, int fq) const {
        const int row0 = u.pm * 256 + wr * 64 + fr, col0 = u.pn * 256 + 32 * wc + 8 * fq, lr0 = wr * 64 + fr, lc0 = 32 * wc + 8 * fq;
#pragma unroll
        for (int ai = 0; ai < 2; ++ai)
#pragma unroll
            for (int m = 0; m < 4; ++m) {
                const size_t off = (size_t)(row0 + ai * 128 + m * 16) * DM + col0;
                bf16_t* sp = (bf16_t*)scr + (size_t)(lr0 + ai * 128 + m * 16) * 256 + lc0;
#pragma unroll
                for (int bj = 0; bj < 2; ++bj) {
                    f32x4 a0 = {1.f, 1.f, 1.f, 1.f}, a1 = a0;
                    if (GATE) { const u32x4 ga = *(const u32x4*)(SGA + off + bj * 128), gb = *(const u32x4*)(SGB + off + bj * 128);
                        a0 = (f32x4){bf_lo(ga.x) * bf_lo(gb.x), bf_hi(ga.x) * bf_hi(gb.x), bf_lo(ga.y) * bf_lo(gb.y), bf_hi(ga.y) * bf_hi(gb.y)};
                        a1 = (f32x4){bf_lo(ga.z) * bf_lo(gb.z), bf_hi(ga.z) * bf_hi(gb.z), bf_lo(ga.w) * bf_lo(gb.w), bf_hi(ga.w) * bf_hi(gb.w)}; }
                    *(u32x4*)(sp + bj * 128) = pack8(acc[ai][bj][m][0] * a0, acc[ai][bj][m][1] * a1);
                }
            }
    }
};
__device__ __forceinline__ void wait_count(unsigned* cnt, unsigned want) {
    unsigned sp = 0; while (xb_ld(cnt) < want) { __builtin_amdgcn_s_sleep(1); if (++sp > (1u << 22)) break; }
    __builtin_amdgcn_fence(__ATOMIC_ACQUIRE, "agent");
    asm volatile("s_waitcnt vmcnt(0)" ::: "memory");
}
struct Epi2b {
    const bf16_t* SGB; const float* scr; bf16_t* MIX; unsigned* cnt;
    __device__ __forceinline__ bool keep(const pg8::Unit&) const { return false; }
    __device__ __forceinline__ void operator()(f32x4 (&acc)[2][2][4][2], const pg8::Unit& u, int wr, int wc, int fr, int fq) const {
        const int row0 = u.pm * 256 + wr * 64 + fr, col0 = u.pn * 256 + 32 * wc + 8 * fq, lr0 = wr * 64 + fr, lc0 = 32 * wc + 8 * fq;
        u32x4 gbv[4][2];
#pragma unroll
        for (int m = 0; m < 4; ++m)
#pragma unroll
            for (int bj = 0; bj < 2; ++bj) gbv[m][bj] = *(const u32x4*)(SGB + (size_t)(row0 + m * 16) * DM + col0 + bj * 128);
        wait_count(cnt, 1u);
#pragma unroll
        for (int ai = 0; ai < 2; ++ai) {
            u32x4 ppv[4][2];
#pragma unroll
            for (int m = 0; m < 4; ++m) { const bf16_t* sp = (const bf16_t*)scr + (size_t)(lr0 + ai * 128 + m * 16) * 256 + lc0;
#pragma unroll
                for (int bj = 0; bj < 2; ++bj) { ppv[m][bj] = *(const u32x4*)(sp + bj * 128); if (ai == 1) gbv[m][bj] = *(const u32x4*)(SGB + (size_t)(row0 + 128 + m * 16) * DM + col0 + bj * 128); } }
#pragma unroll
            for (int m = 0; m < 4; ++m) { const size_t off = (size_t)(row0 + ai * 128 + m * 16) * DM + col0;
#pragma unroll
                for (int bj = 0; bj < 2; ++bj) {
                    const u32x4 gb = gbv[m][bj], pp = ppv[m][bj];
                    const f32x4 b0 = {bf_lo(gb.x), bf_hi(gb.x), bf_lo(gb.y), bf_hi(gb.y)}, b1 = {bf_lo(gb.z), bf_hi(gb.z), bf_lo(gb.w), bf_hi(gb.w)};
                    const f32x4 p0 = {bf_lo(pp.x), bf_hi(pp.x), bf_lo(pp.y), bf_hi(pp.y)}, p1 = {bf_lo(pp.z), bf_hi(pp.z), bf_lo(pp.w), bf_hi(pp.w)};
                    *(u32x4*)(MIX + off + bj * 128) = pack8(p0 + acc[ai][bj][m][0] * b0, p1 + acc[ai][bj][m][1] * b1);
                } }
            asm volatile("" ::: "memory");
        }
    }
};
struct Epi3b {
    const float *xp, *xs; float* y; const float* scr; unsigned* cnt;
    __device__ __forceinline__ bool keep(const pg8::Unit&) const { return false; }
    __device__ __forceinline__ void operator()(f32x4 (&acc)[2][2][4][2], const pg8::Unit& u, int wr, int wc, int fr, int fq) const {
        const int row0 = u.pm * 256 + wr * 64 + fr, col0 = u.pn * 256 + 32 * wc + 8 * fq, lr0 = wr * 64 + fr, lc0 = 32 * wc + 8 * fq;
        wait_count(cnt, 1u);
#pragma unroll
        for (int ai = 0; ai < 2; ++ai)
#pragma unroll
            for (int m = 0; m < 4; ++m) {
                const int gr = row0 + ai * 128 + m * 16;
                const float* xr = (gr < 16384 ? xp + (size_t)gr * DM : xs + (size_t)(gr - 16384) * DM) + col0;
                float* yr = y + (size_t)gr * DM + col0;
                const bf16_t* sp = (const bf16_t*)scr + (size_t)(lr0 + ai * 128 + m * 16) * 256 + lc0;
#pragma unroll
                for (int bj = 0; bj < 2; ++bj) {
                    const u32x4 pp = *(const u32x4*)(sp + bj * 128); const f32x4 p0 = {bf_lo(pp.x), bf_hi(pp.x), bf_lo(pp.y), bf_hi(pp.y)}, p1 = {bf_lo(pp.z), bf_hi(pp.z), bf_lo(pp.w), bf_hi(pp.w)};
                    *(f32x4*)(yr + bj * 128) = *(const f32x4*)(xr + bj * 128) + p0 + acc[ai][bj][m][0]; *(f32x4*)(yr + bj * 128 + 4) = *(const f32x4*)(xr + bj * 128 + 4) + p1 + acc[ai][bj][m][1];
                }
            }
    }
};
__device__ __forceinline__ void publish_count(unsigned* cnt) {
    asm volatile("s_waitcnt vmcnt(0)" ::: "memory");
    __syncthreads();
    if (threadIdx.x == 0) { __builtin_amdgcn_fence(__ATOMIC_RELEASE, "agent"); asm volatile("s_waitcnt vmcnt(0)" ::: "memory"); xb_add(cnt, 1u); }
}

struct Epi3 {
    const float *xp, *xs; float* y;
    __device__ __forceinline__ bool keep(const pg8::Unit&) const { return false; }
    __device__ __forceinline__ void operator()(f32x4 (&acc)[2][2][4][2], const pg8::Unit& u, int wr, int wc, int fr, int fq) const {
        const int row0 = u.pm * 256 + wr * 64 + fr, col0 = u.pn * 256 + 32 * wc + 8 * fq;
#pragma unroll
        for (int ai = 0; ai < 2; ++ai) {
            f32x4 xv[4][2][2];
#pragma unroll
            for (int m = 0; m < 4; ++m) {
                const int gr = row0 + ai * 128 + m * 16;
                const float* xr = (gr < 16384 ? xp + (size_t)gr * DM : xs + (size_t)(gr - 16384) * DM) + col0;
#pragma unroll
                for (int bj = 0; bj < 2; ++bj)
#pragma unroll
                    for (int n = 0; n < 2; ++n) xv[m][bj][n] = *(const f32x4*)(xr + bj * 128 + 4 * n);
            }
#pragma unroll
            for (int m = 0; m < 4; ++m) {
                float* yr = y + (size_t)(row0 + ai * 128 + m * 16) * DM + col0;
#pragma unroll
                for (int bj = 0; bj < 2; ++bj)
#pragma unroll
                    for (int n = 0; n < 2; ++n) *(f32x4*)(yr + bj * 128 + 4 * n) = xv[m][bj][n] + acc[ai][bj][m][n];
            }
            asm volatile("" ::: "memory");
        }
    }
};

__device__ __forceinline__ float wave_sum(float v) {
#pragma unroll
    for (int o = 1; o < 64; o <<= 1) v += __shfl_xor(v, o);
    return v;
}
__device__ __forceinline__ int win_orig_col(int n) {
    const int pn = n >> 8, c = n & 255;
    if (pn < 5) { const int bj = c >> 7, wc = (c >> 5) & 3, j = c & 31; return 64 * (4 * pn + wc) + 32 * bj + j; }
    if (pn >= 10 && pn < 26) { const int t = pn - 10, bj = c >> 7, wc = (c >> 5) & 3, fq = (c >> 3) & 3, nn = (c >> 2) & 1, e = c & 3; return 2560 + 1024 * (2 * bj + nn) + 64 * t + 16 * wc + 4 * fq + e; }
    if (pn >= 26) { const int t = pn - 26, bj = c >> 7, rest = c & 127; return 6656 + 1024 * bj + 128 * t + rest; }
    return n;
}
template <bool PERMUTE>
__device__ __forceinline__ void p0_transpose_item(const float* W, int K, int N, bf16_t* WT, LAS float* scr, int item, int lane) {
    const int nblk = N / 32, kb = item / nblk, nb = item % nblk, k0 = 64 * kb, n0 = 32 * nb;
    const int ncol = PERMUTE ? win_orig_col(n0 + (lane & 31)) : n0 + (lane & 31);
    float tv[32];
#pragma unroll
    for (int i = 0; i < 32; ++i) tv[i] = __builtin_nontemporal_load(W + (size_t)(k0 + 2 * i + (lane >> 5)) * N + ncol);
#pragma unroll
    for (int i = 0; i < 32; ++i) scr[(2 * i + (lane >> 5)) * 33 + (lane & 31)] = tv[i];
    asm volatile("s_waitcnt lgkmcnt(0)" ::: "memory");
    const int c = lane & 7;
#pragma unroll
    for (int j = 0; j < 4; ++j) { const int n = (lane >> 3) + 8 * j; const LAS float* s = scr + (8 * c) * 33 + n;
        u32x4 o; o.x = cvt_pk_bf16(s[0 * 33], s[1 * 33]); o.y = cvt_pk_bf16(s[2 * 33], s[3 * 33]); o.z = cvt_pk_bf16(s[4 * 33], s[5 * 33]); o.w = cvt_pk_bf16(s[6 * 33], s[7 * 33]);
        *(u32x4*)(WT + (size_t)(n0 + n) * K + k0 + 8 * c) = o; }
    asm volatile("s_waitcnt lgkmcnt(0)" ::: "memory");
}

struct Args { const float* in[15]; float* out; unsigned char* ws; int ph_lo, ph_hi; };

__device__ __forceinline__ void p0_prologue(const Args& a, LAS unsigned char* lds, int tid, int lane, int wave, int G) {
    LAS float* scr = (LAS float*)(lds + wave * 16384);
    const int gw = blockIdx.x * 8 + wave, NGW = G * 8;
    bf16_t* WIN = (bf16_t*)(a.ws + WS_WIN); bf16_t* WA = (bf16_t*)(a.ws + WS_WA); bf16_t* WB = (bf16_t*)(a.ws + WS_WB); bf16_t* WO = (bf16_t*)(a.ws + WS_WO);
    constexpr int I_IN = 16 * (NIN / 32), I_SQ = 16 * 32, NITEMS = I_IN + 3 * I_SQ;
    for (int it = gw; it < NITEMS; it += NGW) {
        int r = it;
        if (r < I_IN) { p0_transpose_item<true>(a.in[7], DM, NIN, WIN, scr, r, lane); continue; } r -= I_IN;
        if (r < I_SQ) { p0_transpose_item<false>(a.in[12], DM, DM, WA, scr, r, lane); continue; } r -= I_SQ;
        if (r < I_SQ) { p0_transpose_item<false>(a.in[13], DM, DM, WB, scr, r, lane); continue; } r -= I_SQ;
        p0_transpose_item<false>(a.in[14], DM, DM, WO, scr, r, lane);
    }
    bf16_t* XN = (bf16_t*)(a.ws + WS_B0);
    const f32x4* nwp = (const f32x4*)a.in[6] + lane;
    f32x4 nw[4];
#pragma unroll
    for (int j = 0; j < 4; ++j) nw[j] = nwp[64 * j];
    for (int m0 = gw; m0 < MROWS; m0 += 4 * NGW) {
        const float* src[4]; f32x4 v[4][4];
#pragma unroll
        for (int q = 0; q < 4; ++q) {
            const int m = m0 + q * NGW; src[q] = nullptr;
            if (m >= R_PROMPT && m < R_SAMPLE) src[q] = a.in[0] + (size_t)(m - R_PROMPT) * DM;
            else if (m >= R_SAMPLE && m < R_END) src[q] = a.in[1] + (size_t)(m - R_SAMPLE) * DM;
            else if (m >= R_META && m < R_PROMPT) src[q] = a.in[5] + (size_t)(m - R_META) * DM;
#pragma unroll
            for (int j = 0; j < 4; ++j) v[q][j] = src[q] ? __builtin_nontemporal_load((const f32x4*)src[q] + lane + 64 * j) : (f32x4){0.f, 0.f, 0.f, 0.f};
        }
#pragma unroll
        for (int q = 0; q < 4; ++q) {
            const int m = m0 + q * NGW;
            if (m < MROWS) {
                float s2 = 0.f;
#pragma unroll
                for (int j = 0; j < 4; ++j) s2 += (v[q][j].x * v[q][j].x + v[q][j].y * v[q][j].y) + (v[q][j].z * v[q][j].z + v[q][j].w * v[q][j].w);
                const float r = 1.0f / sqrtf(wave_sum(s2) * (1.f / DM) + EPS);
                unsigned long long* o8 = (unsigned long long*)(XN + (size_t)m * DM) + lane;
#pragma unroll
                for (int j = 0; j < 4; ++j) { const f32x4 y = v[q][j] * r * nw[j]; o8[64 * j] = (unsigned long long)cvt_pk_bf16(y.x, y.y) | ((unsigned long long)cvt_pk_bf16(y.z, y.w) << 32); }
            }
        }
    }
    float* rope = (float*)(a.ws + WS_ROPE);
    for (int i = blockIdx.x * 512 + tid; i < NPOS * 32; i += G * 512) {
        const int pos = i >> 5, j = i & 31;
        double invd = 1.0; for (int q = 0; q < j; ++q) invd *= 0.74989420933245582730;
        const float inv = (float)invd; const float angf = (float)pos * inv; const double ang = (double)angf;
        const double kq = __builtin_rint(ang * 0.63661977236758134308); const int qi = (int)kq;
        double rr = __builtin_fma(-kq, 1.57079632679489655800, ang); rr = __builtin_fma(-kq, 6.12323399573676603587e-17, rr);
        const double r2 = rr * rr;
        double sn = r2 * (1.0 / 6227020800.0) - (1.0 / 39916800.0); sn = sn * r2 + (1.0 / 362880.0); sn = sn * r2 - (1.0 / 5040.0); sn = sn * r2 + (1.0 / 120.0); sn = sn * r2 - (1.0 / 6.0); sn = sn * r2 * rr + rr;
        double cs = r2 * (1.0 / 479001600.0) - (1.0 / 3628800.0); cs = cs * r2 + (1.0 / 40320.0); cs = cs * r2 - (1.0 / 720.0); cs = cs * r2 + (1.0 / 24.0); cs = cs * r2 - 0.5; cs = cs * r2 + 1.0;
        double so, co;
        switch (qi & 3) { case 0: so = sn; co = cs; break; case 1: so = cs; co = -sn; break; case 2: so = -sn; co = -cs; break; default: so = -cs; co = sn; break; }
        rope[(size_t)pos * 64 + j] = (float)co; rope[(size_t)pos * 64 + 32 + j] = (float)so;
    }
}

__device__ __forceinline__ int crow(int r, int hi) { return (r & 3) + 8 * (r >> 2) + 4 * hi; }
__device__ __forceinline__ bf16x8 packp(const f32x16& p, int s) {
    u32x4 w; w.x = cvt_pk_bf16(p[8 * s + 0], p[8 * s + 1]); w.y = cvt_pk_bf16(p[8 * s + 2], p[8 * s + 3]); w.z = cvt_pk_bf16(p[8 * s + 4], p[8 * s + 5]); w.w = cvt_pk_bf16(p[8 * s + 6], p[8 * s + 7]);
    return __builtin_bit_cast(bf16x8, w);
}
__device__ __forceinline__ float sink_softmax5(f32x16 (&S)[5], int qcmp, int hi, float sink2, int minkr) {
    const float NEG = -INFINITY;
#pragma unroll
    for (int r = 0; r < 16; ++r) { const int c = crow(r, hi); if (c < qcmp) S[0][r] = NEG; if (c > qcmp) S[4][r] = NEG; }
    if (minkr > 0) {
#pragma unroll
        for (int kb = 0; kb < 5; ++kb)
#pragma unroll
            for (int r = 0; r < 16; ++r) if (32 * kb + crow(r, hi) < minkr) S[kb][r] = NEG;
    }
    float m = sink2;
#pragma unroll
    for (int kb = 0; kb < 5; ++kb)
#pragma unroll
        for (int r = 0; r < 16; ++r) m = fmaxf(m, S[kb][r]);
    m = fmaxf(m, __shfl_xor(m, 32));
    float l = 0.f;
#pragma unroll
    for (int kb = 0; kb < 5; ++kb)
#pragma unroll
        for (int r = 0; r < 16; ++r) { const float p = __builtin_amdgcn_exp2f(S[kb][r] - m); S[kb][r] = p; l += p; }
    l += __shfl_xor(l, 32);
    l += __builtin_amdgcn_exp2f(sink2 - m);
    return 1.0f / l;
}
__device__ __forceinline__ void attn_store(const f32x16 (&O)[2], float inv_l, int row, int head, int hi, const bf16_t* SZA, bf16_t* QA) {
#pragma unroll
    for (int blk = 0; blk < 2; ++blk)
#pragma unroll
        for (int rr = 0; rr < 4; ++rr) {
            const size_t off = (size_t)row * DM + 64 * head + 32 * blk + 8 * rr + 4 * hi;
            const u32x2 z = *(const u32x2*)(SZA + off);
            u32x2 w; w.x = cvt_pk_bf16(O[blk][4 * rr] * inv_l * bf_lo(z.x), O[blk][4 * rr + 1] * inv_l * bf_hi(z.x)); w.y = cvt_pk_bf16(O[blk][4 * rr + 2] * inv_l * bf_lo(z.y), O[blk][4 * rr + 3] * inv_l * bf_hi(z.y));
            *(u32x2*)(QA + off) = w;
        }
}

__device__ __forceinline__ void attn_prompt_all(LAS unsigned char* lds, int tid, int id0, int G, int idEnd, const bf16_t* Kb, const bf16_t* Vt, bf16_t* QA, const bf16_t* SZA, const float* sinks) {
    const int lane = tid & 63, wid = __builtin_amdgcn_readfirstlane(tid >> 6), ql = lane & 31, hi = lane >> 5;
    LAS unsigned char* Ks = lds; LAS unsigned char* Vs = lds + 27648;
    const int i0 = 32 * (wid & 1);
    u32x4 kst[3], vst[3];
#define ATT_FETCH(id_) do { const int n_ = 1 + ((id_) >> 3), g_ = ((id_) >> 1) & 3, kbase_ = 128 * (n_ - 1) + 64 * ((id_) & 1); \
        _Pragma("unroll") for (int i = 0; i < 3; ++i) { const int ch = tid + 512 * i; \
            { const int row = ch >> 3, c = ch & 7; kst[i] = *(const u32x4*)(Kb + (size_t)(kbase_ + row) * 256 + g_ * 64 + c * 8); } \
            { const int d = ch / 24, c = ch - d * 24; vst[i] = *(const u32x4*)(Vt + (size_t)(g_ * 64 + d) * MROWS + kbase_ + c * 8); } } \
        } while (0)
    int id = id0;
    if (id < idEnd) ATT_FETCH(id);
    for (; id < idEnd; id += G) {
        const int n = 1 + (id >> 3), g = (id >> 1) & 3, half = id & 1;
        const int kbase = 128 * (n - 1) + 64 * half;
#pragma unroll
        for (int i = 0; i < 3; ++i) {
            const int ch = tid + 512 * i;
            { const int row = ch >> 3, c = ch & 7; *(LAS u32x4*)(Ks + row * 144 + c * 16) = kst[i]; }
            { const int d = ch / 24, c = ch - d * 24; LAS u32x2* p = (LAS u32x2*)(Vs + d * 392 + c * 16); p[0] = (u32x2){vst[i].x, vst[i].y}; p[1] = (u32x2){vst[i].z, vst[i].w}; }
        }
        const int hq = 4 * g + (wid >> 1);
        const int qrow = kbase + 128 + i0 + ql;
        bf16x8 qr[4];
#pragma unroll
        for (int d0 = 0; d0 < 4; ++d0) qr[d0] = *(const bf16x8*)(QA + (size_t)qrow * DM + 64 * hq + 16 * d0 + 8 * hi);
        const float sink2 = sinks[hq] * LOG2E;
        __syncthreads();
        u32x2 zz[2][4];
#pragma unroll
        for (int blk = 0; blk < 2; ++blk)
#pragma unroll
            for (int rr = 0; rr < 4; ++rr) zz[blk][rr] = *(const u32x2*)(SZA + (size_t)qrow * DM + 64 * hq + 32 * blk + 8 * rr + 4 * hi);
        if (id + G < idEnd) ATT_FETCH(id + G);
        const int minkr = R_META - (kbase + i0);
        float mrun = sink2, lrun = hi ? 0.f : 1.f;
        f32x16 O[2]; O[0] = (f32x16){}; O[1] = (f32x16){};
#pragma unroll
        for (int kb = 0; kb < 5; ++kb) {
            f32x16 S = (f32x16){};
#pragma unroll
            for (int d0 = 0; d0 < 4; ++d0) { const bf16x8 a = *(const LAS bf16x8*)(Ks + (i0 + 32 * kb + ql) * 144 + (16 * d0 + 8 * hi) * 2); S = __builtin_amdgcn_mfma_f32_32x32x16_bf16(a, qr[d0], S, 0, 0, 0); }
            if (kb == 0) {
#pragma unroll
                for (int r = 0; r < 16; ++r) if (crow(r, hi) < ql) S[r] = -INFINITY;
            }
            if (kb == 4) {
#pragma unroll
                for (int r = 0; r < 16; ++r) if (crow(r, hi) > ql) S[r] = -INFINITY;
            }
            if (minkr > 32 * kb) {
#pragma unroll
                for (int r = 0; r < 16; ++r) if (32 * kb + crow(r, hi) < minkr) S[r] = -INFINITY;
            }
            float mb = S[0];
#pragma unroll
            for (int r = 1; r < 16; ++r) mb = fmaxf(mb, S[r]);
            mb = fmaxf(mb, __shfl_xor(mb, 32));
            const float mn = fmaxf(mrun, mb), alpha = __builtin_amdgcn_exp2f(mrun - mn); mrun = mn;
            float ps = 0.f;
#pragma unroll
            for (int r = 0; r < 16; ++r) { const float p = __builtin_amdgcn_exp2f(S[r] - mn); S[r] = p; ps += p; }
            lrun = lrun * alpha + ps;
            O[0] = O[0] * alpha; O[1] = O[1] * alpha;
#pragma unroll
            for (int s = 0; s < 2; ++s) {
                const bf16x8 pb = packp(S, s);
#pragma unroll
                for (int blk = 0; blk < 2; ++blk) {
                    const LAS unsigned char* vp = Vs + (32 * blk + ql) * 392 + (i0 + 32 * kb + 16 * s + 4 * hi) * 2;
                    const u32x2 lo = *(const LAS u32x2*)vp, hh = *(const LAS u32x2*)(vp + 16);
                    const u32x4 av = {lo.x, lo.y, hh.x, hh.y};
                    O[blk] = __builtin_amdgcn_mfma_f32_32x32x16_bf16(__builtin_bit_cast(bf16x8, av), pb, O[blk], 0, 0, 0);
                }
            }
        }
        lrun += __shfl_xor(lrun, 32);
        const float inv_l = 1.0f / lrun;
#pragma unroll
        for (int blk = 0; blk < 2; ++blk)
#pragma unroll
            for (int rr = 0; rr < 4; ++rr) {
                const size_t off = (size_t)qrow * DM + 64 * hq + 32 * blk + 8 * rr + 4 * hi; const u32x2 z = zz[blk][rr];
                u32x2 w; w.x = cvt_pk_bf16(O[blk][4 * rr] * inv_l * bf_lo(z.x), O[blk][4 * rr + 1] * inv_l * bf_hi(z.x)); w.y = cvt_pk_bf16(O[blk][4 * rr + 2] * inv_l * bf_lo(z.y), O[blk][4 * rr + 3] * inv_l * bf_hi(z.y));
                *(u32x2*)(QA + off) = w;
            }
        __syncthreads();
    }
#undef ATT_FETCH
}

__device__ __forceinline__ bf16x8 cvt8(const f32x4 a, const f32x4 b) { return __builtin_bit_cast(bf16x8, pack8(a, b)); }

__device__ __forceinline__ void attn_sample_unit(int b, int g, int hh, int lane, const float* ck, const float* cv, const bf16_t* Kb, const bf16_t* Vt, bf16_t* QA, const bf16_t* SZA, const float* sinks, float* out) {
    const int ql = lane & 31, hi = lane >> 5, t = ql & 7; const bool cp = (hh == 0);
    const int row = R_SAMPLE + 8 * b + t, head = 4 * g + hh;
    bf16x8 qr[4];
#pragma unroll
    for (int d0 = 0; d0 < 4; ++d0) qr[d0] = *(const bf16x8*)(QA + (size_t)row * DM + 64 * head + 16 * d0 + 8 * hi);
    const float sink2 = sinks[head] * LOG2E;
    const float* ckb = ck + (size_t)b * 128 * 256 + g * 64; const float* cvb = cv + (size_t)b * 128 * 256 + g * 64;
    float* oks = out + O_NKS + (size_t)b * 128 * 256 + g * 64; float* ovs = out + O_NVS + (size_t)b * 128 * 256 + g * 64;
    float m = sink2, l = hi ? 0.f : 1.f;
    f32x16 O[2]; O[0] = (f32x16){}; O[1] = (f32x16){};
    const float NEG = -INFINITY;
#pragma unroll 1
    for (int kb = 0; kb < 5; ++kb) {
        f32x16 S = (f32x16){};
        if (kb < 4) {
            const int s = 32 * kb + ql;
#pragma unroll
            for (int d0 = 0; d0 < 4; ++d0) {
                const float* p = ckb + (size_t)s * 256 + 16 * d0 + 8 * hi; const f32x4 x0 = *(const f32x4*)p, x1 = *(const f32x4*)(p + 4);
                if (cp && s >= 8) { float* o = oks + (size_t)(s - 8) * 256 + 16 * d0 + 8 * hi; *(f32x4*)o = x0; *(f32x4*)(o + 4) = x1; }
                S = __builtin_amdgcn_mfma_f32_32x32x16_bf16(cvt8(x0, x1), qr[d0], S, 0, 0, 0);
            }
        } else {
#pragma unroll
            for (int d0 = 0; d0 < 4; ++d0) {
                u32x4 kv = {0u, 0u, 0u, 0u};
                if (ql < 8) kv = *(const u32x4*)(Kb + (size_t)(R_SAMPLE + 8 * b + ql) * 256 + g * 64 + 16 * d0 + 8 * hi);
                S = __builtin_amdgcn_mfma_f32_32x32x16_bf16(__builtin_bit_cast(bf16x8, kv), qr[d0], S, 0, 0, 0);
            }
        }
        if (kb == 0) {
#pragma unroll
            for (int r = 0; r < 16; ++r) if (crow(r, hi) < t) S[r] = NEG;
        }
        if (kb == 4) {
#pragma unroll
            for (int r = 0; r < 16; ++r) if (crow(r, hi) > t) S[r] = NEG;
        }
        float mb = S[0];
#pragma unroll
        for (int r = 1; r < 16; ++r) mb = fmaxf(mb, S[r]);
        mb = fmaxf(mb, __shfl_xor(mb, 32));
        const float mn = fmaxf(m, mb), alpha = __builtin_amdgcn_exp2f(m - mn); m = mn;
        float ps = 0.f;
#pragma unroll
        for (int r = 0; r < 16; ++r) { const float p = __builtin_amdgcn_exp2f(S[r] - mn); S[r] = p; ps += p; }
        l = l * alpha + ps;
        O[0] = O[0] * alpha; O[1] = O[1] * alpha;
        if (kb < 4) {
#pragma unroll
            for (int s2 = 0; s2 < 2; ++s2) {
                const bf16x8 pb = packp(S, s2);
#pragma unroll
                for (int blk = 0; blk < 2; ++blk) {
                    const int d = 32 * blk + ql;
                    f32x4 v0, v1;
                    const int kk = 32 * kb + 16 * s2 + 4 * hi;
                    const float* vsrc = cvb + (size_t)kk * 256 + d; float* vdst = ovs + (size_t)kk * 256 + d - 8 * 256;
                    v0.x = vsrc[0]; v0.y = vsrc[256]; v0.z = vsrc[512]; v0.w = vsrc[768]; v1.x = vsrc[2048]; v1.y = vsrc[2304]; v1.z = vsrc[2560]; v1.w = vsrc[2816];
                    if (cp && kk >= 8) { vdst[0] = v0.x; vdst[256] = v0.y; vdst[512] = v0.z; vdst[768] = v0.w; }
                    if (cp) { vdst[2048] = v1.x; vdst[2304] = v1.y; vdst[2560] = v1.z; vdst[2816] = v1.w; }
                    O[blk] = __builtin_amdgcn_mfma_f32_32x32x16_bf16(cvt8(v0, v1), pb, O[blk], 0, 0, 0);
                }
            }
        } else {
            const bf16x8 pb = packp(S, 0);
#pragma unroll
            for (int blk = 0; blk < 2; ++blk) {
                const int d = 32 * blk + ql;
                const u32x2 lo = *(const u32x2*)(Vt + (size_t)(g * 64 + d) * MROWS + R_SAMPLE + 8 * b + 4 * hi);
                const u32x4 av = {lo.x, lo.y, 0u, 0u};
                O[blk] = __builtin_amdgcn_mfma_f32_32x32x16_bf16(__builtin_bit_cast(bf16x8, av), pb, O[blk], 0, 0, 0);
            }
        }
    }
    l += __shfl_xor(l, 32);
    if (ql < 8) attn_store(O, 1.0f / l, row, head, hi, SZA, QA);
}

__device__ __forceinline__ void attn_sample_wg(LAS unsigned char* lds, int tid, int id, const float* ck, const float* cv, const bf16_t* Kb, const bf16_t* Vt, bf16_t* QA, const bf16_t* SZA, const float* sinks, float* out) {
    const int lane = tid & 63, wid = __builtin_amdgcn_readfirstlane(tid >> 6), ql = lane & 31, hi = lane >> 5, t = ql & 7;
    const int b = id >> 1, gp = id & 1;
    constexpr int KSG = 160 * 144, VSG = 64 * 328;
    LAS unsigned char* Ks = lds; LAS unsigned char* Vs = lds + 2 * KSG;
    const float* ckb = ck + (size_t)b * 128 * 256 + gp * 128; const float* cvb = cv + (size_t)b * 128 * 256 + gp * 128;
    float* oks = out + O_NKS + (size_t)b * 128 * 256 + gp * 128; float* ovs = out + O_NVS + (size_t)b * 128 * 256 + gp * 128;
#pragma unroll
    for (int i = 0; i < 8; ++i) {
        const int idx = tid + 512 * i, srow = idx >> 5, c4 = idx & 31, gl = c4 >> 4, d = (c4 & 15) * 4;
        const f32x4 k4 = __builtin_nontemporal_load((const f32x4*)(ckb + (size_t)srow * 256 + c4 * 4)), v4 = __builtin_nontemporal_load((const f32x4*)(cvb + (size_t)srow * 256 + c4 * 4));
        if (srow >= 8) { __builtin_nontemporal_store(k4, (f32x4*)(oks + (size_t)(srow - 8) * 256 + c4 * 4)); __builtin_nontemporal_store(v4, (f32x4*)(ovs + (size_t)(srow - 8) * 256 + c4 * 4)); }
        u32x2 kw; kw.x = cvt_pk_bf16(k4.x, k4.y); kw.y = cvt_pk_bf16(k4.z, k4.w);
        *(LAS u32x2*)(Ks + gl * KSG + srow * 144 + d * 2) = kw;
        const unsigned v01 = cvt_pk_bf16(v4.x, v4.y), v23 = cvt_pk_bf16(v4.z, v4.w);
        LAS bf16_t* vp = (LAS bf16_t*)(Vs + gl * VSG + d * 328 + srow * 2);
        vp[0] = (bf16_t)(v01 & 0xffffu); vp[164] = (bf16_t)(v01 >> 16); vp[328] = (bf16_t)(v23 & 0xffffu); vp[492] = (bf16_t)(v23 >> 16);
    }
    if (tid < 128) {
        const int j = tid >> 4, c8 = tid & 15, gl = c8 >> 3, d = (c8 & 7) * 8;
        *(LAS u32x4*)(Ks + gl * KSG + (128 + j) * 144 + d * 2) = *(const u32x4*)(Kb + (size_t)(R_SAMPLE + 8 * b + j) * 256 + (2 * gp + gl) * 64 + d);
    } else if (tid < 256) {
        const int gl = (tid - 128) >> 6, d = (tid - 128) & 63;
        const u32x4 v = *(const u32x4*)(Vt + (size_t)((2 * gp + gl) * 64 + d) * MROWS + R_SAMPLE + 8 * b);
        LAS u32x2* p = (LAS u32x2*)(Vs + gl * VSG + d * 328 + 256); p[0] = (u32x2){v.x, v.y}; p[1] = (u32x2){v.z, v.w};
    } else if (tid < 384) {
        const int gl = (tid - 256) >> 6, d = (tid - 256) & 63;
        LAS u32x2* p = (LAS u32x2*)(Vs + gl * VSG + d * 328 + 272);
#pragma unroll
        for (int q = 0; q < 6; ++q) p[q] = (u32x2){0u, 0u};
    }
    const int gl = wid >> 2, hh = wid & 3, head = 4 * (2 * gp + gl) + hh, row = R_SAMPLE + 8 * b + t;
    bf16x8 qr[4];
#pragma unroll
    for (int d0 = 0; d0 < 4; ++d0) qr[d0] = *(const bf16x8*)(QA + (size_t)row * DM + 64 * head + 16 * d0 + 8 * hi);
    const float sink2 = sinks[head] * LOG2E;
    __syncthreads();
    const LAS unsigned char* Kg = Ks + gl * KSG; const LAS unsigned char* Vg = Vs + gl * VSG;
    f32x16 S[5];
#pragma unroll
    for (int kb = 0; kb < 5; ++kb) {
        S[kb] = (f32x16){};
#pragma unroll
        for (int d0 = 0; d0 < 4; ++d0) { const bf16x8 a = *(const LAS bf16x8*)(Kg + (32 * kb + ql) * 144 + (16 * d0 + 8 * hi) * 2); S[kb] = __builtin_amdgcn_mfma_f32_32x32x16_bf16(a, qr[d0], S[kb], 0, 0, 0); }
    }
    const float inv_l = sink_softmax5(S, t, hi, sink2, 0);
    f32x16 O[2]; O[0] = (f32x16){}; O[1] = (f32x16){};
#pragma unroll
    for (int kb = 0; kb < 5; ++kb)
#pragma unroll
        for (int s2 = 0; s2 < 2; ++s2) {
            const bf16x8 pb = packp(S[kb], s2);
#pragma unroll
            for (int blk = 0; blk < 2; ++blk) {
                const LAS unsigned char* vp = Vg + (32 * blk + ql) * 328 + (32 * kb + 16 * s2 + 4 * hi) * 2;
                const u32x2 lo = *(const LAS u32x2*)vp, h2 = *(const LAS u32x2*)(vp + 16);
                const u32x4 av = {lo.x, lo.y, h2.x, h2.y};
                O[blk] = __builtin_amdgcn_mfma_f32_32x32x16_bf16(__builtin_bit_cast(bf16x8, av), pb, O[blk], 0, 0, 0);
            }
        }
    if (ql < 8) attn_store(O, inv_l, row, head, hi, SZA, QA);
    __syncthreads();
}

__device__ __forceinline__ void conv_pass(int gtid, int nthr, int item_lo, int item_hi, const bf16_t* U, bf16_t* BZ, const float* cw, const float* state) {
    const int ch = (gtid & 127) * 8;
    float w0[8], w1[8], w2[8];
#pragma unroll
    for (int e = 0; e < 8; ++e) { w0[e] = cw[ch + e]; w1[e] = cw[DM + ch + e]; w2[e] = cw[2 * DM + ch + e]; }
    for (int item = item_lo + (gtid >> 7); item < item_hi; item += nthr >> 7) {
        const int r0 = R_PROMPT + 8 * item;
        float um2[8], um1[8];
        if (r0 < R_SAMPLE) {
            const u32x4 a = *(const u32x4*)(U + (size_t)(r0 - 2) * DM + ch), b = *(const u32x4*)(U + (size_t)(r0 - 1) * DM + ch);
            um2[0] = bf_lo(a.x); um2[1] = bf_hi(a.x); um2[2] = bf_lo(a.y); um2[3] = bf_hi(a.y); um2[4] = bf_lo(a.z); um2[5] = bf_hi(a.z); um2[6] = bf_lo(a.w); um2[7] = bf_hi(a.w);
            um1[0] = bf_lo(b.x); um1[1] = bf_hi(b.x); um1[2] = bf_lo(b.y); um1[3] = bf_hi(b.y); um1[4] = bf_lo(b.z); um1[5] = bf_hi(b.z); um1[6] = bf_lo(b.w); um1[7] = bf_hi(b.w);
        } else {
            const float* st = state + (size_t)((r0 - R_SAMPLE) >> 3) * 2 * DM + ch;
#pragma unroll
            for (int e = 0; e < 8; ++e) { um2[e] = st[e]; um1[e] = st[DM + e]; }
        }
#pragma unroll
        for (int i = 0; i < 8; ++i) {
            const size_t off = (size_t)(r0 + i) * DM + ch;
            const u32x4 a = *(const u32x4*)(U + off), z = *(const u32x4*)(BZ + off);
            float uc[8], bz[8], o[8];
            uc[0] = bf_lo(a.x); uc[1] = bf_hi(a.x); uc[2] = bf_lo(a.y); uc[3] = bf_hi(a.y); uc[4] = bf_lo(a.z); uc[5] = bf_hi(a.z); uc[6] = bf_lo(a.w); uc[7] = bf_hi(a.w);
            bz[0] = bf_lo(z.x); bz[1] = bf_hi(z.x); bz[2] = bf_lo(z.y); bz[3] = bf_hi(z.y); bz[4] = bf_lo(z.z); bz[5] = bf_hi(z.z); bz[6] = bf_lo(z.w); bz[7] = bf_hi(z.w);
#pragma unroll
            for (int e = 0; e < 8; ++e) { o[e] = bz[e] * (w0[e] * um2[e] + w1[e] * um1[e] + w2[e] * uc[e]); um2[e] = um1[e]; um1[e] = uc[e]; }
            u32x4 w; w.x = cvt_pk_bf16(o[0], o[1]); w.y = cvt_pk_bf16(o[2], o[3]); w.z = cvt_pk_bf16(o[4], o[5]); w.w = cvt_pk_bf16(o[6], o[7]);
            *(u32x4*)(BZ + off) = w;
        }
    }
}


#define XB_TMO      128
#define XB_XCNT(j)  (256  + 64 * (j))
#define XB_XSUB(j)  (1280 + 64 * (j))
#define XB_XGEN(j)  (2304 + 64 * (j))
#define XB_TOP      3328
#define XB_TOPGEN   3392
#define XCD_BAR_WORDS 3456
#define XB_SPIN_CAP (1u << 18)
__device__ __forceinline__ unsigned xb_xcc_id() { return (unsigned)__builtin_amdgcn_s_getreg((3 << 11) | 20) & 0xFu; }
#define XB_SPIN(cond, bar) do { unsigned _sp = 0; while (cond) { __builtin_amdgcn_s_sleep(1); \
    if ((++_sp & 255u) == 0u) { if (xb_ld(&(bar)[XB_TMO])) break; if (_sp > XB_SPIN_CAP) { atomicAdd(&(bar)[XB_TMO], 1u); break; } } } } while (0)
struct XcdBarrier { unsigned* bar; unsigned x; volatile LAS unsigned* st; };
__device__ __forceinline__ XcdBarrier xcd_barrier_post(unsigned* bar, volatile LAS unsigned* st) {
    XcdBarrier b; b.bar = bar; b.x = xb_xcc_id(); b.st = st;
    if (threadIdx.x == 0) (void)xb_add(&bar[XB_XCNT(b.x)], 1u);
    return b;
}
__device__ __forceinline__ void xcd_barrier_complete(unsigned* bar, unsigned x, unsigned& nloc, unsigned& nx) {
    const unsigned G = gridDim.x * gridDim.y * gridDim.z;
    unsigned sum, cnt, mine, sp = 0u;
    for (;;) {
        sum = 0u; cnt = 0u; mine = 0u;
#pragma unroll
        for (unsigned j = 0; j < 16; ++j) { const unsigned c = xb_ld(&bar[XB_XCNT(j)]); sum += c; cnt += (c > 0u) ? 1u : 0u; mine = (j == x) ? c : mine; }
        if (sum == G) break;
        __builtin_amdgcn_s_sleep(1);
        if ((++sp & 255u) == 0u) { if (xb_ld(&bar[XB_TMO])) break; if (sp > XB_SPIN_CAP) { atomicAdd(&bar[XB_TMO], 1u); break; } }
    }
    nloc = mine > 0u ? mine : 1u; nx = cnt > 0u ? cnt : 1u;
}
__device__ __forceinline__ void xcd_barrier(const XcdBarrier& b) {
    asm volatile("s_waitcnt vmcnt(0)" ::: "memory");
    __syncthreads();
    if (threadIdx.x == 0) {
        unsigned* bar = b.bar;
        __builtin_amdgcn_s_waitcnt(0);
        unsigned nloc = b.st[0], nx = b.st[1];
        if (nloc == 0u) { xcd_barrier_complete(bar, b.x, nloc, nx); b.st[0] = nloc; b.st[1] = nx; }
        const unsigned old = xb_add(&bar[XB_XSUB(b.x)], 1u);
        const unsigned gen = old / nloc;
        if (old + 1u == (gen + 1u) * nloc) {
            __builtin_amdgcn_fence(__ATOMIC_RELEASE, "agent");
            asm volatile("s_waitcnt vmcnt(0)" ::: "memory");
            const unsigned og = xb_add(&bar[XB_TOP], 1u);
            const unsigned tg = og / nx;
            if (og + 1u == (tg + 1u) * nx) xb_add(&bar[XB_TOPGEN], 1u);
            else XB_SPIN(xb_ld(&bar[XB_TOPGEN]) == tg, bar);
            __builtin_amdgcn_fence(__ATOMIC_ACQUIRE, "agent");
            xb_add(&bar[XB_XGEN(b.x)], 1u);
            asm volatile("s_waitcnt vmcnt(0)" ::: "memory");
        } else {
            XB_SPIN(xb_ld(&bar[XB_XGEN(b.x)]) == gen, bar);
            __builtin_amdgcn_fence(__ATOMIC_ACQUIRE, "agent");
            asm volatile("s_waitcnt vmcnt(0)" ::: "memory");
        }
    }
    __syncthreads();
}

__device__ __forceinline__ void sub_barrier(unsigned* word, unsigned nwg) {
    asm volatile("s_waitcnt vmcnt(0)" ::: "memory");
    __syncthreads();
    if (threadIdx.x == 0) {
        __builtin_amdgcn_s_waitcnt(0);
        __builtin_amdgcn_fence(__ATOMIC_RELEASE, "agent");
        asm volatile("s_waitcnt vmcnt(0)" ::: "memory");
        xb_add(word, 1u);
        unsigned sp = 0; while (xb_ld(word) < nwg) { __builtin_amdgcn_s_sleep(1); if (++sp > (1u << 22)) break; }
        __builtin_amdgcn_fence(__ATOMIC_ACQUIRE, "agent");
        asm volatile("s_waitcnt vmcnt(0)" ::: "memory");
    }
    __syncthreads();
}

typedef const __attribute__((address_space(4))) Args* CArgs;
__device__ __forceinline__ CArgs fresh_args() { CArgs p = (CArgs)__builtin_amdgcn_kernarg_segment_ptr(); asm volatile("" : "+s"(p)); return p; }
#define PTRS() CArgs A = fresh_args(); unsigned char* ws = A->ws; \
    bf16_t* XN = (bf16_t*)(ws + WS_B0); bf16_t* QA = (bf16_t*)(ws + WS_QA); bf16_t* BZ = (bf16_t*)(ws + WS_BZ); bf16_t* SZA = (bf16_t*)(ws + WS_SZA); \
    bf16_t* Ub = (bf16_t*)(ws + WS_U); bf16_t* SGB = (bf16_t*)(ws + WS_SGB); bf16_t* Kb = (bf16_t*)(ws + WS_K); bf16_t* Vt = (bf16_t*)(ws + WS_VT); \
    bf16_t* SGA = (bf16_t*)A->out; float* rope = (float*)(ws + WS_ROPE); \
    (void)XN; (void)QA; (void)BZ; (void)SZA; (void)Ub; (void)SGB; (void)Kb; (void)Vt; (void)SGA; (void)rope
#define G2_DECL() const pg8::Gemm g2{QA + (size_t)R_PROMPT * DM, (const bf16_t*)(ws + WS_WA), M23, DM, DM, BUFB, 2097152}; const Epi2 E2{SGA + (size_t)R_PROMPT * DM, SGB + (size_t)R_PROMPT * DM, XN}
#define G3_DECL() const pg8::Gemm g3{XN, (const bf16_t*)(ws + WS_WO), M23, DM, DM, 0, 0}; const Epi3 E3{A->in[0], A->in[1], A->out + O_Y}
__global__ void __launch_bounds__(512, 2) hybrid_fwd(Args a_unused) {
    extern __shared__ __attribute__((aligned(16))) unsigned char lds_raw[];
    LAS unsigned char* lds = (LAS unsigned char*)lds_raw;
    const int G = gridDim.x;
#define TIDS() int tid = threadIdx.x; asm volatile("" : "+v"(tid)); const int lane = tid & 63, wave = __builtin_amdgcn_readfirstlane(tid >> 6); (void)lane; (void)wave
#define GSYNC() xcd_barrier(xbar)
    volatile LAS unsigned* MISC = (volatile LAS unsigned*)(lds + 131072);
    if (threadIdx.x < 4) MISC[threadIdx.x] = 0u;
    __syncthreads();
    XcdBarrier xbar;
    { CArgs A = fresh_args(); xbar = xcd_barrier_post((unsigned*)(A->ws + WS_CTL), MISC);
      if (A->ph_lo > 1000) cg::this_grid().sync(); }
    unsigned long long pt0 = 0, pt1 = 0; (void)pt0; (void)pt1;
#define PSTAMP0(k) do { if (PROBE_PH == (k)) pt0 = __builtin_amdgcn_s_memrealtime(); } while (0)
#define PSTAMP1(k) do { if (PROBE_PH == (k)) pt1 = __builtin_amdgcn_s_memrealtime(); } while (0)
    const bool split = (G == 256);
    constexpr int NSPL = 16;
    PSTAMP0(0);
    { TIDS(); CArgs A = fresh_args(); Args pa; pa.in[0] = A->in[0]; pa.in[1] = A->in[1]; pa.in[5] = A->in[5]; pa.in[6] = A->in[6]; pa.in[7] = A->in[7]; pa.in[12] = A->in[12]; pa.in[13] = A->in[13]; pa.in[14] = A->in[14]; pa.ws = A->ws; p0_prologue(pa, lds, tid, lane, wave, G); }
    GSYNC();
    PSTAMP1(0); PSTAMP0(1);
    {
        PTRS();
        pg8::Gemm g{XN, (const bf16_t*)(ws + WS_WIN), MROWS, NIN, DM, 0, 0}; pg8::StaticOrder S; S.init(MROWS, NIN, G, (int)blockIdx.x, 1); S.special = split ? 1 : 0;
        Epi1 E{QA, Kb, Vt, SZA, BZ, Ub, SGA, SGB, rope, A->in[8], A->in[9], A->out};
        pg8::gemm_phase<Epi1>(lds, g, S, E);
    }
    GSYNC();
    PSTAMP1(1); PSTAMP0(2);
    {
        TIDS(); PTRS();
        for (int id = blockIdx.x; id < 256; id += G) attn_sample_wg(lds, tid, id, A->in[2], A->in[3], Kb, Vt, QA, SZA, A->in[10], A->out);
        conv_pass(blockIdx.x * 512 + tid, G * 512, 2048, M23 / 8, Ub, BZ, A->in[11], A->in[4]);
    }
    GSYNC();
    PSTAMP1(2); PSTAMP0(3); if (PROBE_PH == 6) pt0 = __builtin_amdgcn_s_memrealtime();
    if (split && blockIdx.x < 2 * NSPL) {
        const int c = (int)blockIdx.x, tj = c & (NSPL - 1);
#define SPL_PTRS() PTRS(); float* scr1 = (float*)(ws + WS_B0) + (size_t)tj * 65536; float* scr2 = (float*)(ws + WS_B0) + (size_t)(NSPL + tj) * 65536; \
        unsigned* cnt1 = (unsigned*)(ws + WS_CTL) + 9216 + 64 * tj; unsigned* cnt2 = (unsigned*)(ws + WS_CTL) + 10240 + 64 * tj; unsigned* bar32 = (unsigned*)(ws + WS_CTL) + 8192; \
        (void)scr1; (void)scr2; (void)cnt1; (void)cnt2; (void)bar32
        if (c < NSPL) {
            { SPL_PTRS(); const pg8::Gemm ga{QA + (size_t)R_PROMPT * DM, (const bf16_t*)(ws + WS_WA), M23, DM, DM, 0, 0, 0};
              const EpiPart<true> Ea{SGA + (size_t)R_PROMPT * DM, scr1, SGB + (size_t)R_PROMPT * DM};
              pg8::StaticOrder S; S.init(M23, DM, G, c, 1, 256 + tj); pg8::gemm_phase<EpiPart<true>>(lds, ga, S, Ea); publish_count(cnt1); }
            { SPL_PTRS(); sub_barrier(bar32, 2 * NSPL); }
            { SPL_PTRS(); const pg8::Gemm g3a{XN, (const bf16_t*)(ws + WS_WO), M23, DM, 512, 0, 0, DM};
              const EpiPart<false> Ea{nullptr, scr2, nullptr};
              pg8::StaticOrder S; S.init(M23, DM, G, c, 1, 256 + tj); pg8::gemm_phase<EpiPart<false>>(lds, g3a, S, Ea); publish_count(cnt2); }
        } else {
            { SPL_PTRS(); const pg8::Gemm gb{BZ + (size_t)R_PROMPT * DM, (const bf16_t*)(ws + WS_WB), M23, DM, DM, 0, 0, 0};
              const Epi2b Eb{SGB + (size_t)R_PROMPT * DM, scr1, XN, cnt1};
              pg8::StaticOrder S; S.init(M23, DM, G, c, 1, 256 + tj); pg8::gemm_phase<Epi2b>(lds, gb, S, Eb); }
            { SPL_PTRS(); sub_barrier(bar32, 2 * NSPL); }
            { SPL_PTRS(); const pg8::Gemm g3b{XN + 512, (const bf16_t*)(ws + WS_WO) + 512, M23, DM, 512, 0, 0, DM};
              const Epi3b Eb{A->in[0], A->in[1], A->out + O_Y, scr2, cnt2};
              pg8::StaticOrder S; S.init(M23, DM, G, c, 1, 256 + tj); pg8::gemm_phase<Epi3b>(lds, g3b, S, Eb); }
        }
#undef SPL_PTRS
    } else {
        TIDS(); PTRS();
        const int vc = split ? (int)blockIdx.x - 2 * NSPL : (int)blockIdx.x, VG = split ? G - 2 * NSPL : G;
        if (split) {
            const int nd = vc < 150 ? 1 : 2, j0 = vc < 150 ? vc : 150 + 2 * (vc - 150);
            for (int k = 0; k < nd; ++k) {
                const int j = j0 + k, q = j - 2, dpm = j < 2 ? 26 : 27 + (q >> 3), dpn = j < 2 ? 32 + j : 26 + (q & 7);
                pg8::Gemm g{XN, (const bf16_t*)(ws + WS_WIN), MROWS, NIN, DM, 0, 0}; pg8::StaticOrder S; S.init(MROWS, NIN, G, (int)blockIdx.x, 1, dpm * 34 + dpn);
                Epi1 E{QA, Kb, Vt, SZA, BZ, Ub, SGA, SGB, rope, A->in[8], A->in[9], A->out};
                pg8::gemm_phase<Epi1>(lds, g, S, E);
            }
        }
        {
            const int a0 = !split ? vc : (vc < 150 ? 5 * vc : (vc < 172 ? 750 + 3 * (vc - 150) : 816 + 4 * (vc - 172))), na = vc < 150 ? 5 : (vc < 172 ? 3 : 4);
            attn_prompt_all(lds, tid, a0, split ? 1 : VG, split ? a0 + na : 1024, Kb, Vt, QA, SZA, A->in[10]);
        }
        { int tid2 = threadIdx.x; asm volatile("" : "+v"(tid2)); conv_pass(vc * 512 + tid2, VG * 512, 0, 2048, Ub, BZ, A->in[11], A->in[4]); }
    }
    if (PROBE_PH == 6) pt1 = __builtin_amdgcn_s_memrealtime();
    GSYNC();
    PSTAMP1(3); PSTAMP0(4);
    { PTRS(); G2_DECL(); pg8::StaticOrder S; S.init(split ? 16384 : M23, DM, G, (int)blockIdx.x, 2); pg8::gemm_phase<Epi2>(lds, g2, S, E2); }
    GSYNC();
#if REP_MASK & 8
    { PTRS(); G2_DECL(); pg8::StaticOrder S; S.init(split ? 16384 : M23, DM, G, (int)blockIdx.x, 2); pg8::gemm_phase<Epi2>(lds, g2, S, E2); }
    GSYNC();
#endif
    PSTAMP1(4); PSTAMP0(5);
    { PTRS(); G3_DECL(); pg8::StaticOrder S; S.init(split ? 16384 : M23, DM, G, (int)blockIdx.x, 1); pg8::gemm_phase<Epi3>(lds, g3, S, E3); }
#if REP_MASK & 16
    GSYNC();
    { PTRS(); G3_DECL(); pg8::StaticOrder S; S.init(split ? 16384 : M23, DM, G, (int)blockIdx.x, 1); pg8::gemm_phase<Epi3>(lds, g3, S, E3); }
#endif
    PSTAMP1(5);
    if (PROBE_PH >= 0 && blockIdx.x == PROBE_BLK) { const unsigned long long te = __builtin_amdgcn_s_memrealtime(); while (__builtin_amdgcn_s_memrealtime() - te < pt1 - pt0) __builtin_amdgcn_s_sleep(8); }
#undef GSYNC
}

#ifndef DBG_DUMP
#define DBG_DUMP 0
#endif
__global__ void dbg_dump(const bf16_t* src, float* dst, size_t n) {
    for (size_t i = (size_t)blockIdx.x * blockDim.x + threadIdx.x; i < n; i += (size_t)gridDim.x * blockDim.x) dst[i] = __uint_as_float((unsigned)src[i] << 16);
}
extern "C" void kernel_launch(void* const* d_in, const int* in_sizes, int n_in, void* d_out, int out_size, void* d_ws, size_t ws_size, hipStream_t stream) {
    static int grid = 0;
    if (grid == 0) {
        int dev = 0, cus = 0, per_cu = 0;
        if (n_in != 15 || ws_size < WS_END) { fprintf(stderr, "kernel_launch: unexpected inputs (n_in %d, ws %zu)\n", n_in, ws_size); grid = -1; return; }
        if (hipGetDevice(&dev) != hipSuccess || hipDeviceGetAttribute(&cus, hipDeviceAttributeMultiprocessorCount, dev) != hipSuccess) { grid = -1; return; }
        if (hipFuncSetAttribute((const void*)hybrid_fwd, hipFuncAttributeMaxDynamicSharedMemorySize, LDS_BYTES) != hipSuccess) { fprintf(stderr, "kernel_launch: hipFuncSetAttribute failed\n"); grid = -1; return; }
        if (hipOccupancyMaxActiveBlocksPerMultiprocessor(&per_cu, (const void*)hybrid_fwd, 512, LDS_BYTES) != hipSuccess || per_cu < 1) { fprintf(stderr, "kernel_launch: occupancy query gives %d\n", per_cu); per_cu = 1; }
        (void)hipGetLastError();
        grid = cus * 1;
    }
    if (grid < 0) return;
    Args a{};
    for (int i = 0; i < 15; ++i) a.in[i] = (const float*)d_in[i];
    a.out = (float*)d_out; a.ws = (unsigned char*)d_ws;
    if (hipMemsetAsync((char*)d_ws + WS_CTL, 0, CTL_BYTES, stream) != hipSuccess) { fprintf(stderr, "kernel_launch: memset of the barrier words failed\n"); return; }
    a.ph_lo = 0; a.ph_hi = 5;
    void* args[] = {&a};
    hipError_t e = hipLaunchCooperativeKernel((const void*)hybrid_fwd, dim3(grid), dim3(512), args, LDS_BYTES, stream);
    if (e != hipSuccess) fprintf(stderr, "cooperative launch failed: %s (grid %d)\n", hipGetErrorString(e), grid);
}
```

```cpp
#include <hip/hip_runtime.h>
#include <hip/hip_cooperative_groups.h>
#include <cstdio>
#include <cstdint>
namespace cg = cooperative_groups;

#ifndef CHAIN_LATE
#define CHAIN_LATE 0
#endif
#ifndef PROBE_BLK
#define PROBE_BLK 32
#endif
#ifndef PROBE_PH
#define PROBE_PH -1
#endif
#ifndef REP_MASK
#define REP_MASK 0
#endif
#ifndef DBG_NPH
#define DBG_NPH 5
#define DBG_DUMP 0
#endif
#ifndef MK_N_LAUNCHES
#define MK_N_LAUNCHES 1
#endif

#define LAS __attribute__((address_space(3)))
typedef unsigned short bf16_t;
typedef short bf16x8 __attribute__((ext_vector_type(8)));
typedef float f32x4 __attribute__((ext_vector_type(4)));
typedef float f32x16 __attribute__((ext_vector_type(16)));
typedef unsigned u32x4 __attribute__((ext_vector_type(4)));
typedef unsigned u32x2 __attribute__((ext_vector_type(2)));

constexpr int DM = 1024, NIN = 8704;
constexpr int R_META = 112, R_PROMPT = 128, R_SAMPLE = 16512, R_END = 17536, MROWS = 17664;
constexpr int M23 = 17408;
constexpr int NPOS = 16400;
constexpr float EPS = 1e-6f;
constexpr float LOG2E = 1.4426950408889634f;
constexpr float C2 = 0.125f * LOG2E;
constexpr size_t O_Y = 0, O_NKP = 17825792, O_NVP = 17858560, O_NCP = 17891328, O_NKS = 17893376, O_NVS = 22087680, O_NCS = 26281984;
constexpr size_t BUFB = (size_t)MROWS * DM * 2;
constexpr size_t WS_WIN = 0, WS_WA = (size_t)NIN * DM * 2, WS_WB = WS_WA + 2097152, WS_WO = WS_WB + 2097152;
constexpr size_t WS_B0 = 25165824;
constexpr size_t WS_QA = WS_B0 + BUFB, WS_BZ = WS_QA + BUFB, WS_SZA = WS_BZ + BUFB, WS_U = WS_SZA + BUFB, WS_SGB = WS_U + BUFB;
constexpr size_t WS_K = WS_SGB + BUFB, WS_VT = WS_K + (size_t)MROWS * 256 * 2, WS_ROPE = WS_VT + (size_t)MROWS * 256 * 2, WS_END = WS_ROPE + (size_t)NPOS * 64 * 4;
constexpr size_t WS_CTL = 265289728, CTL_BYTES = 65536;
static_assert(WS_END <= WS_CTL && WS_CTL + CTL_BYTES <= 268435456, "d_ws map");

constexpr int LDS_BYTES = 147456;

namespace pg8 {
constexpr int BM = 256, BK = 64, HALF = 128, HTB = HALF * BK * 2, STAGE_BYTES = 8 * HTB, NXCD = 8, WGM = 8;
__host__ __device__ __forceinline__ int lds_byte(int r, int c) { const int st = (r >> 4) * 2 + (c >> 5), rr = r & 15, cc = c & 31, ob = rr * 64 + cc * 2; return st * 1024 + (ob ^ (((ob >> 9) & 1) << 5)); }
__host__ __device__ __forceinline__ void stage_rc(int b, int& R, int& C) { const int st = b / 1024, sb = b % 1024, swz = sb ^ (((sb >> 9) & 1) << 5); R = (st >> 1) * 16 + swz / 64; C = (st & 1) * 32 + (swz % 64) / 2; }
__host__ __device__ __forceinline__ int perm32(int rho) { const int n = rho >> 4, i = rho & 15; return 8 * (i >> 2) + 4 * n + (i & 3); }

struct Unit { int pm, pn, part; };
struct Gemm { const bf16_t* A; const bf16_t* Bt; int M, N, K; size_t partA, partB; int ld; };

struct StaticOrder {
    int nM, nN, nwg, G, c, np, direct, special, direct2;
    __host__ __device__ void init(int M, int N, int G_, int c_, int np_, int direct_ = -1) { nM = M / BM; nN = N / BM; nwg = nM * nN; G = G_; c = c_; np = np_; direct = direct_; special = 0; direct2 = -1; }
    __host__ __device__ static void swz(int wgid, int nM_, int nN_, int& pm, int& pn) {
        const int nwg_ = nM_ * nN_;
        { const int q = nwg_ / NXCD, r = nwg_ % NXCD, xcd = wgid % NXCD, off = wgid / NXCD; wgid = (xcd < r ? xcd * (q + 1) : r * (q + 1) + (xcd - r) * q) + off; }
        const int nig = WGM * nN_, gid = wgid / nig, fm = gid * WGM, gsz = (nM_ - fm) < WGM ? (nM_ - fm) : WGM;
        pm = fm + ((wgid % nig) % gsz); pn = (wgid % nig) / gsz;
    }
    __host__ __device__ bool next(int i, Unit& u) const {
        const int it = (np == 2) ? (i >> 1) : i; u.part = (np == 2) ? (i & 1) : 0;
        if (direct >= 0) { const int t = it == 0 ? direct : (it == 1 ? direct2 : -1); if (t < 0) return false; u.pm = t / nN; u.pn = t % nN; return true; }
        const long L = (long)it * G + c;
        if (special) {
            if (L >= 2048) return false;
            int l = (int)L;
            if (l < 884) { swz(l, 26, 34, u.pm, u.pn); return true; } l -= 884;
            if (l < 1118) { swz(l, 43, 26, u.pm, u.pn); u.pm += 26; return true; } l -= 1118;
            if (l < 40) { u.pm = 64 + (l >> 3); u.pn = 26 + (l & 7); return true; } l -= 40;
            u.pm = 26; u.pn = 26 + l; return true;
        }
        if (L >= nwg) return false;
        swz((int)L, nM, nN, u.pm, u.pn); return true;
    }
};

typedef float f32x2_t __attribute__((ext_vector_type(2))); typedef __bf16 bf16x2_t __attribute__((ext_vector_type(2)));
__device__ __forceinline__ unsigned cvt_pk_bf16(float lo, float hi) { const f32x2_t v = {lo, hi}; const bf16x2_t b = __builtin_convertvector(v, bf16x2_t); return __builtin_bit_cast(unsigned, b); }

template <class Epi>
__device__ __forceinline__ void gemm_phase(LAS unsigned char* lds, const Gemm g, const StaticOrder& S, const Epi& E) {
    int tid_ = threadIdx.x; asm volatile("" : "+v"(tid_));
    const int tid = tid_, wid = __builtin_amdgcn_readfirstlane(tid >> 6), lane = tid & 63, wr = wid >> 2, wc = wid & 3, fr = lane & 15, fq = lane >> 4;
    const int K = g.ld ? g.ld : g.K, nt = g.K / BK;
    unsigned voffA[2], voffB[2];
#pragma unroll
    for (int i = 0; i < 2; ++i) { int R, C; stage_rc(tid * 16 + i * 8192, R, C); const int Rb = ((R & ~31) + perm32(R & 31));
        voffA[i] = (unsigned)(R * K + C) * 2u; voffB[i] = (unsigned)(Rb * K + C) * 2u; }
    const size_t kstep = (size_t)(BK * 2);
    const size_t hstep = (size_t)HALF * K * 2;
    const size_t tstep = 2 * hstep;
    const unsigned ldsw = (unsigned)wid * 1024u;
    const int aoff = lds_byte(wr * 64 + fr, fq * 8), boff = lds_byte(wc * 32 + fr, fq * 8);
#define PG8_SA(b, h) (((b) * 2 + (h)) * HTB)
#define PG8_SB(b, h) ((4 + (b) * 2 + (h)) * HTB)
#define PG8_STAGE(bufoff, gbase, voff) do { _Pragma("unroll") for (int _i = 0; _i < 2; ++_i) \
        __builtin_amdgcn_global_load_lds((const unsigned*)((const char*)(gbase) + (voff)[_i]), (LAS unsigned*)(lds + (bufoff) + ldsw + _i * 8192), 16, 0, 0); } while (0)
#define PG8_LDA(dst, b, h) do { _Pragma("unroll") for (int m = 0; m < 4; ++m) _Pragma("unroll") for (int k = 0; k < 2; ++k) dst[m][k] = *(const LAS bf16x8*)(lds + PG8_SA(b, h) + aoff + m * 2048 + k * 1024); } while (0)
#define PG8_LDB(dst, b, h) do { _Pragma("unroll") for (int n = 0; n < 2; ++n) _Pragma("unroll") for (int k = 0; k < 2; ++k) dst[n][k] = *(const LAS bf16x8*)(lds + PG8_SB(b, h) + boff + n * 2048 + k * 1024); } while (0)
#define PG8_MMA(ai, bj, At, Bt) do { __builtin_amdgcn_s_setprio(1); _Pragma("unroll") for (int m = 0; m < 4; ++m) _Pragma("unroll") for (int n = 0; n < 2; ++n) _Pragma("unroll") for (int k = 0; k < 2; ++k) \
        acc[ai][bj][m][n] = __builtin_amdgcn_mfma_f32_16x16x32_bf16(Bt[n][k], At[m][k], acc[ai][bj][m][n], 0, 0, 0); __builtin_amdgcn_s_setprio(0); } while (0)
#define PG8_WAIT_V(n) asm volatile("s_waitcnt vmcnt(" #n ")" ::: "memory")
#define PG8_WAIT_L(n) asm volatile("s_waitcnt lgkmcnt(" #n ")" ::: "memory")
#define PG8_BAR __builtin_amdgcn_s_barrier()
#define PG8_SCHED __builtin_amdgcn_sched_barrier(0)
    Unit cur, nxt; int ui = 0;
    if (!S.next(0, cur)) return;
    f32x4 acc[2][2][4][2];
#pragma unroll
    for (int a = 0; a < 2; ++a)
#pragma unroll
        for (int b = 0; b < 2; ++b)
#pragma unroll
            for (int m = 0; m < 4; ++m)
#pragma unroll
                for (int n = 0; n < 2; ++n) acc[a][b][m][n] = (f32x4){0.f, 0.f, 0.f, 0.f};
    bf16x8 At[4][2], B0[2][2], B1[2][2];
    const char* cA = (const char*)g.A + (size_t)cur.pm * tstep + (size_t)cur.part * g.partA; const char* cB = (const char*)g.Bt + (size_t)cur.pn * tstep + (size_t)cur.part * g.partB;
    PG8_STAGE(PG8_SB(0, 0), cB, voffB); PG8_STAGE(PG8_SB(0, 1), cB + hstep, voffB); PG8_STAGE(PG8_SA(0, 0), cA, voffA); PG8_STAGE(PG8_SA(0, 1), cA + hstep, voffA);
    PG8_STAGE(PG8_SB(1, 0), cB + kstep, voffB); PG8_STAGE(PG8_SA(1, 0), cA + kstep, voffA); PG8_STAGE(PG8_SB(1, 1), cB + hstep + kstep, voffB);
    if (wr == 1) PG8_BAR;
    PG8_WAIT_V(8); PG8_BAR;
    PG8_WAIT_V(6); PG8_BAR;
    for (;;) {
        const bool has_next = S.next(ui + 1, nxt);
        const char* nA = has_next ? (const char*)g.A + (size_t)nxt.pm * tstep + (size_t)nxt.part * g.partA : cA; const char* nB = has_next ? (const char*)g.Bt + (size_t)nxt.pn * tstep + (size_t)nxt.part * g.partB : cB;
        for (int t = 0; t < nt; t += 2) {
            const bool last = (t == nt - 2);
            const char* a1 = cA + (size_t)(t + 1) * kstep;
            const char* a2 = last ? nA : cA + (size_t)(t + 2) * kstep; const char* b2 = last ? nB : cB + (size_t)(t + 2) * kstep;
            const char* a3 = a2 + kstep; const char* b3 = b2 + kstep;
            PG8_LDB(B0, 0, 0); PG8_LDB(B1, 0, 1); PG8_SCHED; PG8_LDA(At, 0, 0); PG8_STAGE(PG8_SA(1, 1), a1 + hstep, voffA);
            PG8_WAIT_V(8); PG8_WAIT_L(0); PG8_BAR; PG8_MMA(0, 0, At, B0); PG8_MMA(0, 1, At, B1); PG8_BAR; PG8_SCHED;
            PG8_LDA(At, 0, 1); PG8_STAGE(PG8_SB(0, 0), b2, voffB); PG8_STAGE(PG8_SB(0, 1), b2 + hstep, voffB); PG8_STAGE(PG8_SA(0, 0), a2, voffA);
            PG8_WAIT_V(8); PG8_WAIT_L(0); PG8_BAR; PG8_MMA(1, 0, At, B0); PG8_MMA(1, 1, At, B1); PG8_BAR; PG8_SCHED;
            PG8_LDB(B0, 1, 0); PG8_LDB(B1, 1, 1); PG8_SCHED; PG8_LDA(At, 1, 0); PG8_STAGE(PG8_SA(0, 1), a2 + hstep, voffA);
            PG8_WAIT_V(8); PG8_WAIT_L(0); PG8_BAR; PG8_MMA(0, 0, At, B0); PG8_MMA(0, 1, At, B1); PG8_BAR; PG8_SCHED;
            PG8_LDA(At, 1, 1); PG8_STAGE(PG8_SB(1, 0), b3, voffB); PG8_STAGE(PG8_SB(1, 1), b3 + hstep, voffB); PG8_STAGE(PG8_SA(1, 0), a3, voffA);
            PG8_WAIT_V(8); PG8_WAIT_L(0); PG8_BAR; PG8_MMA(1, 0, At, B0); PG8_MMA(1, 1, At, B1); PG8_BAR; PG8_SCHED;
        }
        if (wr == 0) PG8_BAR;
        { Unit eu = cur; int ewr = wr, ewc = wc, efr = fr, efq = fq;
          asm volatile("" : "+s"(eu.pm), "+s"(eu.pn), "+s"(eu.part), "+s"(ewr), "+s"(ewc), "+v"(efr), "+v"(efq));
          E(acc, eu, ewr, ewc, efr, efq); }
        if (!has_next) break;
        if (!E.keep(cur)) {
#pragma unroll
        for (int a = 0; a < 2; ++a)
#pragma unroll
            for (int b = 0; b < 2; ++b)
#pragma unroll
                for (int m = 0; m < 4; ++m)
#pragma unroll
                    for (int n = 0; n < 2; ++n) acc[a][b][m][n] = (f32x4){0.f, 0.f, 0.f, 0.f};
        }
        cur = nxt; cA = nA; cB = nB; ++ui;
        if (wr == 1) PG8_BAR;
    }
    PG8_WAIT_V(0);
    PG8_BAR;
#undef PG8_SA
#undef PG8_SB
#undef PG8_STAGE
#undef PG8_LDA
#undef PG8_LDB
#undef PG8_MMA
#undef PG8_WAIT_V
#undef PG8_WAIT_L
#undef PG8_BAR
#undef PG8_SCHED
}
}
using pg8::cvt_pk_bf16;

__device__ __forceinline__ unsigned xb_ld(unsigned* p)              { return __hip_atomic_load(p, __ATOMIC_RELAXED, __HIP_MEMORY_SCOPE_AGENT); }
__device__ __forceinline__ unsigned xb_add(unsigned* p, unsigned v) { return __hip_atomic_fetch_add(p, v, __ATOMIC_RELAXED, __HIP_MEMORY_SCOPE_AGENT); }
__device__ __forceinline__ float bf_lo(unsigned u) { return __uint_as_float(u << 16); }
__device__ __forceinline__ float bf_hi(unsigned u) { return __uint_as_float(u & 0xffff0000u); }
__device__ __forceinline__ float sigm_f(float x) { return __builtin_amdgcn_rcpf(1.f + __builtin_amdgcn_exp2f(-LOG2E * x)); }
__device__ __forceinline__ float silu_f(float x) { return x * sigm_f(x); }
__device__ __forceinline__ f32x4 sigm4(const f32x4 v) { f32x4 r; r.x = sigm_f(v.x); r.y = sigm_f(v.y); r.z = sigm_f(v.z); r.w = sigm_f(v.w); return r; }
__device__ __forceinline__ f32x4 onepexp4(const f32x4 v) { f32x4 r; r.x = 1.f + __builtin_amdgcn_exp2f(-LOG2E * v.x); r.y = 1.f + __builtin_amdgcn_exp2f(-LOG2E * v.y); r.z = 1.f + __builtin_amdgcn_exp2f(-LOG2E * v.z); r.w = 1.f + __builtin_amdgcn_exp2f(-LOG2E * v.w); return r; }
__device__ __forceinline__ f32x4 rcp4(const f32x4 v) { f32x4 r; r.x = __builtin_amdgcn_rcpf(v.x); r.y = __builtin_amdgcn_rcpf(v.y); r.z = __builtin_amdgcn_rcpf(v.z); r.w = __builtin_amdgcn_rcpf(v.w); return r; }
__device__ __forceinline__ void gate4(const f32x4 ga, const f32x4 gb, f32x4& r, f32x4& sb) { const f32x4 ea = onepexp4(ga), eb = onepexp4(gb); sb = rcp4(eb); r = rcp4(ea) * eb; }
__device__ __forceinline__ int rowpos(int row) { return row < R_SAMPLE ? (row > R_META ? row - R_META : 0) : (row < R_END ? 16384 + ((row - R_SAMPLE) & 7) : 0); }
__device__ __forceinline__ u32x4 pack8(const f32x4 a, const f32x4 b) { u32x4 w; w.x = cvt_pk_bf16(a[0], a[1]); w.y = cvt_pk_bf16(a[2], a[3]); w.z = cvt_pk_bf16(b[0], b[1]); w.w = cvt_pk_bf16(b[2], b[3]); return w; }

struct Epi1 {
    bf16_t *Q, *Kb, *Vt, *SZA, *BZ, *U, *SGA, *SGB; const float *rope, *qnw, *knw; float* out;
    __device__ __forceinline__ bool keep(const pg8::Unit&) const { return false; }
    __device__ __forceinline__ void operator()(f32x4 (&acc)[2][2][4][2], const pg8::Unit& u, int wr, int wc, int fr, int fq) const {
        const int pn = u.pn, row0 = u.pm * 256 + wr * 64 + fr;
        if (pn < 5) {
            const bool isq = pn < 4; const float* nw = isq ? qnw : knw;
            f32x4 w[2][2];
#pragma unroll
            for (int bj = 0; bj < 2; ++bj)
#pragma unroll
                for (int n = 0; n < 2; ++n) w[bj][n] = *(const f32x4*)(nw + 32 * bj + 8 * fq + 4 * n);
            const float sc = isq ? C2 : 1.f;
#pragma unroll
            for (int ai = 0; ai < 2; ++ai)
#pragma unroll
                for (int m = 0; m < 4; ++m) {
                    const int row = row0 + ai * 128 + m * 16;
                    float ss = 0.f;
#pragma unroll
                    for (int bj = 0; bj < 2; ++bj)
#pragma unroll
                        for (int n = 0; n < 2; ++n) { const f32x4 x = acc[ai][bj][m][n]; ss += (x[0] * x[0] + x[1] * x[1]) + (x[2] * x[2] + x[3] * x[3]); }
                    ss += __shfl_xor(ss, 16); ss += __shfl_xor(ss, 32);
                    const float rinv = 1.0f / sqrtf(ss * (1.f / 64.f) + EPS);
                    const float* rp = rope + (size_t)rowpos(row) * 64 + 8 * fq;
                    f32x4 o1[2], o2[2];
#pragma unroll
                    for (int n = 0; n < 2; ++n) {
                        const f32x4 cs = *(const f32x4*)(rp + 4 * n), sn = *(const f32x4*)(rp + 32 + 4 * n);
                        const f32x4 x1 = acc[ai][0][m][n] * rinv * w[0][n], x2 = acc[ai][1][m][n] * rinv * w[1][n];
                        o1[n] = (x1 * cs - x2 * sn) * sc; o2[n] = (x2 * cs + x1 * sn) * sc;
                    }
                    if (isq) {
                        bf16_t* p = Q + (size_t)row * DM + 64 * (4 * pn + wc) + 8 * fq;
                        *(u32x4*)p = pack8(o1[0], o1[1]); *(u32x4*)(p + 32) = pack8(o2[0], o2[1]);
                    } else {
                        bf16_t* p = Kb + (size_t)row * 256 + 64 * wc + 8 * fq;
                        *(u32x4*)p = pack8(o1[0], o1[1]); *(u32x4*)(p + 32) = pack8(o2[0], o2[1]);
                        if (u.pm >= 64) {
                            float* d = nullptr;
                            if (row >= 16384 && row < R_SAMPLE) d = out + O_NKP + (size_t)(row - 16384) * 256;
                            else if (row >= R_SAMPLE && row < R_END) { const int sr = row - R_SAMPLE; d = out + O_NKS + ((size_t)(sr >> 3) * 128 + 120 + (sr & 7)) * 256; }
                            if (d) { d += 64 * wc + 8 * fq; *(f32x4*)d = o1[0]; *(f32x4*)(d + 4) = o1[1]; *(f32x4*)(d + 32) = o2[0]; *(f32x4*)(d + 36) = o2[1]; }
                        }
                    }
                }
        } else if (pn == 5) {
#pragma unroll
            for (int ai = 0; ai < 2; ++ai)
#pragma unroll
                for (int m = 0; m < 4; ++m) {
                    const int row = row0 + ai * 128 + m * 16;
                    float* d = nullptr;
                    if (u.pm >= 64) {
                        if (row >= 16384 && row < R_SAMPLE) d = out + O_NVP + (size_t)(row - 16384) * 256;
                        else if (row >= R_SAMPLE && row < R_END) { const int sr = row - R_SAMPLE; d = out + O_NVS + ((size_t)(sr >> 3) * 128 + 120 + (sr & 7)) * 256; }
                    }
#pragma unroll
                    for (int bj = 0; bj < 2; ++bj)
#pragma unroll
                        for (int n = 0; n < 2; ++n) {
                            const int c = 128 * bj + 32 * wc + 8 * fq + 4 * n; const f32x4 x = acc[ai][bj][m][n];
                            const unsigned p0 = cvt_pk_bf16(x[0], x[1]), p1 = cvt_pk_bf16(x[2], x[3]);
                            bf16_t* vp = Vt + (size_t)c * MROWS + row;
                            vp[0] = (bf16_t)(p0 & 0xffffu); vp[MROWS] = (bf16_t)(p0 >> 16); vp[2 * (size_t)MROWS] = (bf16_t)(p1 & 0xffffu); vp[3 * (size_t)MROWS] = (bf16_t)(p1 >> 16);
                            if (d) *(f32x4*)(d + c) = x;
                        }
                }
        } else if (pn >= 10 && pn < 26) {
            const int ch = 64 * (pn - 10) + 16 * wc + 4 * fq;
#pragma unroll
            for (int ai = 0; ai < 2; ++ai)
#pragma unroll
                for (int m = 0; m < 4; ++m) {
                    const int row = row0 + ai * 128 + m * 16;
                    const f32x4 b = acc[ai][0][m][0], c = acc[ai][0][m][1], hc = acc[ai][1][m][0], zb = acc[ai][1][m][1];
                    const f32x4 uu = c * hc, bz = b * zb * sigm4(zb);
                    u32x2 wu, wb; wu.x = cvt_pk_bf16(uu[0], uu[1]); wu.y = cvt_pk_bf16(uu[2], uu[3]); wb.x = cvt_pk_bf16(bz[0], bz[1]); wb.y = cvt_pk_bf16(bz[2], bz[3]);
                    *(u32x2*)(U + (size_t)row * DM + ch) = wu; *(u32x2*)(BZ + (size_t)row * DM + ch) = wb;
                    if (u.pm >= 64) {
                        if (row == 16510 || row == 16511) *(f32x4*)(out + O_NCP + (size_t)(row - 16510) * DM + ch) = uu;
                        else if (row >= R_SAMPLE && row < R_END && ((row - R_SAMPLE) & 7) >= 6) { const int sr = row - R_SAMPLE; *(f32x4*)(out + O_NCS + ((size_t)(sr >> 3) * 2 + ((sr & 7) - 6)) * DM + ch) = uu; }
                    }
                }
        } else if (pn < 10) {
            const int col0 = (pn - 6) * 256 + 32 * wc + 8 * fq;
#pragma unroll
            for (int ai = 0; ai < 2; ++ai)
#pragma unroll
                for (int m = 0; m < 4; ++m) {
                    bf16_t* rowp = SZA + (size_t)(row0 + ai * 128 + m * 16) * DM + col0;
#pragma unroll
                    for (int bj = 0; bj < 2; ++bj) {
                        const f32x4 v0 = acc[ai][bj][m][0], v1 = acc[ai][bj][m][1];
                        *(u32x4*)(rowp + bj * 128) = pack8(sigm4(v0) * v0, sigm4(v1) * v1);
                    }
                }
        } else {
            const int col0 = (pn - 26) * 128 + 32 * wc + 8 * fq;
#pragma unroll
            for (int ai = 0; ai < 2; ++ai)
#pragma unroll
                for (int m = 0; m < 4; ++m) {
                    const size_t off = (size_t)(row0 + ai * 128 + m * 16) * DM + col0;
#pragma unroll
                    for (int n = 0; n < 2; ++n) {
                        f32x4 r0, s0; gate4(acc[ai][0][m][n], acc[ai][1][m][n], r0, s0);
                        u32x2 wr_, ws_; wr_.x = cvt_pk_bf16(r0.x, r0.y); wr_.y = cvt_pk_bf16(r0.z, r0.w); ws_.x = cvt_pk_bf16(s0.x, s0.y); ws_.y = cvt_pk_bf16(s0.z, s0.w);
                        *(u32x2*)(SGA + off + 4 * n) = wr_; *(u32x2*)(SGB + off + 4 * n) = ws_;
                        __builtin_amdgcn_sched_barrier(0);
                    }
                }
        }
    }
};

struct Epi2 {
    const bf16_t *SGA, *SGB; bf16_t* MIX;
    __device__ __forceinline__ bool keep(const pg8::Unit& u) const { return u.part == 0; }
    __device__ __forceinline__ void operator()(f32x4 (&acc)[2][2][4][2], const pg8::Unit& u, int wr, int wc, int fr, int fq) const {
        const int row0 = u.pm * 256 + wr * 64 + fr, col0 = u.pn * 256 + 32 * wc + 8 * fq;
        const bf16_t* p0 = SGA; const bf16_t* p1 = SGB; asm volatile("" : "+s"(p0), "+s"(p1));
        const bf16_t* G = u.part == 0 ? p0 : p1;
        u32x4 gv[2][4][2];
#pragma unroll
        for (int ai = 0; ai < 2; ++ai)
#pragma unroll
            for (int m = 0; m < 4; ++m)
#pragma unroll
                for (int bj = 0; bj < 2; ++bj) gv[ai][m][bj] = *(const u32x4*)(G + (size_t)(row0 + ai * 128 + m * 16) * DM + col0 + bj * 128);
#pragma unroll
        for (int ai = 0; ai < 2; ++ai)
#pragma unroll
            for (int m = 0; m < 4; ++m) {
                const size_t off = (size_t)(row0 + ai * 128 + m * 16) * DM + col0;
#pragma unroll
                for (int bj = 0; bj < 2; ++bj) {
                    const u32x4 gb = gv[ai][m][bj];
                    const f32x4 b0 = {bf_lo(gb.x), bf_hi(gb.x), bf_lo(gb.y), bf_hi(gb.y)}, b1 = {bf_lo(gb.z), bf_hi(gb.z), bf_lo(gb.w), bf_hi(gb.w)};
                    if (u.part == 0) { acc[ai][bj][m][0] = acc[ai][bj][m][0] * b0; acc[ai][bj][m][1] = acc[ai][bj][m][1] * b1; }
                    else *(u32x4*)(MIX + off + bj * 128) = pack8(acc[ai][bj][m][0] * b0, acc[ai][bj][m][1] * b1);
                }
            }
    }
};

template <bool GATE> struct EpiPart {
    const bf16_t* SGA; float* scr; const bf16_t* SGB;
    __device__ __forceinline__ bool keep(const pg8::Unit&) const { return false; }
    __device__ __forceinline__ void operator()(f32x4 (&acc)[2][2][4][2], const pg8::Unit& u, int wr, int wc, int fr, int fq) const {
        const int row0 = u.pm * 256 + wr * 64 + fr, col0 = u.pn * 256 + 32 * wc + 8 * fq, lr0 = wr * 64 + fr, lc0 = 32 * wc + 8 * fq;
#pragma unroll
        for (int ai = 0; ai < 2; ++ai)
#pragma unroll
            for (int m = 0; m < 4; ++m) {
                const size_t off = (size_t)(row0 + ai * 128 + m * 16) * DM + col0;
                bf16_t* sp = (bf16_t*)scr + (size_t)(lr0 + ai * 128 + m * 16) * 256 + lc0;
#pragma unroll
                for (int bj = 0; bj < 2; ++bj) {
                    f32x4 a0 = {1.f, 1.f, 1.f, 1.f}, a1 = a0;
                    if (GATE) { const u32x4 ga = *(const u32x4*)(SGA + off + bj * 128), gb = *(const u32x4*)(SGB + off + bj * 128);
                        a0 = (f32x4){bf_lo(ga.x) * bf_lo(gb.x), bf_hi(ga.x) * bf_hi(gb.x), bf_lo(ga.y) * bf_lo(gb.y), bf_hi(ga.y) * bf_hi(gb.y)};
                        a1 = (f32x4){bf_lo(ga.z) * bf_lo(gb.z), bf_hi(ga.z) * bf_hi(gb.z), bf_lo(ga.w) * bf_lo(gb.w), bf_hi(ga.w) * bf_hi(gb.w)}; }
                    *(u32x4*)(sp + bj * 128) = pack8(acc[ai][bj][m][0] * a0, acc[ai][bj][m][1] * a1);
                }
            }
    }
};
__device__ __forceinline__ void wait_count(unsigned* cnt, unsigned want) {
    unsigned sp = 0; while (xb_ld(cnt) < want) { __builtin_amdgcn_s_sleep(1); if (++sp > (1u << 22)) break; }
    __builtin_amdgcn_fence(__ATOMIC_ACQUIRE, "agent");
    asm volatile("s_waitcnt vmcnt(0)" ::: "memory");
}
struct Epi2b {
    const bf16_t* SGB; const float* scr; bf16_t* MIX; unsigned* cnt;
    __device__ __forceinline__ bool keep(const pg8::Unit&) const { return false; }
    __device__ __forceinline__ void operator()(f32x4 (&acc)[2][2][4][2], const pg8::Unit& u, int wr, int wc, int fr, int fq) const {
        const int row0 = u.pm * 256 + wr * 64 + fr, col0 = u.pn * 256 + 32 * wc + 8 * fq, lr0 = wr * 64 + fr, lc0 = 32 * wc + 8 * fq;
        u32x4 gbv[4][2];
#pragma unroll
        for (int m = 0; m < 4; ++m)
#pragma unroll
            for (int bj = 0; bj < 2; ++bj) gbv[m][bj] = *(const u32x4*)(SGB + (size_t)(row0 + m * 16) * DM + col0 + bj * 128);
        wait_count(cnt, 1u);
#pragma unroll
        for (int ai = 0; ai < 2; ++ai) {
            u32x4 ppv[4][2];
#pragma unroll
            for (int m = 0; m < 4; ++m) { const bf16_t* sp = (const bf16_t*)scr + (size_t)(lr0 + ai * 128 + m * 16) * 256 + lc0;
#pragma unroll
                for (int bj = 0; bj < 2; ++bj) { ppv[m][bj] = *(const u32x4*)(sp + bj * 128); if (ai == 1) gbv[m][bj] = *(const u32x4*)(SGB + (size_t)(row0 + 128 + m * 16) * DM + col0 + bj * 128); } }
#pragma unroll
            for (int m = 0; m < 4; ++m) { const size_t off = (size_t)(row0 + ai * 128 + m * 16) * DM + col0;
#pragma unroll
                for (int bj = 0; bj < 2; ++bj) {
                    const u32x4 gb = gbv[m][bj], pp = ppv[m][bj];
                    const f32x4 b0 = {bf_lo(gb.x), bf_hi(gb.x), bf_lo(gb.y), bf_hi(gb.y)}, b1 = {bf_lo(gb.z), bf_hi(gb.z), bf_lo(gb.w), bf_hi(gb.w)};
                    const f32x4 p0 = {bf_lo(pp.x), bf_hi(pp.x), bf_lo(pp.y), bf_hi(pp.y)}, p1 = {bf_lo(pp.z), bf_hi(pp.z), bf_lo(pp.w), bf_hi(pp.w)};
                    *(u32x4*)(MIX + off + bj * 128) = pack8(p0 + acc[ai][bj][m][0] * b0, p1 + acc[ai][bj][m][1] * b1);
                } }
            asm volatile("" ::: "memory");
        }
    }
};
struct Epi3b {
    const float *xp, *xs; float* y; const float* scr; unsigned* cnt;
    __device__ __forceinline__ bool keep(const pg8::Unit&) const { return false; }
    __device__ __forceinline__ void operator()(f32x4 (&acc)[2][2][4][2], const pg8::Unit& u, int wr, int wc, int fr, int fq) const {
        const int row0 = u.pm * 256 + wr * 64 + fr, col0 = u.pn * 256 + 32 * wc + 8 * fq, lr0 = wr * 64 + fr, lc0 = 32 * wc + 8 * fq;
        wait_count(cnt, 1u);
#pragma unroll
        for (int ai = 0; ai < 2; ++ai)
#pragma unroll
            for (int m = 0; m < 4; ++m) {
                const int gr = row0 + ai * 128 + m * 16;
                const float* xr = (gr < 16384 ? xp + (size_t)gr * DM : xs + (size_t)(gr - 16384) * DM) + col0;
                float* yr = y + (size_t)gr * DM + col0;
                const bf16_t* sp = (const bf16_t*)scr + (size_t)(lr0 + ai * 128 + m * 16) * 256 + lc0;
#pragma unroll
                for (int bj = 0; bj < 2; ++bj) {
                    const u32x4 pp = *(const u32x4*)(sp + bj * 128); const f32x4 p0 = {bf_lo(pp.x), bf_hi(pp.x), bf_lo(pp.y), bf_hi(pp.y)}, p1 = {bf_lo(pp.z), bf_hi(pp.z), bf_lo(pp.w), bf_hi(pp.w)};
                    *(f32x4*)(yr + bj * 128) = *(const f32x4*)(xr + bj * 128) + p0 + acc[ai][bj][m][0]; *(f32x4*)(yr + bj * 128 + 4) = *(const f32x4*)(xr + bj * 128 + 4) + p1 + acc[ai][bj][m][1];
                }
            }
    }
};
__device__ __forceinline__ void publish_count(unsigned* cnt) {
    asm volatile("s_waitcnt vmcnt(0)" ::: "memory");
    __syncthreads();
    if (threadIdx.x == 0) { __builtin_amdgcn_fence(__ATOMIC_RELEASE, "agent"); asm volatile("s_waitcnt vmcnt(0)" ::: "memory"); xb_add(cnt, 1u); }
}

struct Epi3 {
    const float *xp, *xs; float* y;
    __device__ __forceinline__ bool keep(const pg8::Unit&) const { return false; }
    __device__ __forceinline__ void operator()(f32x4 (&acc)[2][2][4][2], const pg8::Unit& u, int wr, int wc, int fr, int fq) const {
        const int row0 = u.pm * 256 + wr * 64 + fr, col0 = u.pn * 256 + 32 * wc + 8 * fq;
#pragma unroll
        for (int ai = 0; ai < 2; ++ai) {
            f32x4 xv[4][2][2];
#pragma unroll
            for (int m = 0; m < 4; ++m) {
                const int gr = row0 + ai * 128 + m * 16;
                const float* xr = (gr < 16384 ? xp + (size_t)gr * DM : xs + (size_t)(gr - 16384) * DM) + col0;
#pragma unroll
                for (int bj = 0; bj < 2; ++bj)
#pragma unroll
                    for (int n = 0; n < 2; ++n) xv[m][bj][n] = *(const f32x4*)(xr + bj * 128 + 4 * n);
            }
#pragma unroll
            for (int m = 0; m < 4; ++m) {
                float* yr = y + (size_t)(row0 + ai * 128 + m * 16) * DM + col0;
#pragma unroll
                for (int bj = 0; bj < 2; ++bj)
#pragma unroll
                    for (int n = 0; n < 2; ++n) *(f32x4*)(yr + bj * 128 + 4 * n) = xv[m][bj][n] + acc[ai][bj][m][n];
            }
            asm volatile("" ::: "memory");
        }
    }
};

__device__ __forceinline__ float wave_sum(float v) {
#pragma unroll
    for (int o = 1; o < 64; o <<= 1) v += __shfl_xor(v, o);
    return v;
}
__device__ __forceinline__ int win_orig_col(int n) {
    const int pn = n >> 8, c = n & 255;
    if (pn < 5) { const int bj = c >> 7, wc = (c >> 5) & 3, j = c & 31; return 64 * (4 * pn + wc) + 32 * bj + j; }
    if (pn >= 10 && pn < 26) { const int t = pn - 10, bj = c >> 7, wc = (c >> 5) & 3, fq = (c >> 3) & 3, nn = (c >> 2) & 1, e = c & 3; return 2560 + 1024 * (2 * bj + nn) + 64 * t + 16 * wc + 4 * fq + e; }
    if (pn >= 26) { const int t = pn - 26, bj = c >> 7, rest = c & 127; return 6656 + 1024 * bj + 128 * t + rest; }
    return n;
}
template <bool PERMUTE>
__device__ __forceinline__ void p0_transpose_item(const float* W, int K, int N, bf16_t* WT, LAS float* scr, int item, int lane) {
    const int nblk = N / 32, kb = item / nblk, nb = item % nblk, k0 = 64 * kb, n0 = 32 * nb;
    const int ncol = PERMUTE ? win_orig_col(n0 + (lane & 31)) : n0 + (lane & 31);
    float tv[32];
#pragma unroll
    for (int i = 0; i < 32; ++i) tv[i] = __builtin_nontemporal_load(W + (size_t)(k0 + 2 * i + (lane >> 5)) * N + ncol);
#pragma unroll
    for (int i = 0; i < 32; ++i) scr[(2 * i + (lane >> 5)) * 33 + (lane & 31)] = tv[i];
    asm volatile("s_waitcnt lgkmcnt(0)" ::: "memory");
    const int c = lane & 7;
#pragma unroll
    for (int j = 0; j < 4; ++j) { const int n = (lane >> 3) + 8 * j; const LAS float* s = scr + (8 * c) * 33 + n;
        u32x4 o; o.x = cvt_pk_bf16(s[0 * 33], s[1 * 33]); o.y = cvt_pk_bf16(s[2 * 33], s[3 * 33]); o.z = cvt_pk_bf16(s[4 * 33], s[5 * 33]); o.w = cvt_pk_bf16(s[6 * 33], s[7 * 33]);
        *(u32x4*)(WT + (size_t)(n0 + n) * K + k0 + 8 * c) = o; }
    asm volatile("s_waitcnt lgkmcnt(0)" ::: "memory");
}

struct Args { const float* in[15]; float* out; unsigned char* ws; int ph_lo, ph_hi; };

__device__ __forceinline__ void p0_prologue(const Args& a, LAS unsigned char* lds, int tid, int lane, int wave, int G) {
    LAS float* scr = (LAS float*)(lds + wave * 16384);
    const int gw = blockIdx.x * 8 + wave, NGW = G * 8;
    bf16_t* WIN = (bf16_t*)(a.ws + WS_WIN); bf16_t* WA = (bf16_t*)(a.ws + WS_WA); bf16_t* WB = (bf16_t*)(a.ws + WS_WB); bf16_t* WO = (bf16_t*)(a.ws + WS_WO);
    constexpr int I_IN = 16 * (NIN / 32), I_SQ = 16 * 32, NITEMS = I_IN + 3 * I_SQ;
    for (int it = gw; it < NITEMS; it += NGW) {
        int r = it;
        if (r < I_IN) { p0_transpose_item<true>(a.in[7], DM, NIN, WIN, scr, r, lane); continue; } r -= I_IN;
        if (r < I_SQ) { p0_transpose_item<false>(a.in[12], DM, DM, WA, scr, r, lane); continue; } r -= I_SQ;
        if (r < I_SQ) { p0_transpose_item<false>(a.in[13], DM, DM, WB, scr, r, lane); continue; } r -= I_SQ;
        p0_transpose_item<false>(a.in[14], DM, DM, WO, scr, r, lane);
    }
    bf16_t* XN = (bf16_t*)(a.ws + WS_B0);
    const f32x4* nwp = (const f32x4*)a.in[6] + lane;
    f32x4 nw[4];
#pragma unroll
    for (int j = 0; j < 4; ++j) nw[j] = nwp[64 * j];
    for (int m0 = gw; m0 < MROWS; m0 += 4 * NGW) {
        const float* src[4]; f32x4 v[4][4];
#pragma unroll
        for (int q = 0; q < 4; ++q) {
            const int m = m0 + q * NGW; src[q] = nullptr;
            if (m >= R_PROMPT && m < R_SAMPLE) src[q] = a.in[0] + (size_t)(m - R_PROMPT) * DM;
            else if (m >= R_SAMPLE && m < R_END) src[q] = a.in[1] + (size_t)(m - R_SAMPLE) * DM;
            else if (m >= R_META && m < R_PROMPT) src[q] = a.in[5] + (size_t)(m - R_META) * DM;
#pragma unroll
            for (int j = 0; j < 4; ++j) v[q][j] = src[q] ? __builtin_nontemporal_load((const f32x4*)src[q] + lane + 64 * j) : (f32x4){0.f, 0.f, 0.f, 0.f};
        }
#pragma unroll
        for (int q = 0; q < 4; ++q) {
            const int m = m0 + q * NGW;
            if (m < MROWS) {
                float s2 = 0.f;
#pragma unroll
                for (int j = 0; j < 4; ++j) s2 += (v[q][j].x * v[q][j].x + v[q][j].y * v[q][j].y) + (v[q][j].z * v[q][j].z + v[q][j].w * v[q][j].w);
                const float r = 1.0f / sqrtf(wave_sum(s2) * (1.f / DM) + EPS);
                unsigned long long* o8 = (unsigned long long*)(XN + (size_t)m * DM) + lane;
#pragma unroll
                for (int j = 0; j < 4; ++j) { const f32x4 y = v[q][j] * r * nw[j]; o8[64 * j] = (unsigned long long)cvt_pk_bf16(y.x, y.y) | ((unsigned long long)cvt_pk_bf16(y.z, y.w) << 32); }
            }
        }
    }
    float* rope = (float*)(a.ws + WS_ROPE);
    for (int i = blockIdx.x * 512 + tid; i < NPOS * 32; i += G * 512) {
        const int pos = i >> 5, j = i & 31;
        double invd = 1.0; for (int q = 0; q < j; ++q) invd *= 0.74989420933245582730;
        const float inv = (float)invd; const float angf = (float)pos * inv; const double ang = (double)angf;
        const double kq = __builtin_rint(ang * 0.63661977236758134308); const int qi = (int)kq;
        double rr = __builtin_fma(-kq, 1.57079632679489655800, ang); rr = __builtin_fma(-kq, 6.12323399573676603587e-17, rr);
        const double r2 = rr * rr;
        double sn = r2 * (1.0 / 6227020800.0) - (1.0 / 39916800.0); sn = sn * r2 + (1.0 / 362880.0); sn = sn * r2 - (1.0 / 5040.0); sn = sn * r2 + (1.0 / 120.0); sn = sn * r2 - (1.0 / 6.0); sn = sn * r2 * rr + rr;
        double cs = r2 * (1.0 / 479001600.0) - (1.0 / 3628800.0); cs = cs * r2 + (1.0 / 40320.0); cs = cs * r2 - (1.0 / 720.0); cs = cs * r2 + (1.0 / 24.0); cs = cs * r2 - 0.5; cs = cs * r2 + 1.0;
        double so, co;
        switch (qi & 3) { case 0: so = sn; co = cs; break; case 1: so = cs; co = -sn; break; case 2: so = -sn; co = -cs; break; default: so = -cs; co = sn; break; }
        rope[(size_t)pos * 64 + j] = (float)co; rope[(size_t)pos * 64 + 32 + j] = (float)so;
    }
}

__device__ __forceinline__ int crow(int r, int hi) { return (r & 3) + 8 * (r >> 2) + 4 * hi; }
__device__ __forceinline__ bf16x8 packp(const f32x16& p, int s) {
    u32x4 w; w.x = cvt_pk_bf16(p[8 * s + 0], p[8 * s + 1]); w.y = cvt_pk_bf16(p[8 * s + 2], p[8 * s + 3]); w.z = cvt_pk_bf16(p[8 * s + 4], p[8 * s + 5]); w.w = cvt_pk_bf16(p[8 * s + 6], p[8 * s + 7]);
    return __builtin_bit_cast(bf16x8, w);
}
__device__ __forceinline__ float sink_softmax5(f32x16 (&S)[5], int qcmp, int hi, float sink2, int minkr) {
    const float NEG = -INFINITY;
#pragma unroll
    for (int r = 0; r < 16; ++r) { const int c = crow(r, hi); if (c < qcmp) S[0][r] = NEG; if (c > qcmp) S[4][r] = NEG; }
    if (minkr > 0) {
#pragma unroll
        for (int kb = 0; kb < 5; ++kb)
#pragma unroll
            for (int r = 0; r < 16; ++r) if (32 * kb + crow(r, hi) < minkr) S[kb][r] = NEG;
    }
    float m = sink2;
#pragma unroll
    for (int kb = 0; kb < 5; ++kb)
#pragma unroll
        for (int r = 0; r < 16; ++r) m = fmaxf(m, S[kb][r]);
    m = fmaxf(m, __shfl_xor(m, 32));
    float l = 0.f;
#pragma unroll
    for (int kb = 0; kb < 5; ++kb)
#pragma unroll
        for (int r = 0; r < 16; ++r) { const float p = __builtin_amdgcn_exp2f(S[kb][r] - m); S[kb][r] = p; l += p; }
    l += __shfl_xor(l, 32);
    l += __builtin_amdgcn_exp2f(sink2 - m);
    return 1.0f / l;
}
__device__ __forceinline__ void attn_store(const f32x16 (&O)[2], float inv_l, int row, int head, int hi, const bf16_t* SZA, bf16_t* QA) {
#pragma unroll
    for (int blk = 0; blk < 2; ++blk)
#pragma unroll
        for (int rr = 0; rr < 4; ++rr) {
            const size_t off = (size_t)row * DM + 64 * head + 32 * blk + 8 * rr + 4 * hi;
            const u32x2 z = *(const u32x2*)(SZA + off);
            u32x2 w; w.x = cvt_pk_bf16(O[blk][4 * rr] * inv_l * bf_lo(z.x), O[blk][4 * rr + 1] * inv_l * bf_hi(z.x)); w.y = cvt_pk_bf16(O[blk][4 * rr + 2] * inv_l * bf_lo(z.y), O[blk][4 * rr + 3] * inv_l * bf_hi(z.y));
            *(u32x2*)(QA + off) = w;
        }
}

__device__ __forceinline__ void attn_prompt_all(LAS unsigned char* lds, int tid, int id0, int G, int idEnd, const bf16_t* Kb, const bf16_t* Vt, bf16_t* QA, const bf16_t* SZA, const float* sinks) {
    const int lane = tid & 63, wid = __builtin_amdgcn_readfirstlane(tid >> 6), ql = lane & 31, hi = lane >> 5;
    LAS unsigned char* Ks = lds; LAS unsigned char* Vs = lds + 27648;
    const int i0 = 32 * (wid & 1);
    u32x4 kst[3], vst[3];
#define ATT_FETCH(id_) do { const int n_ = 1 + ((id_) >> 3), g_ = ((id_) >> 1) & 3, kbase_ = 128 * (n_ - 1) + 64 * ((id_) & 1); \
        _Pragma("unroll") for (int i = 0; i < 3; ++i) { const int ch = tid + 512 * i; \
            { const int row = ch >> 3, c = ch & 7; kst[i] = *(const u32x4*)(Kb + (size_t)(kbase_ + row) * 256 + g_ * 64 + c * 8); } \
            { const int d = ch / 24, c = ch - d * 24; vst[i] = *(const u32x4*)(Vt + (size_t)(g_ * 64 + d) * MROWS + kbase_ + c * 8); } } \
        } while (0)
    int id = id0;
    if (id < idEnd) ATT_FETCH(id);
    for (; id < idEnd; id += G) {
        const int n = 1 + (id >> 3), g = (id >> 1) & 3, half = id & 1;
        const int kbase = 128 * (n - 1) + 64 * half;
#pragma unroll
        for (int i = 0; i < 3; ++i) {
            const int ch = tid + 512 * i;
            { const int row = ch >> 3, c = ch & 7; *(LAS u32x4*)(Ks + row * 144 + c * 16) = kst[i]; }
            { const int d = ch / 24, c = ch - d * 24; LAS u32x2* p = (LAS u32x2*)(Vs + d * 392 + c * 16); p[0] = (u32x2){vst[i].x, vst[i].y}; p[1] = (u32x2){vst[i].z, vst[i].w}; }
        }
        const int hq = 4 * g + (wid >> 1);
        const int qrow = kbase + 128 + i0 + ql;
        bf16x8 qr[4];
#pragma unroll
        for (int d0 = 0; d0 < 4; ++d0) qr[d0] = *(const bf16x8*)(QA + (size_t)qrow * DM + 64 * hq + 16 * d0 + 8 * hi);
        const float sink2 = sinks[hq] * LOG2E;
        __syncthreads();
        u32x2 zz[2][4];
#pragma unroll
        for (int blk = 0; blk < 2; ++blk)
#pragma unroll
            for (int rr = 0; rr < 4; ++rr) zz[blk][rr] = *(const u32x2*)(SZA + (size_t)qrow * DM + 64 * hq + 32 * blk + 8 * rr + 4 * hi);
        if (id + G < idEnd) ATT_FETCH(id + G);
        const int minkr = R_META - (kbase + i0);
        float mrun = sink2, lrun = hi ? 0.f : 1.f;
        f32x16 O[2]; O[0] = (f32x16){}; O[1] = (f32x16){};
#pragma unroll
        for (int kb = 0; kb < 5; ++kb) {
            f32x16 S = (f32x16){};
#pragma unroll
            for (int d0 = 0; d0 < 4; ++d0) { const bf16x8 a = *(const LAS bf16x8*)(Ks + (i0 + 32 * kb + ql) * 144 + (16 * d0 + 8 * hi) * 2); S = __builtin_amdgcn_mfma_f32_32x32x16_bf16(a, qr[d0], S, 0, 0, 0); }
            if (kb == 0) {
#pragma unroll
                for (int r = 0; r < 16; ++r) if (crow(r, hi) < ql) S[r] = -INFINITY;
            }
            if (kb == 4) {
#pragma unroll
                for (int r = 0; r < 16; ++r) if (crow(r, hi) > ql) S[r] = -INFINITY;
            }
            if (minkr > 32 * kb) {
#pragma unroll
                for (int r = 0; r < 16; ++r) if (32 * kb + crow(r, hi) < minkr) S[r] = -INFINITY;
            }
            float mb = S[0];
#pragma unroll
            for (int r = 1; r < 16; ++r) mb = fmaxf(mb, S[r]);
            mb = fmaxf(mb, __shfl_xor(mb, 32));
            const float mn = fmaxf(mrun, mb), alpha = __builtin_amdgcn_exp2f(mrun - mn); mrun = mn;
            float ps = 0.f;
#pragma unroll
            for (int r = 0; r < 16; ++r) { const float p = __builtin_amdgcn_exp2f(S[r] - mn); S[r] = p; ps += p; }
            lrun = lrun * alpha + ps;
            O[0] = O[0] * alpha; O[1] = O[1] * alpha;
#pragma unroll
            for (int s = 0; s < 2; ++s) {
                const bf16x8 pb = packp(S, s);
#pragma unroll
                for (int blk = 0; blk < 2; ++blk) {
                    const LAS unsigned char* vp = Vs + (32 * blk + ql) * 392 + (i0 + 32 * kb + 16 * s + 4 * hi) * 2;
                    const u32x2 lo = *(const LAS u32x2*)vp, hh = *(const LAS u32x2*)(vp + 16);
                    const u32x4 av = {lo.x, lo.y, hh.x, hh.y};
                    O[blk] = __builtin_amdgcn_mfma_f32_32x32x16_bf16(__builtin_bit_cast(bf16x8, av), pb, O[blk], 0, 0, 0);
                }
            }
        }
        lrun += __shfl_xor(lrun, 32);
        const float inv_l = 1.0f / lrun;
#pragma unroll
        for (int blk = 0; blk < 2; ++blk)
#pragma unroll
            for (int rr = 0; rr < 4; ++rr) {
                const size_t off = (size_t)qrow * DM + 64 * hq + 32 * blk + 8 * rr + 4 * hi; const u32x2 z = zz[blk][rr];
                u32x2 w; w.x = cvt_pk_bf16(O[blk][4 * rr] * inv_l * bf_lo(z.x), O[blk][4 * rr + 1] * inv_l * bf_hi(z.x)); w.y = cvt_pk_bf16(O[blk][4 * rr + 2] * inv_l * bf_lo(z.y), O[blk][4 * rr + 3] * inv_l * bf_hi(z.y));
                *(u32x2*)(QA + off) = w;
            }
        __syncthreads();
    }
#undef ATT_FETCH
}

__device__ __forceinline__ bf16x8 cvt8(const f32x4 a, const f32x4 b) { return __builtin_bit_cast(bf16x8, pack8(a, b)); }

__device__ __forceinline__ void attn_sample_unit(int b, int g, int hh, int lane, const float* ck, const float* cv, const bf16_t* Kb, const bf16_t* Vt, bf16_t* QA, const bf16_t* SZA, const float* sinks, float* out) {
    const int ql = lane & 31, hi = lane >> 5, t = ql & 7; const bool cp = (hh == 0);
    const int row = R_SAMPLE + 8 * b + t, head = 4 * g + hh;
    bf16x8 qr[4];
#pragma unroll
    for (int d0 = 0; d0 < 4; ++d0) qr[d0] = *(const bf16x8*)(QA + (size_t)row * DM + 64 * head + 16 * d0 + 8 * hi);
    const float sink2 = sinks[head] * LOG2E;
    const float* ckb = ck + (size_t)b * 128 * 256 + g * 64; const float* cvb = cv + (size_t)b * 128 * 256 + g * 64;
    float* oks = out + O_NKS + (size_t)b * 128 * 256 + g * 64; float* ovs = out + O_NVS + (size_t)b * 128 * 256 + g * 64;
    float m = sink2, l = hi ? 0.f : 1.f;
    f32x16 O[2]; O[0] = (f32x16){}; O[1] = (f32x16){};
    const float NEG = -INFINITY;
#pragma unroll 1
    for (int kb = 0; kb < 5; ++kb) {
        f32x16 S = (f32x16){};
        if (kb < 4) {
            const int s = 32 * kb + ql;
#pragma unroll
            for (int d0 = 0; d0 < 4; ++d0) {
                const float* p = ckb + (size_t)s * 256 + 16 * d0 + 8 * hi; const f32x4 x0 = *(const f32x4*)p, x1 = *(const f32x4*)(p + 4);
                if (cp && s >= 8) { float* o = oks + (size_t)(s - 8) * 256 + 16 * d0 + 8 * hi; *(f32x4*)o = x0; *(f32x4*)(o + 4) = x1; }
                S = __builtin_amdgcn_mfma_f32_32x32x16_bf16(cvt8(x0, x1), qr[d0], S, 0, 0, 0);
            }
        } else {
#pragma unroll
            for (int d0 = 0; d0 < 4; ++d0) {
                u32x4 kv = {0u, 0u, 0u, 0u};
                if (ql < 8) kv = *(const u32x4*)(Kb + (size_t)(R_SAMPLE + 8 * b + ql) * 256 + g * 64 + 16 * d0 + 8 * hi);
                S = __builtin_amdgcn_mfma_f32_32x32x16_bf16(__builtin_bit_cast(bf16x8, kv), qr[d0], S, 0, 0, 0);
            }
        }
        if (kb == 0) {
#pragma unroll
            for (int r = 0; r < 16; ++r) if (crow(r, hi) < t) S[r] = NEG;
        }
        if (kb == 4) {
#pragma unroll
            for (int r = 0; r < 16; ++r) if (crow(r, hi) > t) S[r] = NEG;
        }
        float mb = S[0];
#pragma unroll
        for (int r = 1; r < 16; ++r) mb = fmaxf(mb, S[r]);
        mb = fmaxf(mb, __shfl_xor(mb, 32));
        const float mn = fmaxf(m, mb), alpha = __builtin_amdgcn_exp2f(m - mn); m = mn;
        float ps = 0.f;
#pragma unroll
        for (int r = 0; r < 16; ++r) { const float p = __builtin_amdgcn_exp2f(S[r] - mn); S[r] = p; ps += p; }
        l = l * alpha + ps;
        O[0] = O[0] * alpha; O[1] = O[1] * alpha;
        if (kb < 4) {
#pragma unroll
            for (int s2 = 0; s2 < 2; ++s2) {
                const bf16x8 pb = packp(S, s2);
#pragma unroll
                for (int blk = 0; blk < 2; ++blk) {
                    const int d = 32 * blk + ql;
                    f32x4 v0, v1;
                    const int kk = 32 * kb + 16 * s2 + 4 * hi;
                    const float* vsrc = cvb + (size_t)kk * 256 + d; float* vdst = ovs + (size_t)kk * 256 + d - 8 * 256;
                    v0.x = vsrc[0]; v0.y = vsrc[256]; v0.z = vsrc[512]; v0.w = vsrc[768]; v1.x = vsrc[2048]; v1.y = vsrc[2304]; v1.z = vsrc[2560]; v1.w = vsrc[2816];
                    if (cp && kk >= 8) { vdst[0] = v0.x; vdst[256] = v0.y; vdst[512] = v0.z; vdst[768] = v0.w; }
                    if (cp) { vdst[2048] = v1.x; vdst[2304] = v1.y; vdst[2560] = v1.z; vdst[2816] = v1.w; }
                    O[blk] = __builtin_amdgcn_mfma_f32_32x32x16_bf16(cvt8(v0, v1), pb, O[blk], 0, 0, 0);
                }
            }
        } else {
            const bf16x8 pb = packp(S, 0);
#pragma unroll
            for (int blk = 0; blk < 2; ++blk) {
                const int d = 32 * blk + ql;
                const u32x2 lo = *(const u32x2*)(Vt + (size_t)(g * 64 + d) * MROWS + R_SAMPLE + 8 * b + 4 * hi);
                const u32x4 av = {lo.x, lo.y, 0u, 0u};
                O[blk] = __builtin_amdgcn_mfma_f32_32x32x16_bf16(__builtin_bit_cast(bf16x8, av), pb, O[blk], 0, 0, 0);
            }
        }
    }
    l += __shfl_xor(l, 32);
    if (ql < 8) attn_store(O, 1.0f / l, row, head, hi, SZA, QA);
}

__device__ __forceinline__ void attn_sample_wg(LAS unsigned char* lds, int tid, int id, const float* ck, const float* cv, const bf16_t* Kb, const bf16_t* Vt, bf16_t* QA, const bf16_t* SZA, const float* sinks, float* out) {
    const int lane = tid & 63, wid = __builtin_amdgcn_readfirstlane(tid >> 6), ql = lane & 31, hi = lane >> 5, t = ql & 7;
    const int b = id >> 1, gp = id & 1;
    constexpr int KSG = 160 * 144, VSG = 64 * 328;
    LAS unsigned char* Ks = lds; LAS unsigned char* Vs = lds + 2 * KSG;
    const float* ckb = ck + (size_t)b * 128 * 256 + gp * 128; const float* cvb = cv + (size_t)b * 128 * 256 + gp * 128;
    float* oks = out + O_NKS + (size_t)b * 128 * 256 + gp * 128; float* ovs = out + O_NVS + (size_t)b * 128 * 256 + gp * 128;
#pragma unroll
    for (int i = 0; i < 8; ++i) {
        const int idx = tid + 512 * i, srow = idx >> 5, c4 = idx & 31, gl = c4 >> 4, d = (c4 & 15) * 4;
        const f32x4 k4 = __builtin_nontemporal_load((const f32x4*)(ckb + (size_t)srow * 256 + c4 * 4)), v4 = __builtin_nontemporal_load((const f32x4*)(cvb + (size_t)srow * 256 + c4 * 4));
        if (srow >= 8) { __builtin_nontemporal_store(k4, (f32x4*)(oks + (size_t)(srow - 8) * 256 + c4 * 4)); __builtin_nontemporal_store(v4, (f32x4*)(ovs + (size_t)(srow - 8) * 256 + c4 * 4)); }
        u32x2 kw; kw.x = cvt_pk_bf16(k4.x, k4.y); kw.y = cvt_pk_bf16(k4.z, k4.w);
        *(LAS u32x2*)(Ks + gl * KSG + srow * 144 + d * 2) = kw;
        const unsigned v01 = cvt_pk_bf16(v4.x, v4.y), v23 = cvt_pk_bf16(v4.z, v4.w);
        LAS bf16_t* vp = (LAS bf16_t*)(Vs + gl * VSG + d * 328 + srow * 2);
        vp[0] = (bf16_t)(v01 & 0xffffu); vp[164] = (bf16_t)(v01 >> 16); vp[328] = (bf16_t)(v23 & 0xffffu); vp[492] = (bf16_t)(v23 >> 16);
    }
    if (tid < 128) {
        const int j = tid >> 4, c8 = tid & 15, gl = c8 >> 3, d = (c8 & 7) * 8;
        *(LAS u32x4*)(Ks + gl * KSG + (128 + j) * 144 + d * 2) = *(const u32x4*)(Kb + (size_t)(R_SAMPLE + 8 * b + j) * 256 + (2 * gp + gl) * 64 + d);
    } else if (tid < 256) {
        const int gl = (tid - 128) >> 6, d = (tid - 128) & 63;
        const u32x4 v = *(const u32x4*)(Vt + (size_t)((2 * gp + gl) * 64 + d) * MROWS + R_SAMPLE + 8 * b);
        LAS u32x2* p = (LAS u32x2*)(Vs + gl * VSG + d * 328 + 256); p[0] = (u32x2){v.x, v.y}; p[1] = (u32x2){v.z, v.w};
    } else if (tid < 384) {
        const int gl = (tid - 256) >> 6, d = (tid - 256) & 63;
        LAS u32x2* p = (LAS u32x2*)(Vs + gl * VSG + d * 328 + 272);
#pragma unroll
        for (int q = 0; q < 6; ++q) p[q] = (u32x2){0u, 0u};
    }
    const int gl = wid >> 2, hh = wid & 3, head = 4 * (2 * gp + gl) + hh, row = R_SAMPLE + 8 * b + t;
    bf16x8 qr[4];
#pragma unroll
    for (int d0 = 0; d0 < 4; ++d0) qr[d0] = *(const bf16x8*)(QA + (size_t)row * DM + 64 * head + 16 * d0 + 8 * hi);
    const float sink2 = sinks[head] * LOG2E;
    __syncthreads();
    const LAS unsigned char* Kg = Ks + gl * KSG; const LAS unsigned char* Vg = Vs + gl * VSG;
    f32x16 S[5];
#pragma unroll
    for (int kb = 0; kb < 5; ++kb) {
        S[kb] = (f32x16){};
#pragma unroll
        for (int d0 = 0; d0 < 4; ++d0) { const bf16x8 a = *(const LAS bf16x8*)(Kg + (32 * kb + ql) * 144 + (16 * d0 + 8 * hi) * 2); S[kb] = __builtin_amdgcn_mfma_f32_32x32x16_bf16(a, qr[d0], S[kb], 0, 0, 0); }
    }
    const float inv_l = sink_softmax5(S, t, hi, sink2, 0);
    f32x16 O[2]; O[0] = (f32x16){}; O[1] = (f32x16){};
#pragma unroll
    for (int kb = 0; kb < 5; ++kb)
#pragma unroll
        for (int s2 = 0; s2 < 2; ++s2) {
            const bf16x8 pb = packp(S[kb], s2);
#pragma unroll
            for (int blk = 0; blk < 2; ++blk) {
                const LAS unsigned char* vp = Vg + (32 * blk + ql) * 328 + (32 * kb + 16 * s2 + 4 * hi) * 2;
                const u32x2 lo = *(const LAS u32x2*)vp, h2 = *(const LAS u32x2*)(vp + 16);
                const u32x4 av = {lo.x, lo.y, h2.x, h2.y};
                O[blk] = __builtin_amdgcn_mfma_f32_32x32x16_bf16(__builtin_bit_cast(bf16x8, av), pb, O[blk], 0, 0, 0);
            }
        }
    if (ql < 8) attn_store(O, inv_l, row, head, hi, SZA, QA);
    __syncthreads();
}

__device__ __forceinline__ void conv_pass(int gtid, int nthr, int item_lo, int item_hi, const bf16_t* U, bf16_t* BZ, const float* cw, const float* state) {
    const int ch = (gtid & 127) * 8;
    float w0[8], w1[8], w2[8];
#pragma unroll
    for (int e = 0; e < 8; ++e) { w0[e] = cw[ch + e]; w1[e] = cw[DM + ch + e]; w2[e] = cw[2 * DM + ch + e]; }
    for (int item = item_lo + (gtid >> 7); item < item_hi; item += nthr >> 7) {
        const int r0 = R_PROMPT + 8 * item;
        float um2[8], um1[8];
        if (r0 < R_SAMPLE) {
            const u32x4 a = *(const u32x4*)(U + (size_t)(r0 - 2) * DM + ch), b = *(const u32x4*)(U + (size_t)(r0 - 1) * DM + ch);
            um2[0] = bf_lo(a.x); um2[1] = bf_hi(a.x); um2[2] = bf_lo(a.y); um2[3] = bf_hi(a.y); um2[4] = bf_lo(a.z); um2[5] = bf_hi(a.z); um2[6] = bf_lo(a.w); um2[7] = bf_hi(a.w);
            um1[0] = bf_lo(b.x); um1[1] = bf_hi(b.x); um1[2] = bf_lo(b.y); um1[3] = bf_hi(b.y); um1[4] = bf_lo(b.z); um1[5] = bf_hi(b.z); um1[6] = bf_lo(b.w); um1[7] = bf_hi(b.w);
        } else {
            const float* st = state + (size_t)((r0 - R_SAMPLE) >> 3) * 2 * DM + ch;
#pragma unroll
            for (int e = 0; e < 8; ++e) { um2[e] = st[e]; um1[e] = st[DM + e]; }
        }
#pragma unroll
        for (int i = 0; i < 8; ++i) {
            const size_t off = (size_t)(r0 + i) * DM + ch;
            const u32x4 a = *(const u32x4*)(U + off), z = *(const u32x4*)(BZ + off);
            float uc[8], bz[8], o[8];
            uc[0] = bf_lo(a.x); uc[1] = bf_hi(a.x); uc[2] = bf_lo(a.y); uc[3] = bf_hi(a.y); uc[4] = bf_lo(a.z); uc[5] = bf_hi(a.z); uc[6] = bf_lo(a.w); uc[7] = bf_hi(a.w);
            bz[0] = bf_lo(z.x); bz[1] = bf_hi(z.x); bz[2] = bf_lo(z.y); bz[3] = bf_hi(z.y); bz[4] = bf_lo(z.z); bz[5] = bf_hi(z.z); bz[6] = bf_lo(z.w); bz[7] = bf_hi(z.w);
#pragma unroll
            for (int e = 0; e < 8; ++e) { o[e] = bz[e] * (w0[e] * um2[e] + w1[e] * um1[e] + w2[e] * uc[e]); um2[e] = um1[e]; um1[e] = uc[e]; }
            u32x4 w; w.x = cvt_pk_bf16(o[0], o[1]); w.y = cvt_pk_bf16(o[2], o[3]); w.z = cvt_pk_bf16(o[4], o[5]); w.w = cvt_pk_bf16(o[6], o[7]);
            *(u32x4*)(BZ + off) = w;
        }
    }
}


#define XB_TMO      128
#define XB_XCNT(j)  (256  + 64 * (j))
#define XB_XSUB(j)  (1280 + 64 * (j))
#define XB_XGEN(j)  (2304 + 64 * (j))
#define XB_TOP      3328
#define XB_TOPGEN   3392
#define XCD_BAR_WORDS 3456
#define XB_SPIN_CAP (1u << 18)
__device__ __forceinline__ unsigned xb_xcc_id() { return (unsigned)__builtin_amdgcn_s_getreg((3 << 11) | 20) & 0xFu; }
#define XB_SPIN(cond, bar) do { unsigned _sp = 0; while (cond) { __builtin_amdgcn_s_sleep(1); \
    if ((++_sp & 255u) == 0u) { if (xb_ld(&(bar)[XB_TMO])) break; if (_sp > XB_SPIN_CAP) { atomicAdd(&(bar)[XB_TMO], 1u); break; } } } } while (0)
struct XcdBarrier { unsigned* bar; unsigned x; volatile LAS unsigned* st; };
__device__ __forceinline__ XcdBarrier xcd_barrier_post(unsigned* bar, volatile LAS unsigned* st) {
    XcdBarrier b; b.bar = bar; b.x = xb_xcc_id(); b.st = st;
    if (threadIdx.x == 0) (void)xb_add(&bar[XB_XCNT(b.x)], 1u);
    return b;
}
__device__ __forceinline__ void xcd_barrier_complete(unsigned* bar, unsigned x, unsigned& nloc, unsigned& nx) {
    const unsigned G = gridDim.x * gridDim.y * gridDim.z;
    unsigned sum, cnt, mine, sp = 0u;
    for (;;) {
        sum = 0u; cnt = 0u; mine = 0u;
#pragma unroll
        for (unsigned j = 0; j < 16; ++j) { const unsigned c = xb_ld(&bar[XB_XCNT(j)]); sum += c; cnt += (c > 0u) ? 1u : 0u; mine = (j == x) ? c : mine; }
        if (sum == G) break;
        __builtin_amdgcn_s_sleep(1);
        if ((++sp & 255u) == 0u) { if (xb_ld(&bar[XB_TMO])) break; if (sp > XB_SPIN_CAP) { atomicAdd(&bar[XB_TMO], 1u); break; } }
    }
    nloc = mine > 0u ? mine : 1u; nx = cnt > 0u ? cnt : 1u;
}
__device__ __forceinline__ void xcd_barrier(const XcdBarrier& b) {
    asm volatile("s_waitcnt vmcnt(0)" ::: "memory");
    __syncthreads();
    if (threadIdx.x == 0) {
        unsigned* bar = b.bar;
        __builtin_amdgcn_s_waitcnt(0);
        unsigned nloc = b.st[0], nx = b.st[1];
        if (nloc == 0u) { xcd_barrier_complete(bar, b.x, nloc, nx); b.st[0] = nloc; b.st[1] = nx; }
        const unsigned old = xb_add(&bar[XB_XSUB(b.x)], 1u);
        const unsigned gen = old / nloc;
        if (old + 1u == (gen + 1u) * nloc) {
            __builtin_amdgcn_fence(__ATOMIC_RELEASE, "agent");
            asm volatile("s_waitcnt vmcnt(0)" ::: "memory");
            const unsigned og = xb_add(&bar[XB_TOP], 1u);
            const unsigned tg = og / nx;
            if (og + 1u == (tg + 1u) * nx) xb_add(&bar[XB_TOPGEN], 1u);
            else XB_SPIN(xb_ld(&bar[XB_TOPGEN]) == tg, bar);
            __builtin_amdgcn_fence(__ATOMIC_ACQUIRE, "agent");
            xb_add(&bar[XB_XGEN(b.x)], 1u);
            asm volatile("s_waitcnt vmcnt(0)" ::: "memory");
        } else {
            XB_SPIN(xb_ld(&bar[XB_XGEN(b.x)]) == gen, bar);
            __builtin_amdgcn_fence(__ATOMIC_ACQUIRE, "agent");
            asm volatile("s_waitcnt vmcnt(0)" ::: "memory");
        }
    }
    __syncthreads();
}

__device__ __forceinline__ void sub_barrier(unsigned* word, unsigned nwg) {
    asm volatile("s_waitcnt vmcnt(0)" ::: "memory");
    __syncthreads();
    if (threadIdx.x == 0) {
        __builtin_amdgcn_s_waitcnt(0);
        __builtin_amdgcn_fence(__ATOMIC_RELEASE, "agent");
        asm volatile("s_waitcnt vmcnt(0)" ::: "memory");
        xb_add(word, 1u);
        unsigned sp = 0; while (xb_ld(word) < nwg) { __builtin_amdgcn_s_sleep(1); if (++sp > (1u << 22)) break; }
        __builtin_amdgcn_fence(__ATOMIC_ACQUIRE, "agent");
        asm volatile("s_waitcnt vmcnt(0)" ::: "memory");
    }
    __syncthreads();
}

typedef const __attribute__((address_space(4))) Args* CArgs;
__device__ __forceinline__ CArgs fresh_args() { CArgs p = (CArgs)__builtin_amdgcn_kernarg_segment_ptr(); asm volatile("" : "+s"(p)); return p; }
#define PTRS() CArgs A = fresh_args(); unsigned char* ws = A->ws; \
    bf16_t* XN = (bf16_t*)(ws + WS_B0); bf16_t* QA = (bf16_t*)(ws + WS_QA); bf16_t* BZ = (bf16_t*)(ws + WS_BZ); bf16_t* SZA = (bf16_t*)(ws + WS_SZA); \
    bf16_t* Ub = (bf16_t*)(ws + WS_U); bf16_t* SGB = (bf16_t*)(ws + WS_SGB); bf16_t* Kb = (bf16_t*)(ws + WS_K); bf16_t* Vt = (bf16_t*)(ws + WS_VT); \
    bf16_t* SGA = (bf16_t*)A->out; float* rope = (float*)(ws + WS_ROPE); \
    (void)XN; (void)QA; (void)BZ; (void)SZA; (void)Ub; (void)SGB; (void)Kb; (void)Vt; (void)SGA; (void)rope
#define G2_DECL() const pg8::Gemm g2{QA + (size_t)R_PROMPT * DM, (const bf16_t*)(ws + WS_WA), M23, DM, DM, BUFB, 2097152}; const Epi2 E2{SGA + (size_t)R_PROMPT * DM, SGB + (size_t)R_PROMPT * DM, XN}
#define G3_DECL() const pg8::Gemm g3{XN, (const bf16_t*)(ws + WS_WO), M23, DM, DM, 0, 0}; const Epi3 E3{A->in[0], A->in[1], A->out + O_Y}
__global__ void __launch_bounds__(512, 2) hybrid_fwd(Args a_unused) {
    extern __shared__ __attribute__((aligned(16))) unsigned char lds_raw[];
    LAS unsigned char* lds = (LAS unsigned char*)lds_raw;
    const int G = gridDim.x;
#define TIDS() int tid = threadIdx.x; asm volatile("" : "+v"(tid)); const int lane = tid & 63, wave = __builtin_amdgcn_readfirstlane(tid >> 6); (void)lane; (void)wave
#define GSYNC() xcd_barrier(xbar)
    volatile LAS unsigned* MISC = (volatile LAS unsigned*)(lds + 131072);
    if (threadIdx.x < 4) MISC[threadIdx.x] = 0u;
    __syncthreads();
    XcdBarrier xbar;
    { CArgs A = fresh_args(); xbar = xcd_barrier_post((unsigned*)(A->ws + WS_CTL), MISC);
      if (A->ph_lo > 1000) cg::this_grid().sync(); }
    unsigned long long pt0 = 0, pt1 = 0; (void)pt0; (void)pt1;
#define PSTAMP0(k) do { if (PROBE_PH == (k)) pt0 = __builtin_amdgcn_s_memrealtime(); } while (0)
#define PSTAMP1(k) do { if (PROBE_PH == (k)) pt1 = __builtin_amdgcn_s_memrealtime(); } while (0)
    const bool split = (G == 256);
    constexpr int NSPL = 16;
    PSTAMP0(0);
    { TIDS(); CArgs A = fresh_args(); Args pa; pa.in[0] = A->in[0]; pa.in[1] = A->in[1]; pa.in[5] = A->in[5]; pa.in[6] = A->in[6]; pa.in[7] = A->in[7]; pa.in[12] = A->in[12]; pa.in[13] = A->in[13]; pa.in[14] = A->in[14]; pa.ws = A->ws; p0_prologue(pa, lds, tid, lane, wave, G); }
    GSYNC();
    PSTAMP1(0); PSTAMP0(1);
    {
        PTRS();
        pg8::Gemm g{XN, (const bf16_t*)(ws + WS_WIN), MROWS, NIN, DM, 0, 0}; pg8::StaticOrder S; S.init(MROWS, NIN, G, (int)blockIdx.x, 1); S.special = split ? 1 : 0;
        Epi1 E{QA, Kb, Vt, SZA, BZ, Ub, SGA, SGB, rope, A->in[8], A->in[9], A->out};
        pg8::gemm_phase<Epi1>(lds, g, S, E);
    }
    GSYNC();
    PSTAMP1(1); PSTAMP0(2);
    {
        TIDS(); PTRS();
        for (int id = blockIdx.x; id < 256; id += G) attn_sample_wg(lds, tid, id, A->in[2], A->in[3], Kb, Vt, QA, SZA, A->in[10], A->out);
        conv_pass(blockIdx.x * 512 + tid, G * 512, 2048, M23 / 8, Ub, BZ, A->in[11], A->in[4]);
    }
    GSYNC();
    PSTAMP1(2); PSTAMP0(3); if (PROBE_PH == 6) pt0 = __builtin_amdgcn_s_memrealtime();
    if (split && blockIdx.x < 2 * NSPL) {
        const int c = (int)blockIdx.x, tj = c & (NSPL - 1);
#define SPL_PTRS() PTRS(); float* scr1 = (float*)(ws + WS_B0) + (size_t)tj * 65536; float* scr2 = (float*)(ws + WS_B0) + (size_t)(NSPL + tj) * 65536; \
        unsigned* cnt1 = (unsigned*)(ws + WS_CTL) + 9216 + 64 * tj; unsigned* cnt2 = (unsigned*)(ws + WS_CTL) + 10240 + 64 * tj; unsigned* bar32 = (unsigned*)(ws + WS_CTL) + 8192; \
        (void)scr1; (void)scr2; (void)cnt1; (void)cnt2; (void)bar32
        if (c < NSPL) {
            { SPL_PTRS(); const pg8::Gemm ga{QA + (size_t)R_PROMPT * DM, (const bf16_t*)(ws + WS_WA), M23, DM, DM, 0, 0, 0};
              const EpiPart<true> Ea{SGA + (size_t)R_PROMPT * DM, scr1, SGB + (size_t)R_PROMPT * DM};
              pg8::StaticOrder S; S.init(M23, DM, G, c, 1, 256 + tj); pg8::gemm_phase<EpiPart<true>>(lds, ga, S, Ea); publish_count(cnt1); }
            { SPL_PTRS(); sub_barrier(bar32, 2 * NSPL); }
            { SPL_PTRS(); const pg8::Gemm g3a{XN, (const bf16_t*)(ws + WS_WO), M23, DM, 512, 0, 0, DM};
              const EpiPart<false> Ea{nullptr, scr2, nullptr};
              pg8::StaticOrder S; S.init(M23, DM, G, c, 1, 256 + tj); pg8::gemm_phase<EpiPart<false>>(lds, g3a, S, Ea); publish_count(cnt2); }
        } else {
            { SPL_PTRS(); const pg8::Gemm gb{BZ + (size_t)R_PROMPT * DM, (const bf16_t*)(ws + WS_WB), M23, DM, DM, 0, 0, 0};
              const Epi2b Eb{SGB + (size_t)R_PROMPT * DM, scr1, XN, cnt1};
              pg8::StaticOrder S; S.init(M23, DM, G, c, 1, 256 + tj); pg8::gemm_phase<Epi2b>(lds, gb, S, Eb); }
            { SPL_PTRS(); sub_barrier(bar32, 2 * NSPL); }
            { SPL_PTRS(); const pg8::Gemm g3b{XN + 512, (const bf16_t*)(ws + WS_WO) + 512, M23, DM, 512, 0, 0, DM};
              const Epi3b Eb{A->in[0], A->in[1], A->out + O_Y, scr2, cnt2};
              pg8::StaticOrder S; S.init(M23, DM, G, c, 1, 256 + tj); pg8::gemm_phase<Epi3b>(lds, g3b, S, Eb); }
        }
#undef SPL_PTRS
    } else {
        TIDS(); PTRS();
        const int vc = split ? (int)blockIdx.x - 2 * NSPL : (int)blockIdx.x, VG = split ? G - 2 * NSPL : G;
        if (split) {
            const int nd = vc < 150 ? 1 : 2, j0 = vc < 150 ? vc : 150 + 2 * (vc - 150);
            {
                const int ja = j0, qa = ja - 2, ta = (ja < 2 ? 26 : 27 + (qa >> 3)) * 34 + (ja < 2 ? 32 + ja : 26 + (qa & 7));
                const int jb = j0 + 1, qb = jb - 2, tb = (jb < 2 ? 26 : 27 + (qb >> 3)) * 34 + (jb < 2 ? 32 + jb : 26 + (qb & 7));
                pg8::Gemm g{XN, (const bf16_t*)(ws + WS_WIN), MROWS, NIN, DM, 0, 0}; pg8::StaticOrder S; S.init(MROWS, NIN, G, (int)blockIdx.x, 1, ta); S.direct2 = nd == 2 ? tb : -1;
                Epi1 E{QA, Kb, Vt, SZA, BZ, Ub, SGA, SGB, rope, A->in[8], A->in[9], A->out};
                pg8::gemm_phase<Epi1>(lds, g, S, E);
            }
        }
        {
            const int a0 = !split ? vc : (vc < 150 ? 5 * vc : (vc < 172 ? 750 + 3 * (vc - 150) : 816 + 4 * (vc - 172))), na = vc < 150 ? 5 : (vc < 172 ? 3 : 4);
            attn_prompt_all(lds, tid, a0, split ? 1 : VG, split ? a0 + na : 1024, Kb, Vt, QA, SZA, A->in[10]);
        }
        { int tid2 = threadIdx.x; asm volatile("" : "+v"(tid2)); conv_pass(vc * 512 + tid2, VG * 512, 0, 2048, Ub, BZ, A->in[11], A->in[4]); }
    }
    if (PROBE_PH == 6) pt1 = __builtin_amdgcn_s_memrealtime();
    GSYNC();
    PSTAMP1(3); PSTAMP0(4);
    { PTRS(); G2_DECL(); pg8::StaticOrder S; S.init(split ? 16384 : M23, DM, G, (int)blockIdx.x, 2); pg8::gemm_phase<Epi2>(lds, g2, S, E2); }
    GSYNC();
#if REP_MASK & 8
    { PTRS(); G2_DECL(); pg8::StaticOrder S; S.init(split ? 16384 : M23, DM, G, (int)blockIdx.x, 2); pg8::gemm_phase<Epi2>(lds, g2, S, E2); }
    GSYNC();
#endif
    PSTAMP1(4); PSTAMP0(5);
    { PTRS(); G3_DECL(); pg8::StaticOrder S; S.init(split ? 16384 : M23, DM, G, (int)blockIdx.x, 1); pg8::gemm_phase<Epi3>(lds, g3, S, E3); }
#if REP_MASK & 16
    GSYNC();
    { PTRS(); G3_DECL(); pg8::StaticOrder S; S.init(split ? 16384 : M23, DM, G, (int)blockIdx.x, 1); pg8::gemm_phase<Epi3>(lds, g3, S, E3); }
#endif
    PSTAMP1(5);
    if (PROBE_PH >= 0 && blockIdx.x == PROBE_BLK) { const unsigned long long te = __builtin_amdgcn_s_memrealtime(); while (__builtin_amdgcn_s_memrealtime() - te < pt1 - pt0) __builtin_amdgcn_s_sleep(8); }
#undef GSYNC
}

#ifndef DBG_DUMP
#define DBG_DUMP 0
#endif
__global__ void dbg_dump(const bf16_t* src, float* dst, size_t n) {
    for (size_t i = (size_t)blockIdx.x * blockDim.x + threadIdx.x; i < n; i += (size_t)gridDim.x * blockDim.x) dst[i] = __uint_as_float((unsigned)src[i] << 16);
}
extern "C" void kernel_launch(void* const* d_in, const int* in_sizes, int n_in, void* d_out, int out_size, void* d_ws, size_t ws_size, hipStream_t stream) {
    static int grid = 0;
    if (grid == 0) {
        int dev = 0, cus = 0, per_cu = 0;
        if (n_in != 15 || ws_size < WS_END) { fprintf(stderr, "kernel_launch: unexpected inputs (n_in %d, ws %zu)\n", n_in, ws_size); grid = -1; return; }
        if (hipGetDevice(&dev) != hipSuccess || hipDeviceGetAttribute(&cus, hipDeviceAttributeMultiprocessorCount, dev) != hipSuccess) { grid = -1; return; }
        if (hipFuncSetAttribute((const void*)hybrid_fwd, hipFuncAttributeMaxDynamicSharedMemorySize, LDS_BYTES) != hipSuccess) { fprintf(stderr, "kernel_launch: hipFuncSetAttribute failed\n"); grid = -1; return; }
        if (hipOccupancyMaxActiveBlocksPerMultiprocessor(&per_cu, (const void*)hybrid_fwd, 512, LDS_BYTES) != hipSuccess || per_cu < 1) { fprintf(stderr, "kernel_launch: occupancy query gives %d\n", per_cu); per_cu = 1; }
        (void)hipGetLastError();
        grid = cus * 1;
    }
    if (grid < 0) return;
    Args a{};
    for (int i = 0; i < 15; ++i) a.in[i] = (const float*)d_in[i];
    a.out = (float*)d_out; a.ws = (unsigned char*)d_ws;
    if (hipMemsetAsync((char*)d_ws + WS_CTL, 0, CTL_BYTES, stream) != hipSuccess) { fprintf(stderr, "kernel_launch: memset of the barrier words failed\n"); return; }
    a.ph_lo = 0; a.ph_hi = 5;
    void* args[] = {&a};
    hipError_t e = hipLaunchCooperativeKernel((const void*)hybrid_fwd, dim3(grid), dim3(512), args, LDS_BYTES, stream);
    if (e != hipSuccess) fprintf(stderr, "cooperative launch failed: %s (grid %d)\n", hipGetErrorString(e), grid);
}
```
